# Optimizing an MI355X kernel written in HIP

```python
import math
import jax, jax.numpy as jnp
from jax import lax
import numpy as np

D_MODEL = 1024
BATCH = 32
SEQ = 256
DEPTH = 2
DEC_BATCH = 4
DEC_SEQ = 4096
PAST_LEN = 256

GRID_W = 64
N_EVEN = (DEPTH + 1) // 2
N_ODD = DEPTH // 2
ADA_CHUNKS = 6
EPS = 1e-6
HY_WIDTH = D_MODEL // 2
HY_ORDER = 2
HY_BANDS = 16
HY_EMB = 1 + 2 * HY_BANDS
HY_FFN = 64
S5_WIDTH = D_MODEL // 2
S5_CH = 16
S5_GROUPS = S5_WIDTH // S5_CH
S5_P = 64
ML_WIDTH = D_MODEL
ML_HEADS = 8
ML_DH = ML_WIDTH // ML_HEADS
ML_CHUNK = 128
PK_HEADS = 8
PK_DQ = 256
PK_HALF = PK_DQ // 2
N_KEYS = 128
N_EXPERTS = N_KEYS * N_KEYS
PK_TOPK = 16
PEER_BLOCK = 128

kernel_name = 'hyena_s5_mlstm_peer_diffusion_step'


def _f(a):
    return a.astype(jnp.float32)


def rmsnorm(x, g):
    x32 = _f(x)
    y = x32 * lax.rsqrt(jnp.mean(x32 * x32, axis=-1, keepdims=True) + EPS)
    return (y * _f(g)).astype(x.dtype)


def short_conv(x, w, b):
    xp = jnp.pad(x, ((0, 0), (1, 1), (0, 0)))
    return xp[:, :-2] * w[0] + xp[:, 1:-1] * w[1] + xp[:, 2:] * w[2] + b


def grid_pos_embed(n_tok, dtype):
    rows = n_tok // GRID_W
    quarter = D_MODEL // 4
    omega = 1.0 / (10000.0 ** (jnp.arange(quarter, dtype=jnp.float32) / quarter))
    def emb1d(pos):
        ang = pos.astype(jnp.float32)[:, None] * omega[None]
        return jnp.concatenate([jnp.sin(ang), jnp.cos(ang)], axis=-1)
    er = emb1d(jnp.arange(rows))
    ec = emb1d(jnp.arange(GRID_W))
    half = D_MODEL // 2
    pe = jnp.concatenate([jnp.broadcast_to(er[:, None], (rows, GRID_W, half)),
                          jnp.broadcast_to(ec[None], (rows, GRID_W, half))], axis=-1)
    return pe.reshape(rows * GRID_W, D_MODEL).astype(dtype)


def hyena_filters(n_tok, w1, b1, w2, b2, w3, freq, decay):
    pos = jnp.arange(n_tok, dtype=jnp.float32)
    t = pos / n_tok
    bands = jnp.linspace(1e-4, HY_BANDS - 1, HY_BANDS, dtype=jnp.float32)
    ang = 2.0 * math.pi * t[:, None] * bands[None]
    z = jnp.concatenate([t[:, None], jnp.cos(ang), jnp.sin(ang)], axis=-1)
    fr = _f(freq)
    h = jnp.sin(fr * (z @ _f(w1) + _f(b1)))
    h = jnp.sin(fr * (h @ _f(w2) + _f(b2)))
    h = (h @ _f(w3)) * jnp.exp(-t[:, None] * jnp.abs(_f(decay)))
    h = h.reshape(n_tok, HY_ORDER, 2, HY_WIDTH)
    fwd, bwd = h[:, :, 0], h[:, :, 1]
    kern = jnp.concatenate([fwd, jnp.zeros_like(fwd[:1]), bwd[1:][::-1]], axis=0)
    kern = kern * lax.rsqrt(jnp.sum(kern * kern, axis=0, keepdims=True) + EPS)
    return jnp.fft.rfft(kern, axis=0)


def hyena_mix(u, kf, bias):
    n_tok = u.shape[1]
    v, g1, g2 = jnp.split(_f(u), 3, axis=-1)
    gates = (g1, g2)
    z = v
    for o in range(HY_ORDER):
        zf = jnp.fft.rfft(z, n=2 * n_tok, axis=1)
        conv = jnp.fft.irfft(zf * kf[None, :, o], n=2 * n_tok, axis=1)[:, :n_tok]
        z = gates[o] * (conv + bias[o] * z)
    return z


def _lin_rec(e1, e2):
    a1, b1 = e1
    a2, b2 = e2
    return a1 * a2, a2 * b1 + b2


def s5_scan(u, lam_bar, b_bar, c_mat, h0):
    bu = jnp.einsum('gpj,blgj->blgp', b_bar, u.astype(jnp.complex64))
    bu = bu.at[:, 0].add(lam_bar[None] * h0)
    a = jnp.broadcast_to(lam_bar, bu.shape)
    _, hs = lax.associative_scan(_lin_rec, (a, bu), axis=1)
    y = jnp.einsum('gjp,blgp->blgj', c_mat, hs).real
    return y, hs[:, -1]


def s5_mix(u, h0_re, h0_im, a_re, a_im, b_re, b_im, c_re, c_im, log_step, d_skip, glu_w, glu_b):
    bsz, n_tok, _ = u.shape
    u = _f(u).reshape(bsz, n_tok, S5_GROUPS, S5_CH)
    lam = lax.complex(_f(a_re), _f(a_im))
    lam_bar = jnp.exp(lam * jnp.exp(_f(log_step))[..., None])
    b_bar = ((lam_bar - 1.0) / lam)[..., None] * lax.complex(_f(b_re), _f(b_im))
    c_mat = lax.complex(_f(c_re), _f(c_im))
    h0 = lax.complex(_f(h0_re), _f(h0_im))
    y_f, hf = s5_scan(u, lam_bar[0], b_bar[0], c_mat[0], h0[:, 0])
    y_b, hb = s5_scan(u[:, ::-1], lam_bar[1], b_bar[1], c_mat[1], h0[:, 1])
    u_flat = u.reshape(bsz, n_tok, S5_WIDTH)
    y = (y_f + y_b[:, ::-1]).reshape(bsz, n_tok, S5_WIDTH) + _f(d_skip) * u_flat
    y = jax.nn.gelu(y)
    y = y * jax.nn.sigmoid(y @ _f(glu_w) + _f(glu_b))
    h_fin = jnp.stack([hf, hb], axis=1)
    return y, h_fin.real, h_fin.imag


def mlstm_scan(q, k, v, ig, lf, c0, n0, m0):
    bsz, nh, n_tok, dh = q.shape
    nc = n_tok // ML_CHUNK
    def chunks(a):
        return jnp.moveaxis(a.reshape(bsz, nh, nc, ML_CHUNK, *a.shape[3:]), 2, 0)
    causal = jnp.tril(jnp.ones((ML_CHUNK, ML_CHUNK), dtype=bool))
    def step(carry, xs):
        cm, nv, m = carry
        qc, kc, vc, ic, fc = xs
        b = jnp.cumsum(fc, axis=-1)
        a = b + m[..., None]
        dmat = jnp.where(causal, b[..., :, None] - b[..., None, :] + ic[..., None, :], -jnp.inf)
        mq = jnp.maximum(a, jnp.max(dmat, axis=-1))
        w_intra = jnp.exp(dmat - mq[..., None])
        w_inter = jnp.exp(a - mq)
        s = jnp.einsum('bhtd,bhsd->bhts', qc, kc) * w_intra
        num = jnp.einsum('bhts,bhsv->bhtv', s, vc) + w_inter[..., None] * jnp.einsum('bhtk,bhkv->bhtv', qc, cm)
        den = jnp.sum(s, axis=-1) + w_inter * jnp.einsum('bhtk,bhk->bht', qc, nv)
        h = num / jnp.maximum(jnp.abs(den), jnp.exp(-mq))[..., None]
        b_last = b[..., -1]
        g = b_last[..., None] - b + ic
        m_new = jnp.maximum(b_last + m, jnp.max(g, axis=-1))
        w_s = jnp.exp(g - m_new[..., None])
        keep = jnp.exp(b_last + m - m_new)
        cm_new = keep[..., None, None] * cm + jnp.einsum('bhs,bhsk,bhsv->bhkv', w_s, kc, vc)
        nv_new = keep[..., None] * nv + jnp.einsum('bhs,bhsk->bhk', w_s, kc)
        return (cm_new, nv_new, m_new), h
    (cm, nv, m), hs = lax.scan(step, (c0, n0, m0), (chunks(q), chunks(k), chunks(v), chunks(ig), chunks(lf)))
    h = jnp.moveaxis(hs, 0, 2).reshape(bsz, nh, n_tok, dh)
    return h, cm, nv, m


def mlstm_mix(hn, c0, n0, m0, w_in, gate_b, conv_w, conv_b, norm_g, w_out):
    bsz, n_tok, _ = hn.shape
    proj = _f(hn @ w_in)
    qk_raw, v, o, gates = jnp.split(proj, [2 * ML_WIDTH, 3 * ML_WIDTH, 4 * ML_WIDTH], axis=-1)
    qk = jax.nn.silu(short_conv(qk_raw, _f(conv_w), _f(conv_b)))
    q, k = jnp.split(qk, 2, axis=-1)
    def heads(a):
        return a.reshape(bsz, n_tok, ML_HEADS, ML_DH).transpose(0, 2, 1, 3)
    q = heads(q) * (ML_DH ** -0.5)
    k = heads(k)
    vh = heads(v)
    gates = (gates.reshape(bsz, n_tok, 4, ML_HEADS) + _f(gate_b)).transpose(2, 0, 3, 1)
    ig_f, ig_b = gates[0], gates[1]
    lf_f, lf_b = jax.nn.log_sigmoid(gates[2]), jax.nn.log_sigmoid(gates[3])
    c0, n0, m0 = _f(c0), _f(n0), _f(m0)
    h_f, cf, nf, mf = mlstm_scan(q, k, vh, ig_f, lf_f, c0[:, 0], n0[:, 0], m0[:, 0])
    def rev(a):
        return jnp.flip(a, axis=2)
    h_b, cb, nb, mb = mlstm_scan(rev(q), rev(k), rev(vh), rev(ig_b), rev(lf_b), c0[:, 1], n0[:, 1], m0[:, 1])
    h = h_f + rev(h_b)
    h = h * lax.rsqrt(jnp.mean(h * h, axis=-1, keepdims=True) + EPS)
    h = h.transpose(0, 2, 1, 3).reshape(bsz, n_tok, ML_WIDTH) * _f(norm_g)
    out = (h * jax.nn.silu(o)).astype(hn.dtype) @ w_out
    return out, jnp.stack([cf, cb], 1), jnp.stack([nf, nb], 1), jnp.stack([mf, mb], 1)


def peer(x, w_q, keys, u_tab, v_tab):
    bsz, n_tok, _ = x.shape
    n = bsz * n_tok
    xt = x.reshape(n, D_MODEL)
    q = _f(xt @ w_q).reshape(n, PK_HEADS, 2, PK_HALF)
    s = jnp.einsum('thcd,hcnd->thcn', q, _f(keys))
    sv, si = lax.top_k(s, PK_TOPK)
    cand = (sv[:, :, 0, :, None] + sv[:, :, 1, None, :]).reshape(n, PK_HEADS, PK_TOPK * PK_TOPK)
    best, bi = lax.top_k(cand, PK_TOPK)
    i1 = jnp.take_along_axis(si[:, :, 0], bi // PK_TOPK, axis=-1)
    i2 = jnp.take_along_axis(si[:, :, 1], bi % PK_TOPK, axis=-1)
    nblk = n // PEER_BLOCK
    eidx = (i1 * N_KEYS + i2).reshape(nblk, PEER_BLOCK, PK_HEADS * PK_TOPK)
    gate = jax.nn.softmax(best, axis=-1).reshape(nblk, PEER_BLOCK, PK_HEADS * PK_TOPK)
    xb = xt.reshape(nblk, PEER_BLOCK, D_MODEL)
    def block(args):
        xi, ei, gi = args
        act = jax.nn.gelu(_f(jnp.einsum('td,ted->te', xi, u_tab[ei]))) * gi
        return jnp.einsum('te,ted->td', act.astype(xi.dtype), v_tab[ei])
    out = lax.map(block, (xb, eidx, gate))
    return out.reshape(bsz, n_tok, D_MODEL).astype(x.dtype)


def even_mixer(h, s5_re0, s5_im0, p, i):
    n_tok = h.shape[1]
    proj = h @ p['ev_w_in'][i]
    hy_in = short_conv(proj[..., :3 * HY_WIDTH], p['hy_conv_w'][i], p['hy_conv_b'][i])
    kf = hyena_filters(n_tok, p['hy_w1'][i], p['hy_b1'][i], p['hy_w2'][i], p['hy_b2'][i],
                       p['hy_w3'][i], p['hy_freq'][i], p['hy_decay'][i])
    hy_out = hyena_mix(hy_in, kf, _f(p['hy_bias'][i]))
    s5_out, s_re, s_im = s5_mix(proj[..., 3 * HY_WIDTH:], s5_re0, s5_im0,
                                p['s5_a_re'][i], p['s5_a_im'][i], p['s5_b_re'][i], p['s5_b_im'][i],
                                p['s5_c_re'][i], p['s5_c_im'][i], p['s5_log_step'][i], p['s5_d'][i],
                                p['s5_glu_w'][i], p['s5_glu_b'][i])
    out = jnp.concatenate([hy_out, s5_out], axis=-1).astype(h.dtype) @ p['ev_w_out'][i]
    return out, s_re, s_im


def odd_mixer(h, c0, n0, m0, p, i):
    return mlstm_mix(h, c0, n0, m0, p['od_w_in'][i], p['od_gate_b'][i], p['ml_conv_w'][i],
                     p['ml_conv_b'][i], p['ml_norm_g'][i], p['od_w_out'][i])


def trunk(x, cond, s5_re0, s5_im0, ml_c0, ml_n0, ml_m0, p):
    s5_re, s5_im, ml_c, ml_n, ml_m = [], [], [], [], []
    for l in range(DEPTH):
        mod = jax.nn.silu(_f(cond)) @ _f(p['ada_w'][l]) + _f(p['ada_b'][l])
        sh1, sc1, g1, sh2, sc2, g2 = jnp.split(mod[:, None, :].astype(x.dtype), ADA_CHUNKS, axis=-1)
        h = rmsnorm(x, p['norm_g'][l, 0]) * (1 + sc1) + sh1
        i = l // 2
        if l % 2 == 0:
            y, sr, si = even_mixer(h, s5_re0[:, i], s5_im0[:, i], p, i)
            s5_re.append(sr)
            s5_im.append(si)
        else:
            y, cm, nv, m = odd_mixer(h, ml_c0[:, i], ml_n0[:, i], ml_m0[:, i], p, i)
            ml_c.append(cm)
            ml_n.append(nv)
            ml_m.append(m)
        x = x + g1 * y
        h = rmsnorm(x, p['norm_g'][l, 1]) * (1 + sc2) + sh2
        x = x + g2 * peer(h, p['pk_w_q'][l], p['pk_keys'][l], p['pk_u'][l], p['pk_v'][l])
    y = rmsnorm(x, p['final_g'])
    return (y, jnp.stack(s5_re, 1), jnp.stack(s5_im, 1), jnp.stack(ml_c, 1), jnp.stack(ml_n, 1), jnp.stack(ml_m, 1))


def setup_inputs(seed: int = 0) -> dict:
    key = jax.random.key(seed)
    ks = iter(list(jax.random.split(key, 64)))
    f32 = jnp.float32
    def nrm(shape, scale):
        return jax.random.normal(next(ks), shape, f32) * scale
    def unif(shape, lo, hi):
        return jax.random.uniform(next(ks), shape, f32, lo, hi)
    d = D_MODEL
    ne, no = N_EVEN, N_ODD
    hy_decay0 = jnp.linspace(math.log(100.0) / 1.5, math.log(100.0) / 0.3, 4 * HY_WIDTH, dtype=f32)
    fgate0 = jnp.linspace(3.0, 6.0, ML_HEADS, dtype=f32)
    return {
        'x_prompt': nrm((BATCH, SEQ, d), 1.0),
        'x_sample': nrm((DEC_BATCH, DEC_SEQ, d), 1.0),
        'state_s5_re': nrm((DEC_BATCH, ne, 2, S5_GROUPS, S5_P), 0.1),
        'state_s5_im': nrm((DEC_BATCH, ne, 2, S5_GROUPS, S5_P), 0.1),
        'state_mlstm_C': nrm((DEC_BATCH, no, 2, ML_HEADS, ML_DH, ML_DH), 0.3),
        'state_mlstm_n': nrm((DEC_BATCH, no, 2, ML_HEADS, ML_DH), 0.3),
        'state_mlstm_m': unif((DEC_BATCH, no, 2, ML_HEADS), 0.0, 3.0),
        'c': nrm((DEC_BATCH, d), 1.0),
        'c_ctx': nrm((d,), 1.0),
        'norm_g': 1.0 + nrm((DEPTH, 2, d), 0.02),
        'ada_w': nrm((DEPTH, d, ADA_CHUNKS * d), 0.5 * d ** -0.5),
        'ada_b': nrm((DEPTH, ADA_CHUNKS * d), 0.02),
        'final_g': 1.0 + nrm((d,), 0.02),
        'ev_w_in': nrm((ne, d, 3 * HY_WIDTH + S5_WIDTH), d ** -0.5),
        'hy_conv_w': nrm((ne, 3, 3 * HY_WIDTH), 3 ** -0.5),
        'hy_conv_b': nrm((ne, 3 * HY_WIDTH), 0.02),
        'hy_w1': nrm((ne, HY_EMB, HY_FFN), HY_EMB ** -0.5),
        'hy_b1': nrm((ne, HY_FFN), 0.1),
        'hy_w2': nrm((ne, HY_FFN, HY_FFN), HY_FFN ** -0.5),
        'hy_b2': nrm((ne, HY_FFN), 0.1),
        'hy_w3': nrm((ne, HY_FFN, 4 * HY_WIDTH), HY_FFN ** -0.5),
        'hy_freq': 1.0 + nrm((ne, HY_FFN), 0.1),
        'hy_decay': hy_decay0[None] + nrm((ne, 4 * HY_WIDTH), 0.1),
        'hy_bias': nrm((ne, HY_ORDER, HY_WIDTH), 0.1),
        's5_a_re': -0.5 + nrm((ne, 2, S5_GROUPS, S5_P), 0.01),
        's5_a_im': math.pi * jnp.arange(S5_P, dtype=f32) + nrm((ne, 2, S5_GROUPS, S5_P), 0.01),
        's5_b_re': nrm((ne, 2, S5_GROUPS, S5_P, S5_CH), (2 * S5_CH) ** -0.5),
        's5_b_im': nrm((ne, 2, S5_GROUPS, S5_P, S5_CH), (2 * S5_CH) ** -0.5),
        's5_c_re': nrm((ne, 2, S5_GROUPS, S5_CH, S5_P), S5_P ** -0.5),
        's5_c_im': nrm((ne, 2, S5_GROUPS, S5_CH, S5_P), S5_P ** -0.5),
        's5_log_step': unif((ne, 2, S5_GROUPS), math.log(1e-3), math.log(1e-1)),
        's5_d': nrm((ne, S5_WIDTH), 1.0),
        's5_glu_w': nrm((ne, S5_WIDTH, S5_WIDTH), S5_WIDTH ** -0.5),
        's5_glu_b': nrm((ne, S5_WIDTH), 0.02),
        'ev_w_out': nrm((ne, HY_WIDTH + S5_WIDTH, d), (HY_WIDTH + S5_WIDTH) ** -0.5),
        'od_w_in': nrm((no, d, 4 * ML_WIDTH + 4 * ML_HEADS), d ** -0.5),
        'od_gate_b': jnp.concatenate([nrm((no, 2, ML_HEADS), 0.1),
                                      fgate0[None, None] + nrm((no, 2, ML_HEADS), 0.1)], axis=1),
        'ml_conv_w': nrm((no, 3, 2 * ML_WIDTH), 3 ** -0.5),
        'ml_conv_b': nrm((no, 2 * ML_WIDTH), 0.02),
        'ml_norm_g': 1.0 + nrm((no, ML_WIDTH), 0.02),
        'od_w_out': nrm((no, ML_WIDTH, d), ML_WIDTH ** -0.5),
        'pk_w_q': nrm((DEPTH, d, PK_HEADS * PK_DQ), d ** -0.5),
        'pk_keys': nrm((DEPTH, PK_HEADS, 2, N_KEYS, PK_HALF), PK_HALF ** -0.5),
        'pk_u': nrm((DEPTH, N_EXPERTS, d), d ** -0.5),
        'pk_v': nrm((DEPTH, N_EXPERTS, d), PK_HEADS ** -0.5),
    }


def reference(x_prompt, x_sample, state_s5_re, state_s5_im, state_mlstm_C, state_mlstm_n, state_mlstm_m,
              c, c_ctx, norm_g, ada_w, ada_b, final_g, ev_w_in, hy_conv_w, hy_conv_b, hy_w1, hy_b1, hy_w2,
              hy_b2, hy_w3, hy_freq, hy_decay, hy_bias, s5_a_re, s5_a_im, s5_b_re, s5_b_im, s5_c_re, s5_c_im,
              s5_log_step, s5_d, s5_glu_w, s5_glu_b, ev_w_out, od_w_in, od_gate_b, ml_conv_w, ml_conv_b,
              ml_norm_g, od_w_out, pk_w_q, pk_keys, pk_u, pk_v):
    p = dict(norm_g=norm_g, ada_w=ada_w, ada_b=ada_b, final_g=final_g, ev_w_in=ev_w_in,
             hy_conv_w=hy_conv_w, hy_conv_b=hy_conv_b, hy_w1=hy_w1, hy_b1=hy_b1, hy_w2=hy_w2, hy_b2=hy_b2,
             hy_w3=hy_w3, hy_freq=hy_freq, hy_decay=hy_decay, hy_bias=hy_bias, s5_a_re=s5_a_re,
             s5_a_im=s5_a_im, s5_b_re=s5_b_re, s5_b_im=s5_b_im, s5_c_re=s5_c_re, s5_c_im=s5_c_im,
             s5_log_step=s5_log_step, s5_d=s5_d, s5_glu_w=s5_glu_w, s5_glu_b=s5_glu_b, ev_w_out=ev_w_out,
             od_w_in=od_w_in, od_gate_b=od_gate_b, ml_conv_w=ml_conv_w, ml_conv_b=ml_conv_b,
             ml_norm_g=ml_norm_g, od_w_out=od_w_out, pk_w_q=pk_w_q, pk_keys=pk_keys, pk_u=pk_u, pk_v=pk_v)
    f32 = jnp.float32
    nb = x_prompt.shape[0]
    z_s5 = jnp.zeros((nb, N_EVEN, 2, S5_GROUPS, S5_P), f32)
    z_c = jnp.zeros((nb, N_ODD, 2, ML_HEADS, ML_DH, ML_DH), f32)
    z_n = jnp.zeros((nb, N_ODD, 2, ML_HEADS, ML_DH), f32)
    z_m = jnp.zeros((nb, N_ODD, 2, ML_HEADS), f32)
    y_prompt, new_s5_re, new_s5_im, new_mlstm_C, new_mlstm_n, new_mlstm_m = trunk(
        x_prompt, c_ctx[None], z_s5, z_s5, z_c, z_n, z_m, p)
    x_lat = x_sample + grid_pos_embed(x_sample.shape[1], x_sample.dtype)
    y_sample = trunk(x_lat, c, state_s5_re, state_s5_im, state_mlstm_C, state_mlstm_n, state_mlstm_m, p)[0]
    return (y_prompt, y_sample, new_s5_re, new_s5_im, new_mlstm_C, new_mlstm_n, new_mlstm_m)
```

```cpp
#ifndef EMU
#include <hip/hip_runtime.h>
#include <hip/hip_cooperative_groups.h>
#include <cstdio>
#include <cstdint>
typedef __attribute__((ext_vector_type(8))) short bf16x8;
typedef __attribute__((ext_vector_type(4))) float f32x4;
#define DEV __device__ __forceinline__
#define DEVM __device__ __forceinline__
DEV f32x4 mfma16(bf16x8 a, bf16x8 b, f32x4 c) { return __builtin_amdgcn_mfma_f32_16x16x32_bf16(a, b, c, 0, 0, 0); }
typedef __attribute__((ext_vector_type(4))) short bf16x4;
DEV f32x4 mfma16k16(bf16x4 a, bf16x4 b, f32x4 c) { return __builtin_amdgcn_mfma_f32_16x16x16bf16_1k(a, b, c, 0, 0, 0); }
DEV float u2f(unsigned u) { return __uint_as_float(u); }
DEV unsigned f2u(float f) { return __float_as_uint(f); }
#define SYNC() __syncthreads()
#define GRID_SYNC() cooperative_groups::this_grid().sync()
#define SMEM_DECL(name) extern __shared__ __attribute__((aligned(16))) unsigned char name[]
DEV void glds16(const void* g, void* l) {
  __builtin_amdgcn_global_load_lds((const __attribute__((address_space(1))) unsigned*)g, (__attribute__((address_space(3))) unsigned*)l, 16, 0, 0);
}
DEV void glds_wait() { asm volatile("s_waitcnt vmcnt(0)" ::: "memory"); }
DEV void asm_wait_vm6() { asm volatile("s_waitcnt vmcnt(6)" ::: "memory"); }
DEV int tid_opaque() { int t = threadIdx.x; asm volatile("" : "+v"(t) :: "memory"); return t; }
template <int CTRL> DEV float dpp_mov(float v) { return __int_as_float(__builtin_amdgcn_mov_dpp(__float_as_int(v), CTRL, 0xF, 0xF, true)); }
#else
#define DEV static inline
#define DEVM inline
DEV f32x4 mfma16(bf16x8 a, bf16x8 b, f32x4 c) { return emu_mfma_16x16x32_bf16(a, b, c); }
typedef __attribute__((ext_vector_type(4))) short bf16x4;
DEV f32x4 mfma16k16(bf16x4 a, bf16x4 b, f32x4 c) {
  bf16x8 a8 = {0, 0, 0, 0, 0, 0, 0, 0}, b8 = {0, 0, 0, 0, 0, 0, 0, 0};
  const int q = tl_cur->lane >> 4;
  EmuFiber* f = tl_cur; EmuWave& w = f->blk->waves[f->wave]; int par = w.gen & 1; int l = f->lane;
  for (int j = 0; j < 4; ++j) { w.mbuf[par][l].a[j] = a[j]; w.mbuf[par][l].b[j] = b[j]; }
  emu_wave_barrier();
  int col = l & 15; f32x4 d = c; (void)a8; (void)b8; (void)q;
  for (int r = 0; r < 4; ++r) { int row = 4 * (l >> 4) + r; float acc = c[r];
    for (int k = 0; k < 16; ++k) acc += emu_bf2f(w.mbuf[par][row + 16 * (k >> 2)].a[k & 3]) * emu_bf2f(w.mbuf[par][col + 16 * (k >> 2)].b[k & 3]);
    d[r] = acc; }
  return d;
}
DEV float u2f(unsigned u) { float f; memcpy(&f, &u, 4); return f; }
DEV unsigned f2u(float f) { unsigned u; memcpy(&u, &f, 4); return u; }
#define SYNC() __syncthreads()
#define GRID_SYNC() emu_grid_sync()
#define SMEM_DECL(name) unsigned char* name = EMU_SMEM_PTR()
DEV void glds16(const void* g, void* l) { memcpy(l, g, 16); }
DEV void glds_wait() {}
DEV void asm_wait_vm6() {}
DEV int tid_opaque() { return threadIdx.x; }
template <int CTRL> DEV float dpp_mov(float v) { const int l = tl_cur->lane; const int src = CTRL == 0xB1 ? (l ^ 1) : CTRL == 0x4E ? (l ^ 2) : ((l & ~7) | (7 - (l & 7))); return emu_shfl(v, src); }
#endif

#ifndef CFG_BATCH
#define CFG_BATCH 32
#endif
#ifndef CFG_SEQ
#define CFG_SEQ 256
#endif
#ifndef CFG_DEC_BATCH
#define CFG_DEC_BATCH 4
#endif
#ifndef CFG_DEC_SEQ
#define CFG_DEC_SEQ 4096
#endif
constexpr int D = 1024;
constexpr int NB_C = CFG_BATCH, L_C = CFG_SEQ, NB_L = CFG_DEC_BATCH, L_L = CFG_DEC_SEQ;
constexpr int NTOK_C = NB_C * L_C, NTOK_L = NB_L * L_L, NTOK = NTOK_C + NTOK_L;
constexpr int NSEQ = NB_C + NB_L;
constexpr int NCOND = 1 + NB_L;
constexpr int NT = 512;
constexpr int NW = NT / 64;
constexpr float EPS = 1e-6f;
constexpr int clog2(int n) { return n <= 1 ? 0 : 1 + clog2(n / 2); }
constexpr int LOG_NC = clog2(2 * L_C), LOG_NL = clog2(2 * L_L);
static_assert((1 << LOG_NC) == 2 * L_C && (1 << LOG_NL) == 2 * L_L, "pow2 seq");
static_assert(L_C % 256 == 0 && L_L % 256 == 0, "seq multiple of 256");
static_assert(NB_C % 2 == 0 && NB_L % 2 == 0, "even batches");
constexpr int ODIN_N = 4128, ODIN_NPAD = 4352;

typedef unsigned short bf16_t;
DEV float bf2f(bf16_t h) { return u2f(((unsigned)h) << 16); }
DEV bf16_t f2bf(float f) { unsigned u = f2u(f); u += 0x7fffu + ((u >> 16) & 1u); return (bf16_t)(u >> 16); }
DEV unsigned pack2(float a, float b) { return (unsigned)f2bf(a) | ((unsigned)f2bf(b) << 16); }
DEV float bflo(unsigned u) { return u2f(u << 16); }
DEV float bfhi(unsigned u) { return u2f(u & 0xffff0000u); }
DEV float silu_f(float x) { return x / (1.f + __expf(-x)); }
DEV float sigmoid_f(float x) { return 1.f / (1.f + __expf(-x)); }
DEV float gelu_f(float x) { float u = 0.7978845608028654f * (x + 0.044715f * x * x * x); float e = __expf(-2.f * fabsf(u)); float t = (1.f - e) / (1.f + e); t = u < 0.f ? -t : t; return 0.5f * x * (1.f + t); }
DEV float log_sigmoid_f(float x) { return fminf(x, 0.f) - log1pf(__expf(-fabsf(x))); }
DEV float sum8_dpp(float v) { v += dpp_mov<0xB1>(v); v += dpp_mov<0x4E>(v); v += dpp_mov<0x141>(v); return v; }
DEV float wave_sum(float v) { for (int m = 32; m >= 1; m >>= 1) v += __shfl_xor(v, m); return v; }
DEV float wave_max(float v) { for (int m = 32; m >= 1; m >>= 1) v = fmaxf(v, __shfl_xor(v, m)); return v; }

typedef __attribute__((ext_vector_type(2))) float f32x2_t;
#ifndef EMU
DEV f32x2_t fp8lo2(unsigned w) { return __builtin_amdgcn_cvt_pk_f32_fp8((int)w, false); }
DEV f32x2_t fp8hi2(unsigned w) { return __builtin_amdgcn_cvt_pk_f32_fp8((int)w, true); }
DEV int uniform_i(int v) { return __builtin_amdgcn_readfirstlane(v); }
DEV unsigned pack_fp8x4(float a, float b, float c, float d) {
  int r = __builtin_amdgcn_cvt_pk_fp8_f32(a, b, 0, false);
  r = __builtin_amdgcn_cvt_pk_fp8_f32(c, d, r, true);
  return (unsigned)r;
}
DEV void unpack_fp8x4(unsigned w, float* o) {
  f32x2_t lo = __builtin_amdgcn_cvt_pk_f32_fp8((int)w, false), hi = __builtin_amdgcn_cvt_pk_f32_fp8((int)w, true);
  o[0] = lo[0]; o[1] = lo[1]; o[2] = hi[0]; o[3] = hi[1];
}
DEV void wave_sync() { __builtin_amdgcn_wave_barrier(); }
DEV void wave_lds_fence() { __syncthreads(); }
#else
DEV unsigned emu_enc_fp8(float x) {
  unsigned sgn = x < 0.f ? 0x80u : 0u; float ax = fabsf(x);
  if (!(ax == ax)) return 0x7fu;
  if (ax >= 448.f) return sgn | 0x7eu;
  if (ax < 0.015625f) { int q = (int)nearbyintf(ax * 512.f); return sgn | (unsigned)(q >= 8 ? 0x08 : q); }
  int e; float fr = frexpf(ax, &e);
  e -= 1; float m = fr * 2.f - 1.f;
  int qm = (int)nearbyintf(m * 8.f);
  if (qm == 8) { qm = 0; e += 1; }
  unsigned b = (unsigned)((e + 7) << 3) | (unsigned)qm;
  if (b > 0x7eu) b = 0x7eu;
  return sgn | b;
}
DEV float emu_dec_fp8(unsigned b) {
  unsigned e = (b >> 3) & 15u, m = b & 7u; float v = e == 0 ? (float)m * 0.001953125f : ldexpf(1.f + (float)m * 0.125f, (int)e - 7);
  return (b & 0x80u) ? -v : v;
}
DEV unsigned pack_fp8x4(float a, float b, float c, float d) { return emu_enc_fp8(a) | (emu_enc_fp8(b) << 8) | (emu_enc_fp8(c) << 16) | (emu_enc_fp8(d) << 24); }
DEV void unpack_fp8x4(unsigned w, float* o) { for (int i = 0; i < 4; ++i) o[i] = emu_dec_fp8((w >> (8 * i)) & 255u); }
DEV f32x2_t fp8lo2(unsigned w) { f32x2_t r; r[0] = emu_dec_fp8(w & 255u); r[1] = emu_dec_fp8((w >> 8) & 255u); return r; }
DEV f32x2_t fp8hi2(unsigned w) { f32x2_t r; r[0] = emu_dec_fp8((w >> 16) & 255u); r[1] = emu_dec_fp8((w >> 24) & 255u); return r; }
DEV int uniform_i(int v) { return v; }
DEV void wave_sync() { emu_wave_barrier(); }
DEV void wave_lds_fence() { __syncthreads(); }
#endif
struct U4 { unsigned x, y, z, w; };
struct U2 { unsigned x, y; };
struct F4 { float x, y, z, w; };
struct F2 { float x, y; };
DEV U4 ld16(const void* p) { return *reinterpret_cast<const U4*>(p); }
DEV void st16(void* p, U4 v) { *reinterpret_cast<U4*>(p) = v; }
DEV U2 ld8(const void* p) { return *reinterpret_cast<const U2*>(p); }
DEV void st8(void* p, U2 v) { *reinterpret_cast<U2*>(p) = v; }
DEV F4 ldf4(const float* p) { return *reinterpret_cast<const F4*>(p); }
DEV void stf4(float* p, F4 v) { *reinterpret_cast<F4*>(p) = v; }
#ifndef EMU
DEV F4 ldf4_nt(const float* p) { const f32x4 t = __builtin_nontemporal_load(reinterpret_cast<const f32x4*>(p)); return F4{t[0], t[1], t[2], t[3]}; }
DEV void stf4_nt(float* p, F4 v) { const f32x4 t = {v.x, v.y, v.z, v.w}; __builtin_nontemporal_store(t, reinterpret_cast<f32x4*>(p)); }
DEV F2 ldf2_nt(const float* p) { const f32x2_t t = __builtin_nontemporal_load(reinterpret_cast<const f32x2_t*>(p)); return F2{t[0], t[1]}; }
DEV void stf2_nt(float* p, F2 v) { const f32x2_t t = {v.x, v.y}; __builtin_nontemporal_store(t, reinterpret_cast<f32x2_t*>(p)); }
DEV void sth_nt(bf16_t* p, bf16_t v) { __builtin_nontemporal_store(v, p); }
#else
DEV F4 ldf4_nt(const float* p) { return ldf4(p); }
DEV void stf4_nt(float* p, F4 v) { stf4(p, v); }
DEV F2 ldf2_nt(const float* p) { return *reinterpret_cast<const F2*>(p); }
DEV void stf2_nt(float* p, F2 v) { *reinterpret_cast<F2*>(p) = v; }
DEV void sth_nt(bf16_t* p, bf16_t v) { *p = v; }
#endif
DEV bf16x8 as_frag(U4 v) { bf16x8 r; memcpy(&r, &v, 16); return r; }
DEV bf16x8 as_frag2(U2 a, U2 b) { U4 v{a.x, a.y, b.x, b.y}; return as_frag(v); }
#ifndef EMU
typedef short v4s_t __attribute__((ext_vector_type(4)));
DEV U2 lds_tr_read(const bf16_t* p) {
  const v4s_t r = __builtin_amdgcn_ds_read_tr16_b64_v4i16((__attribute__((address_space(3))) v4s_t*)p);
  U2 o; memcpy(&o, &r, 8); return o;
}
#else
DEV U2 lds_tr_read(const bf16_t* p) {
  const unsigned long long a = (unsigned long long)(uintptr_t)p;
  const int lane = threadIdx.x & 63, i = lane & 15, gb = lane & 48;
  unsigned short e[4];
  for (int q = 0; q < 4; ++q) {
    const int src = gb + 4 * q + (i >> 2);
    const unsigned lo = (unsigned)__shfl((int)(unsigned)(a & 0xffffffffull), src), hi = (unsigned)__shfl((int)(unsigned)(a >> 32), src);
    const bf16_t* rp = (const bf16_t*)(uintptr_t)(((unsigned long long)hi << 32) | lo);
    e[q] = rp[i & 3];
  }
  return U2{(unsigned)e[0] | ((unsigned)e[1] << 16), (unsigned)e[2] | ((unsigned)e[3] << 16)};
}
#endif

DEV int row_seq(int r) { return r < NTOK_C ? r / L_C : NB_C + (r - NTOK_C) / L_L; }
DEV int row_pos(int r) { return r < NTOK_C ? r % L_C : (r - NTOK_C) % L_L; }
DEV int row_cond(int r) { return r < NTOK_C ? 0 : 1 + (r - NTOK_C) / L_L; }
DEV int seq_start(int s) { return s < NB_C ? s * L_C : NTOK_C + (s - NB_C) * L_L; }
DEV int seq_len(int s) { return s < NB_C ? L_C : L_L; }


#ifndef EMU
#define XB_TMO      128
#define XB_XCNT(j)  (256  + 64 * (j))
#define XB_XSUB(j)  (1280 + 64 * (j))
#define XB_XGEN(j)  (2304 + 64 * (j))
#define XB_TOP      3328
#define XB_TOPGEN   3392
#define XCD_BAR_WORDS 3456
#define XB_SPIN_CAP (1u << 22)
#define LAS __attribute__((address_space(3)))
DEV unsigned xb_ld(unsigned* p) { return __hip_atomic_load(p, __ATOMIC_RELAXED, __HIP_MEMORY_SCOPE_AGENT); }
DEV unsigned xb_add(unsigned* p, unsigned v) { return __hip_atomic_fetch_add(p, v, __ATOMIC_RELAXED, __HIP_MEMORY_SCOPE_AGENT); }
DEV unsigned xb_xcc_id() { return (unsigned)__builtin_amdgcn_s_getreg((3 << 11) | 20) & 0xFu; }
#define XB_SPIN(cond, bar) do { unsigned _sp = 0; while (cond) { __builtin_amdgcn_s_sleep(1); \
    if ((++_sp & 255u) == 0u) { if (xb_ld(&(bar)[XB_TMO])) break; if (_sp > XB_SPIN_CAP) { atomicAdd(&(bar)[XB_TMO], 1u); break; } } } } while (0)
struct XcdBarrier { unsigned* bar; unsigned x; volatile unsigned* st; };
DEV XcdBarrier xcd_barrier_post(unsigned* bar, volatile unsigned* st) {
  XcdBarrier b; b.bar = bar; b.x = xb_xcc_id(); b.st = st;
  if (threadIdx.x == 0) (void)xb_add(&bar[XB_XCNT(b.x)], 1u);
  return b;
}
DEV void xcd_barrier_complete(unsigned* bar, unsigned x, unsigned& nloc, unsigned& nx) {
  const unsigned G = gridDim.x * gridDim.y * gridDim.z;
  unsigned sum, cnt, mine, sp = 0u;
  for (;;) {
    sum = 0u; cnt = 0u; mine = 0u;
#pragma unroll
    for (unsigned j = 0; j < 16; ++j) { const unsigned c = xb_ld(&bar[XB_XCNT(j)]); sum += c; cnt += (c > 0u) ? 1u : 0u; mine = (j == x) ? c : mine; }
    if (sum == G) break;
    __builtin_amdgcn_s_sleep(1);
    if ((++sp & 255u) == 0u) { if (xb_ld(&bar[XB_TMO])) break; if (sp > XB_SPIN_CAP) { atomicAdd(&bar[XB_TMO], 1u); break; } }
  }
  nloc = mine > 0u ? mine : 1u; nx = cnt > 0u ? cnt : 1u;
}
DEV void xcd_barrier(const XcdBarrier& b) {
  asm volatile("s_waitcnt vmcnt(0)" ::: "memory");
  __syncthreads();
  if (threadIdx.x == 0) {
    unsigned* bar = b.bar;
    __builtin_amdgcn_s_waitcnt(0);
    unsigned nloc = b.st[0], nx = b.st[1];
    if (nloc == 0u) { xcd_barrier_complete(bar, b.x, nloc, nx); b.st[0] = nloc; b.st[1] = nx; }
    const unsigned old = xb_add(&bar[XB_XSUB(b.x)], 1u);
    const unsigned gen = old / nloc;
    if (old + 1u == (gen + 1u) * nloc) {
      __builtin_amdgcn_fence(__ATOMIC_RELEASE, "agent");
      asm volatile("s_waitcnt vmcnt(0)" ::: "memory");
      const unsigned og = xb_add(&bar[XB_TOP], 1u);
      const unsigned tg = og / nx;
      if (og + 1u == (tg + 1u) * nx) xb_add(&bar[XB_TOPGEN], 1u);
      else XB_SPIN(xb_ld(&bar[XB_TOPGEN]) == tg, bar);
      __builtin_amdgcn_fence(__ATOMIC_ACQUIRE, "agent");
      xb_add(&bar[XB_XGEN(b.x)], 1u);
      asm volatile("s_waitcnt vmcnt(0)" ::: "memory");
    } else {
      XB_SPIN(xb_ld(&bar[XB_XGEN(b.x)]) == gen, bar);
      __builtin_amdgcn_fence(__ATOMIC_ACQUIRE, "agent");
      asm volatile("s_waitcnt vmcnt(0)" ::: "memory");
    }
  }
  __syncthreads();
}
#else
#define XCD_BAR_WORDS 3456
struct XcdBarrier { int dummy; };
#endif

constexpr size_t al256(size_t x) { return (x + 255) & ~(size_t)255; }
constexpr size_t OFF_BAR = 0;
constexpr size_t SZ_BAR = 16384;
constexpr size_t OFF_QCNT = OFF_BAR + 14336;
constexpr size_t OFF_MOD = OFF_BAR + SZ_BAR;
constexpr size_t SZ_MOD = al256((size_t)2 * NCOND * 6144 * 4);
constexpr size_t OFF_WEVIN = OFF_MOD + SZ_MOD;
constexpr size_t OFF_WGLU = OFF_WEVIN + (size_t)2048 * 1024 * 2;
constexpr size_t OFF_WEVOUT = OFF_WGLU + (size_t)512 * 512 * 2;
constexpr size_t OFF_WODIN = OFF_WEVOUT + (size_t)1024 * 1024 * 2;
constexpr size_t OFF_WODOUT = OFF_WODIN + (size_t)ODIN_NPAD * 1024 * 2;
constexpr size_t OFF_WPKQ = OFF_WODOUT + (size_t)1024 * 1024 * 2;
constexpr size_t OFF_KEYS = OFF_WPKQ + (size_t)2 * 2048 * 1024 * 2;
constexpr size_t OFF_H2 = OFF_KEYS + (size_t)2 * 16 * 128 * 128 * 2;
constexpr size_t OFF_LAMB = OFF_H2 + al256((size_t)(L_C + L_L) * 64 * 4);
constexpr size_t OFF_LAMT = OFF_LAMB + (size_t)2 * 32 * 64 * 8;
constexpr size_t OFF_BBAR = OFF_LAMT + (size_t)2 * 32 * 64 * 8;
constexpr size_t OFF_CMT = OFF_BBAR + (size_t)2 * 32 * 64 * 16 * 8;
constexpr size_t OFF_BB16 = OFF_CMT + (size_t)2 * 32 * 16 * 128 * 2;
constexpr size_t OFF_X = OFF_BB16 + (size_t)2 * 32 * 128 * 16 * 2;
constexpr size_t OFF_TAB = OFF_X + (size_t)NTOK * 1024 * 4;
constexpr size_t SZ_TAB = (size_t)2 * 16384 * 1024 * 2;
constexpr size_t OFF_RA = OFF_TAB + SZ_TAB;
constexpr size_t SZ_RA = (size_t)NTOK * 1024 * 2;
constexpr size_t OFF_RB = OFF_RA + SZ_RA;
constexpr size_t SZ_RB = (size_t)NTOK * 4096 * 2 + (size_t)NTOK * 32 * 4;
constexpr size_t OFF_RC = OFF_RB + al256(SZ_RB);
constexpr int KF_N = 2 * L_C + 2 * L_L;
constexpr size_t SZ_KF = (size_t)512 * 2 * KF_N * 8;
constexpr size_t SZ_RC = SZ_KF > (size_t)NTOK * 1024 * 2 ? SZ_KF : (size_t)NTOK * 1024 * 2;
constexpr size_t OFF_S5C = OFF_RC + al256(SZ_RC);
constexpr size_t SZ_S5C = (size_t)(NTOK / 64) * 32 * 2 * 64 * 8;
constexpr size_t WS_TOTAL = OFF_S5C + SZ_S5C;
constexpr size_t OFF_PROJ0 = OFF_RB;
constexpr size_t OFF_HT3 = OFF_RB + (size_t)NTOK * 2048 * 2;
constexpr size_t OFF_HYT = OFF_HT3 + (size_t)3 * 512 * NTOK * 2;
constexpr size_t OFF_Q = OFF_RB;
constexpr size_t OFF_WF = OFF_RB;
constexpr size_t OFF_SV = OFF_RB + (size_t)NTOK * 2048 * 2;
constexpr size_t OFF_SI = OFF_SV + (size_t)NTOK * 256 * 4;
constexpr size_t OFF_PART = OFF_RB;
constexpr size_t OFF_EIDX = OFF_SI + (size_t)NTOK * 256;
constexpr size_t OFF_EGT = OFF_EIDX + (size_t)NTOK * 128 * 4;
static_assert(OFF_EGT + (size_t)NTOK * 128 * 4 <= OFF_RB + SZ_RB, "peer buffers fit region B");
static_assert((size_t)8 * NTOK * 128 * 4 <= (size_t)NTOK * 2048 * 2, "PART fits the Q buffer");
constexpr size_t OFF_PROJ1 = OFF_RB;
constexpr size_t OFF_GATES = OFF_RB + (size_t)NTOK * 4096 * 2;
constexpr size_t OFF_KF = OFF_RC;
constexpr size_t OFF_QC = OFF_RA;
constexpr size_t OFF_KC = OFF_RC;
static_assert((size_t)NTOK * 1024 * 2 <= SZ_RC, "Kc fits region C");
constexpr size_t OFF_GS = OFF_S5C;
static_assert((size_t)(NTOK / 128) * 8 * 2 * 3 * 128 * 4 <= SZ_S5C, "GS fits");
constexpr int HLD = 4096;
constexpr size_t OFF_YS5 = OFF_TAB;

struct Params {
  const float* in[45];
  float* out;
  unsigned char* ws;
};
enum { I_XP = 0, I_XS, I_S5RE, I_S5IM, I_MLC, I_MLN, I_MLM, I_C, I_CCTX, I_NORMG, I_ADAW, I_ADAB, I_FINALG, I_EVWIN,
       I_HYCW, I_HYCB, I_HYW1, I_HYB1, I_HYW2, I_HYB2, I_HYW3, I_HYFREQ, I_HYDECAY, I_HYBIAS, I_S5ARE, I_S5AIM, I_S5BRE,
       I_S5BIM, I_S5CRE, I_S5CIM, I_S5LOGSTEP, I_S5D, I_S5GLUW, I_S5GLUB, I_EVWOUT, I_ODWIN, I_ODGATEB, I_MLCW, I_MLCB,
       I_MLNORMG, I_ODWOUT, I_PKWQ, I_PKKEYS, I_PKU, I_PKV };
constexpr size_t OUT_Y = 0;
constexpr size_t OUT_S5RE = (size_t)NTOK * 1024;
constexpr size_t OUT_S5IM = OUT_S5RE + (size_t)NB_C * 2 * 32 * 64;
constexpr size_t OUT_MLC = OUT_S5IM + (size_t)NB_C * 2 * 32 * 64;
constexpr size_t OUT_MLN = OUT_MLC + (size_t)NB_C * 2 * 8 * 128 * 128;
constexpr size_t OUT_MLM = OUT_MLN + (size_t)NB_C * 2 * 8 * 128;
constexpr size_t OUT_TOTAL = OUT_MLM + (size_t)NB_C * 2 * 8;

template <typename T> DEV T* wsp(const Params& P, size_t off) { return reinterpret_cast<T*>(P.ws + off); }

DEV void job_transpose(const float* src, bf16_t* dst, int K, int N, int Npad, int tile, unsigned char* smem) {
  float* t = reinterpret_cast<float*>(smem);
  const int ntn = Npad / 64;
  const int k0 = (tile / ntn) * 64, n0 = (tile % ntn) * 64;
  const int tid = threadIdx.x;
#pragma unroll
  for (int i = 0; i < 2; ++i) {
    const int e = tid + i * NT, kk = e >> 4, n4 = (e & 15) * 4;
    F4 v = (n0 + n4 < N) ? ldf4(src + (size_t)(k0 + kk) * N + n0 + n4) : F4{0.f, 0.f, 0.f, 0.f};
    float* tp = t + kk * 65 + n4; tp[0] = v.x; tp[1] = v.y; tp[2] = v.z; tp[3] = v.w;
  }
  SYNC();
  {
    const int nn = tid >> 3, k8 = (tid & 7) * 8;
    const float* tp = t + k8 * 65 + nn;
    st16(dst + (size_t)(n0 + nn) * K + k0 + k8, U4{pack2(tp[0], tp[65]), pack2(tp[130], tp[195]), pack2(tp[260], tp[325]), pack2(tp[390], tp[455])});
  }
  SYNC();
}
DEV void job_convert(const float* src, bf16_t* dst, int tile) {
  size_t e = (size_t)tile * 4096 + (size_t)threadIdx.x * 8;
  F4 a = ldf4(src + e), b = ldf4(src + e + 4);
  st16(dst + e, U4{pack2(a.x, a.y), pack2(a.z, a.w), pack2(b.x, b.y), pack2(b.z, b.w)});
}
DEV void job_mod(const Params& P, int task, unsigned char* smem) {
  float* sc = reinterpret_cast<float*>(smem);
  float* part = sc + NCOND * 1024;
  const int l = task / 96, ct = task % 96;
  const int tid = threadIdx.x, lane = tid & 63, w = tid >> 6;
  for (int e = tid; e < NCOND * 1024; e += NT) {
    int cb = e >> 10, k = e & 1023;
    float c = cb == 0 ? P.in[I_CCTX][k] : P.in[I_C][(size_t)(cb - 1) * 1024 + k];
    sc[e] = silu_f(c);
  }
  SYNC();
  const int n = ct * 64 + lane;
  const float* wp = P.in[I_ADAW] + (size_t)l * 1024 * 6144 + (size_t)(w * 128) * 6144 + n;
  float acc[NCOND];
#pragma unroll
  for (int cb = 0; cb < NCOND; ++cb) acc[cb] = 0.f;
#pragma unroll 8
  for (int k = 0; k < 128; ++k) {
    float wv = wp[(size_t)k * 6144];
#pragma unroll
    for (int cb = 0; cb < NCOND; ++cb) acc[cb] += sc[cb * 1024 + w * 128 + k] * wv;
  }
#pragma unroll
  for (int cb = 0; cb < NCOND; ++cb) part[(w * NCOND + cb) * 64 + lane] = acc[cb];
  SYNC();
  if (tid < NCOND * 64) {
    const int cb = tid >> 6, ln = tid & 63;
    float s = P.in[I_ADAB][(size_t)l * 6144 + ct * 64 + ln];
#pragma unroll
    for (int ww = 0; ww < NW; ++ww) s += part[(ww * NCOND + cb) * 64 + ln];
    wsp<float>(P, OFF_MOD)[((size_t)l * NCOND + cb) * 6144 + ct * 64 + ln] = s;
  }
  SYNC();
}
DEV void job_xinit(const Params& P, int tile) {
  const int lane = threadIdx.x & 63, w = threadIdx.x >> 6;
  const int r = tile * 8 + w;
  float* X = wsp<float>(P, OFF_X) + (size_t)r * 1024;
  if (r < NTOK_C) {
    const float* src = P.in[I_XP] + (size_t)r * 1024;
    for (int i = 0; i < 4; ++i) stf4(X + i * 256 + lane * 4, ldf4(src + i * 256 + lane * 4));
  } else {
    const int rl = r - NTOK_C;
    const float* src = P.in[I_XS] + (size_t)rl * 1024;
    const int pos = rl % L_L;
    const float prow = (float)(pos / 64), pcol = (float)(pos % 64);
    for (int i = 0; i < 4; ++i) {
      int c0 = i * 256 + lane * 4;
      F4 v = ldf4(src + c0);
      float o[4] = {v.x, v.y, v.z, v.w};
#pragma unroll
      for (int j = 0; j < 4; ++j) {
        int c = c0 + j;
        int half = c >> 9, cc = c & 511;
        int isc = cc >> 8, fi = cc & 255;
        float omega = exp2f(-(float)fi * (13.287712379549449f / 256.f));
        float ang = (half ? pcol : prow) * omega;
        o[j] += isc ? cosf(ang) : sinf(ang);
      }
      stf4(X + c0, F4{o[0], o[1], o[2], o[3]});
    }
  }
}
DEV void job_h2(const Params& P, int tile) {
  const int lane = threadIdx.x & 63, w = threadIdx.x >> 6;
  const int gi = tile * 8 + w;
  const int L = gi < L_C ? L_C : L_L;
  const int i = gi < L_C ? gi : gi - L_C;
  const float t = (float)i / (float)L;
  float z = 0.f;
  if (lane == 0) z = t;
  else if (lane <= 32) {
    int b = (lane - 1) & 15;
    float band = 1e-4f + (float)b * ((15.f - 1e-4f) / 15.f);
    float ang = 6.283185307179586f * t * band;
    z = lane <= 16 ? cosf(ang) : sinf(ang);
  }
  const float* w1 = P.in[I_HYW1]; const float* w2 = P.in[I_HYW2];
  const float fr = P.in[I_HYFREQ][lane];
  float a = P.in[I_HYB1][lane];
  for (int j = 0; j < 33; ++j) a += __shfl(z, j) * w1[j * 64 + lane];
  float h1 = sinf(fr * a);
  float a2 = P.in[I_HYB2][lane];
  for (int j = 0; j < 64; ++j) a2 += __shfl(h1, j) * w2[j * 64 + lane];
  float h2 = sinf(fr * a2);
  wsp<float>(P, OFF_H2)[(gi < L_C ? (size_t)0 : (size_t)64 * L_C) + (size_t)lane * L + i] = h2;
}
DEV void job_s5p(const Params& P, int task) {
  const int dir = task >> 5, g = task & 31;
  const int p = threadIdx.x & 63, jg = threadIdx.x >> 6;
  const size_t ip = ((size_t)dir * 32 + g) * 64 + p;
  const float are = P.in[I_S5ARE][ip], aim = P.in[I_S5AIM][ip];
  const float dt = expf(P.in[I_S5LOGSTEP][dir * 32 + g]);
  const float mag = expf(are * dt);
  const float sn = sinf(aim * dt), cs = cosf(aim * dt);
  const float lre = mag * cs, lim = mag * sn;
  const float nre = lre - 1.f, nim = lim;
  const float den = are * are + aim * aim;
  const float fre = (nre * are + nim * aim) / den, fim = (nim * are - nre * aim) / den;
  if (jg == 0) {
    wsp<F2>(P, OFF_LAMB)[ip] = F2{lre, lim};
    float xr = lre, xi = lim;
    for (int s = 0; s < 6; ++s) { float nr = xr * xr - xi * xi, ni = 2.f * xr * xi; xr = nr; xi = ni; }
    wsp<F2>(P, OFF_LAMT)[ip] = F2{xr, xi};
  }
  for (int jj = 0; jj < 2; ++jj) {
    int j = jg * 2 + jj;
    float bre = P.in[I_S5BRE][ip * 16 + j], bim = P.in[I_S5BIM][ip * 16 + j];
    wsp<F2>(P, OFF_BBAR)[ip * 16 + j] = F2{fre * bre - fim * bim, fre * bim + fim * bre};
    { bf16_t* bb = wsp<bf16_t>(P, OFF_BB16) + (((size_t)dir * 32 + g) * 128 + 2 * p) * 16 + j; bb[0] = f2bf(fre * bre - fim * bim); bb[16] = f2bf(fre * bim + fim * bre); }
    size_t ic = (((size_t)dir * 32 + g) * 16 + j) * 64 + p;
    unsigned v = pack2(P.in[I_S5CRE][ic], -P.in[I_S5CIM][ic]);
    *reinterpret_cast<unsigned*>(wsp<bf16_t>(P, OFF_CMT) + (((size_t)dir * 32 + g) * 16 + j) * 128 + 2 * p) = v;
  }
}

constexpr int J0_EVIN = 0;
constexpr int J0_GLU = J0_EVIN + 16 * 32;
constexpr int J0_EVOUT = J0_GLU + 8 * 8;
constexpr int J0_ODIN = J0_EVOUT + 16 * 16;
constexpr int J0_ODOUT = J0_ODIN + 16 * (ODIN_NPAD / 64);
constexpr int J0_PKQ0 = J0_ODOUT + 16 * 16;
constexpr int J0_PKQ1 = J0_PKQ0 + 16 * 32;
constexpr int J0_KEYS = J0_PKQ1 + 16 * 32;
constexpr int J0_MOD = J0_KEYS + 128;
constexpr int J0_XINIT = J0_MOD + 2 * 96;
constexpr int J0_H2 = J0_XINIT + NTOK / 8;
constexpr int J0_S5P = J0_H2 + (L_C + L_L) / 8;
constexpr int J0_END = J0_S5P + 64;
constexpr int TAB_TILES = 2 * 16384 / 8;
constexpr size_t OFF_TAB8 = OFF_TAB;
constexpr size_t OFF_RSC = OFF_TAB + (size_t)2 * 16384 * 1024;
DEV void job_tab(const Params& P, int layer, int t) {
  const int lane = threadIdx.x & 63, w = threadIdx.x >> 6;
  const int row = t * 8 + w;
  const int which = row >> 14, r = row & 16383;
  const float* src = P.in[which ? I_PKV : I_PKU] + ((size_t)layer * 16384 + r) * 1024 + lane * 4;
  F4 v[4]; float am = 0.f;
#pragma unroll
  for (int i = 0; i < 4; ++i) { v[i] = ldf4_nt(src + i * 256); am = fmaxf(am, fmaxf(fmaxf(fabsf(v[i].x), fabsf(v[i].y)), fmaxf(fabsf(v[i].z), fabsf(v[i].w)))); }
  am = wave_max(am);
  const float sc = am > 0.f ? 240.f / am : 1.f;
  unsigned char* dst = wsp<unsigned char>(P, OFF_TAB8) + (size_t)which * 16384 * 1024 + (size_t)(lane >> 5) * (16384 * 128) + (size_t)r * 128 + (lane & 31) * 4;
#pragma unroll
  for (int i = 0; i < 4; ++i)
    *reinterpret_cast<unsigned*>(dst + (size_t)(2 * i) * (16384 * 128)) = pack_fp8x4(v[i].x * sc, v[i].y * sc, v[i].z * sc, v[i].w * sc);
  if (lane == 0) wsp<float>(P, OFF_RSC)[row] = am > 0.f ? am / 240.f : 1.f;
}

DEV void phase_prep(const Params& P, unsigned char* smem) {
  for (int t = blockIdx.x; t < J0_END; t += gridDim.x) {
    if (t < J0_GLU) job_transpose(P.in[I_EVWIN], wsp<bf16_t>(P, OFF_WEVIN), 1024, 2048, 2048, t - J0_EVIN, smem);
    else if (t < J0_EVOUT) job_transpose(P.in[I_S5GLUW], wsp<bf16_t>(P, OFF_WGLU), 512, 512, 512, t - J0_GLU, smem);
    else if (t < J0_ODIN) job_transpose(P.in[I_EVWOUT], wsp<bf16_t>(P, OFF_WEVOUT), 1024, 1024, 1024, t - J0_EVOUT, smem);
    else if (t < J0_ODOUT) job_transpose(P.in[I_ODWIN], wsp<bf16_t>(P, OFF_WODIN), 1024, ODIN_N, ODIN_NPAD, t - J0_ODIN, smem);
    else if (t < J0_PKQ0) job_transpose(P.in[I_ODWOUT], wsp<bf16_t>(P, OFF_WODOUT), 1024, 1024, 1024, t - J0_ODOUT, smem);
    else if (t < J0_KEYS) job_convert(P.in[I_PKWQ], wsp<bf16_t>(P, OFF_WPKQ), t - J0_PKQ0);
    else if (t < J0_MOD) job_convert(P.in[I_PKKEYS], wsp<bf16_t>(P, OFF_KEYS), t - J0_KEYS);
    else if (t < J0_XINIT) job_mod(P, t - J0_MOD, smem);
    else if (t < J0_H2) job_xinit(P, t - J0_XINIT);
    else if (t < J0_S5P) job_h2(P, t - J0_H2);
    else job_s5p(P, t - J0_S5P);
  }
}

DEV void phase_norm(const Params& P, int layer, int which, bool with_tab) {
  const int lane = threadIdx.x & 63, w = threadIdx.x >> 6;
  const float* X = wsp<float>(P, OFF_X);
  bf16_t* XN = wsp<bf16_t>(P, OFF_RA);
  const float* g = P.in[I_NORMG] + ((size_t)layer * 2 + which) * 1024;
  F4 gg[4], sh[4], sc[4];
#pragma unroll
  for (int i = 0; i < 4; ++i) gg[i] = ldf4(g + i * 256 + lane * 4);
  int ccur = -1;
  if (with_tab && !(w & 1)) for (int t = blockIdx.x; t < TAB_TILES; t += gridDim.x) job_tab(P, layer, t);
  for (int r = blockIdx.x * NW + w; r < NTOK; r += gridDim.x * NW) {
    const float* x = X + (size_t)r * 1024;
    const int cd = row_cond(r);
    if (cd != ccur) {
      const float* mod = wsp<float>(P, OFF_MOD) + ((size_t)layer * NCOND + cd) * 6144 + (which ? 3 * 1024 : 0);
#pragma unroll
      for (int i = 0; i < 4; ++i) { sh[i] = ldf4(mod + i * 256 + lane * 4); sc[i] = ldf4(mod + 1024 + i * 256 + lane * 4); }
      ccur = cd;
    }
    F4 v[4]; float ss = 0.f;
#pragma unroll
    for (int i = 0; i < 4; ++i) { v[i] = ldf4(x + i * 256 + lane * 4); ss += v[i].x * v[i].x + v[i].y * v[i].y + v[i].z * v[i].z + v[i].w * v[i].w; }
    ss = wave_sum(ss);
    const float rs = rsqrtf(ss * (1.f / 1024.f) + EPS);
#pragma unroll
    for (int i = 0; i < 4; ++i) {
      int c = i * 256 + lane * 4;
      float o0 = v[i].x * rs * gg[i].x * (1.f + sc[i].x) + sh[i].x, o1 = v[i].y * rs * gg[i].y * (1.f + sc[i].y) + sh[i].y;
      float o2 = v[i].z * rs * gg[i].z * (1.f + sc[i].z) + sh[i].z, o3 = v[i].w * rs * gg[i].w * (1.f + sc[i].w) + sh[i].w;
      st8(XN + (size_t)r * 1024 + c, U2{pack2(o0, o1), pack2(o2, o3)});
    }
  }
  if (with_tab && (w & 1)) for (int t = blockIdx.x; t < TAB_TILES; t += gridDim.x) job_tab(P, layer, t);
}

DEV void cswap_desc(float& a, float& b) { const float hi = fmaxf(a, b), lo = fminf(a, b); a = hi; b = lo; }
DEV void bitonic_sort16_desc(float* v) {
#pragma unroll
  for (int k = 2; k <= 16; k <<= 1)
#pragma unroll
    for (int jj = k >> 1; jj >= 1; jj >>= 1)
#pragma unroll
      for (int i = 0; i < 16; ++i) {
        const int l = i ^ jj;
        if (l > i) { if ((i & k) == 0) cswap_desc(v[i], v[l]); else cswap_desc(v[l], v[i]); }
      }
}
DEV void sort16_net_desc(float* v) {
#define CS(i, j) cswap_desc(v[i], v[j])
  CS(0, 13); CS(1, 12); CS(2, 15); CS(3, 14); CS(4, 8); CS(5, 6); CS(7, 11); CS(9, 10);
  CS(0, 5); CS(1, 7); CS(2, 9); CS(3, 4); CS(6, 13); CS(8, 14); CS(10, 15); CS(11, 12);
  CS(0, 1); CS(2, 3); CS(4, 5); CS(6, 8); CS(7, 9); CS(10, 11); CS(12, 13); CS(14, 15);
  CS(0, 2); CS(1, 3); CS(4, 10); CS(5, 11); CS(6, 7); CS(8, 9); CS(12, 14); CS(13, 15);
  CS(1, 2); CS(3, 12); CS(4, 6); CS(5, 7); CS(8, 10); CS(9, 11); CS(13, 14);
  CS(1, 4); CS(2, 6); CS(5, 8); CS(7, 10); CS(9, 13); CS(11, 14);
  CS(2, 4); CS(3, 6); CS(9, 12); CS(11, 13);
  CS(3, 5); CS(6, 8); CS(7, 9); CS(10, 12);
  CS(3, 4); CS(5, 6); CS(7, 8); CS(9, 10); CS(11, 12);
  CS(6, 7); CS(8, 9);
#undef CS
}
DEV void bitonic_merge16_desc(float* v) {
#pragma unroll
  for (int jj = 8; jj >= 1; jj >>= 1)
#pragma unroll
    for (int i = 0; i < 16; ++i) { const int l = i ^ jj; if (l > i) cswap_desc(v[i], v[l]); }
}
DEV float pack_key(float v, int idx) { return u2f((f2u(v) & 0xffffff80u) | (unsigned)(127 - idx)); }
struct EpiTopk { unsigned short* EIDX; bf16_t* EGT;
  DEVM bf16_t* stage_base(int, int) const { return nullptr; }
  DEVM int stage_ld() const { return 0; }
  DEVM void operator()(int, int, f32x4) const {} };
template <class E> struct IsTopk { static constexpr bool value = false; };
template <> struct IsTopk<EpiTopk> { static constexpr bool value = true; };
DEV void topk_rows(const float* S, float* best, int tid) {
  const int lane = tid & 63, w = tid >> 6;
  const int row = 32 * w + (lane & 31), half = lane >> 5;
  const float* sr = S + row * 129 + half * 64;
#pragma unroll
  for (int g = 0; g < 4; ++g) {
    float v[16];
#pragma unroll
    for (int i = 0; i < 16; ++i) v[i] = pack_key(sr[g * 16 + i], half * 64 + g * 16 + i);
    sort16_net_desc(v);
    if (g == 0) {
#pragma unroll
      for (int i = 0; i < 16; ++i) best[i] = v[i];
    } else {
#pragma unroll
      for (int i = 0; i < 16; ++i) best[i] = fmaxf(best[i], v[15 - i]);
      bitonic_merge16_desc(best);
    }
  }
  float oth[16];
#pragma unroll
  for (int i = 0; i < 16; ++i) oth[i] = __shfl_xor(best[15 - i], 32);
#pragma unroll
  for (int i = 0; i < 16; ++i) best[i] = fmaxf(best[i], oth[i]);
  bitonic_merge16_desc(best);
}
template <int ST>
DEV void route_row(const float* ka, const float* kb, float* sb, unsigned char* ia, unsigned char* ib, int col, unsigned short* EI, bf16_t* GT, int head) {
  float* ct = reinterpret_cast<float*>(ib + 16 * ST);
  float a[8];
  const float b0 = u2f(f2u(kb[0]) & 0xffffff80u);
#pragma unroll
  for (int i = 0; i < 16; ++i) {
    const unsigned ua = f2u(ka[i]), ub = f2u(kb[i]);
    const float av = u2f(ua & 0xffffff80u);
    if (i < 8) a[i] = av; else ct[(i - 8) * ST + col] = av + b0;
    sb[i * ST + col] = u2f(ub & 0xffffff80u);
    ia[i * ST + col] = (unsigned char)(127u - (ua & 127u)); ib[i * ST + col] = (unsigned char)(127u - (ub & 127u));
  }
  ct[8 * ST + col] = -3.0e38f;
  float cur[8];
#pragma unroll
  for (int i = 0; i < 8; ++i) cur[i] = a[i] + b0;
  float curT = ct[col];
  int tp = 0;
  unsigned jp = 0u;
  float best[16]; int ex[16];
#pragma unroll
  for (int o2 = 0; o2 < 16; ++o2) {
    float bv = cur[0]; int bi = 0;
#pragma unroll
    for (int i = 1; i < 8; ++i) if (cur[i] > bv) { bv = cur[i]; bi = i; }
    const bool tail = curT > bv;
    best[o2] = tail ? curT : bv;
    const int j = (int)((jp >> (4 * bi)) & 15u);
    const int ra = tail ? 8 + tp : bi, cb = tail ? 0 : j;
    ex[o2] = (int)ia[ra * ST + col] * 128 + (int)ib[cb * ST + col];
    const int jn = j + 1;
    float nv = -3.0e38f;
    if ((bi + 1) * (jn + 1) <= 16) {
      float av = a[0];
#pragma unroll
      for (int i = 1; i < 8; ++i) av = (i == bi) ? a[i] : av;
      nv = av + sb[(jn & 15) * ST + col];
    }
    const int tq = tp + 1 < 8 ? tp + 1 : 8;
    const float nt = ct[tq * ST + col];
    const int bsel = tail ? 8 : bi;
#pragma unroll
    for (int i = 0; i < 8; ++i) cur[i] = (i == bsel) ? nv : cur[i];
    jp += tail ? 0u : (1u << (4 * bi));
    curT = tail ? nt : curT; tp = tail ? tq : tp;
  }
  float sum = 0.f;
  const float bmax = best[0];
#pragma unroll
  for (int o2 = 0; o2 < 16; ++o2) { best[o2] = __expf(best[o2] - bmax); sum += best[o2]; }
  const float inv = 1.f / sum;
#pragma unroll
  for (int o2 = 0; o2 < 16; ++o2) {
    const int pos = (o2 & 7) * 16 + head * 2 + (o2 >> 3);
    EI[pos] = (unsigned short)ex[o2]; GT[pos] = f2bf(best[o2] * inv);
  }
}

constexpr int G_BM = 256, G_BK = 64;
template <int BN, class Epi>
DEV void gemm_tile(const bf16_t* A, int lda, const bf16_t* Bt, int ldb, int K, int m0, int n0, Epi& epi, unsigned char* smem) {
  constexpr int BUFB = (G_BM + BN) * 128;
  constexpr int NST = BN == 256 ? 2 : 3;
  constexpr int MI = BN == 256 ? 8 : 4;
  constexpr int NBP = BN / 64;
  const int tid = threadIdx.x, lane = tid & 63, w = tid >> 6;
  const int wm = BN == 256 ? (w >> 2) : (w >> 1), wn = BN == 256 ? (w & 3) : (w & 1);
  const int lr = lane & 15, lq = lane >> 4;
  f32x4 acc[MI][4];
#pragma unroll
  for (int i = 0; i < MI; ++i)
#pragma unroll
    for (int j = 0; j < 4; ++j) acc[i][j] = f32x4{0.f, 0.f, 0.f, 0.f};
  const int prow = lane >> 3, pslot = (lane & 7) ^ prow;
  auto stage = [&](unsigned char* buf, int k0) {
#pragma unroll
    for (int i = 0; i < 4; ++i) {
      const int piece = w * 4 + i;
      glds16(A + (size_t)(m0 + piece * 8 + prow) * lda + k0 + pslot * 8, buf + piece * 1024 + lane * 16);
    }
#pragma unroll
    for (int i = 0; i < NBP; ++i) {
      const int piece = w * NBP + i;
      glds16(Bt + (size_t)(n0 + piece * 8 + prow) * ldb + k0 + pslot * 8, buf + G_BM * 128 + piece * 1024 + lane * 16);
    }
  };
  auto compute = [&](const unsigned char* As) {
    const unsigned char* Bs = As + G_BM * 128;
#pragma unroll
    for (int kk = 0; kk < 2; ++kk) {
      bf16x8 fa[MI], fb[4];
#pragma unroll
      for (int j = 0; j < 4; ++j) {
        const int r = IsTopk<Epi>::value ? (j >> 1) * 128 + wn * 32 + (j & 1) * 16 + lr : wn * 64 + j * 16 + lr;
        fb[j] = as_frag(ld16(Bs + r * 128 + (((kk * 4 + lq) ^ (r & 7)) << 4)));
      }
#pragma unroll
      for (int i = 0; i < MI; ++i) { const int r = wm * (16 * MI) + i * 16 + lr; fa[i] = as_frag(ld16(As + r * 128 + (((kk * 4 + lq) ^ (r & 7)) << 4))); }
#pragma unroll
      for (int i = 0; i < MI; ++i)
#pragma unroll
        for (int j = 0; j < 4; ++j) acc[i][j] = mfma16(fb[j], fa[i], acc[i][j]);
    }
  };
  const int nk = K / G_BK;
  SYNC();
#pragma unroll
  for (int p = 0; p < NST - 1; ++p) if (p < nk) stage(smem + p * BUFB, p * G_BK);
  for (int kt = 0; kt < nk; ++kt) {
    if (NST == 3 && kt + 1 < nk) asm_wait_vm6(); else glds_wait();
    SYNC();
    SYNC();
    if (kt + NST - 1 < nk) stage(smem + ((kt + NST - 1) % NST) * BUFB, (kt + NST - 1) * G_BK);
    compute(smem + (kt % NST) * BUFB);
  }
  SYNC();
  if constexpr (IsTopk<Epi>::value) {
    static_assert(BN == 256, "top-k epilogue needs the 256-wide tile");
    float* S = reinterpret_cast<float*>(smem);
    const int te = tid, le = lane, we = w;
    float* pw = S + (wm * (16 * MI) + lr) * 129 + wn * 32 + lq * 4;
    float ka[16], kb[16];
#pragma unroll
    for (int i = 0; i < MI; ++i)
#pragma unroll
      for (int j = 0; j < 2; ++j) {
        float* p = pw + i * 16 * 129 + j * 16;
        p[0] = acc[i][j][0]; p[1] = acc[i][j][1]; p[2] = acc[i][j][2]; p[3] = acc[i][j][3];
      }
    SYNC();
    topk_rows(S, ka, te);
    SYNC();
#pragma unroll
    for (int i = 0; i < MI; ++i)
#pragma unroll
      for (int j = 0; j < 2; ++j) {
        float* p = pw + i * 16 * 129 + j * 16;
        p[0] = acc[i][2 + j][0]; p[1] = acc[i][2 + j][1]; p[2] = acc[i][2 + j][2]; p[3] = acc[i][2 + j][3];
      }
    SYNC();
    topk_rows(S, kb, te);
    SYNC();
    if (le < 32) {
      const int col = we * 32 + le;
      float* sb = reinterpret_cast<float*>(smem);
      unsigned char* ia = smem + 16 * 256 * 4;
      unsigned char* ib = ia + 16 * 256;
      route_row<256>(ka, kb, sb, ia, ib, col, epi.EIDX + (size_t)(m0 + col) * 128, epi.EGT + (size_t)(m0 + col) * 128, n0 >> 8);
    }
    return;
  }
  bf16_t* sbase = epi.stage_base(n0, BN);
  if (sbase != nullptr) {
    bf16_t* T = reinterpret_cast<bf16_t*>(smem) + (size_t)w * (16 * MI) * 68;
#pragma unroll
    for (int i = 0; i < MI; ++i)
#pragma unroll
      for (int j = 0; j < 4; ++j) st8(T + (i * 16 + lr) * 68 + j * 16 + lq * 4, U2{pack2(acc[i][j][0], acc[i][j][1]), pack2(acc[i][j][2], acc[i][j][3])});
    wave_lds_fence();
    const int ldc = epi.stage_ld();
    bf16_t* dst = sbase + (size_t)(m0 + wm * (16 * MI)) * ldc + n0 + wn * 64;
#pragma unroll
    for (int p = 0; p < 2 * MI; ++p) {
      const int r = p * 8 + (lane >> 3), c8 = (lane & 7) * 8;
      const U2 a = ld8(T + r * 68 + c8), b = ld8(T + r * 68 + c8 + 4);
      st16(dst + (size_t)r * ldc + c8, U4{a.x, a.y, b.x, b.y});
    }
  } else {
#pragma unroll
    for (int i = 0; i < MI; ++i)
#pragma unroll
      for (int j = 0; j < 4; ++j) epi(m0 + wm * (16 * MI) + i * 16 + lr, n0 + wn * 64 + j * 16 + lq * 4, acc[i][j]);
  }
  SYNC();
}
#ifndef EMU
#define G8_BAR() __builtin_amdgcn_s_barrier()
#define G8_WAIT_V(n) asm volatile("s_waitcnt vmcnt(" #n ")" ::: "memory")
#define G8_WAIT_L(n) asm volatile("s_waitcnt lgkmcnt(" #n ")" ::: "memory")
#define G8_SCHED() __builtin_amdgcn_sched_barrier(0)
#define G8_PRIO(p) __builtin_amdgcn_s_setprio(p)
#else
#define G8_BAR() SYNC()
#define G8_WAIT_V(n) do {} while (0)
#define G8_WAIT_L(n) do {} while (0)
#define G8_SCHED() do {} while (0)
#define G8_PRIO(p) do {} while (0)
#endif
DEV int g8_lds_byte(int r, int c) { const int st = (r >> 4) * 2 + (c >> 5), rr = r & 15, cc = c & 31, ob = rr * 64 + cc * 2; return st * 1024 + (ob ^ (((ob >> 9) & 1) << 5)); }
DEV void g8_stage_rc(int b, int& R, int& C) { const int st = b / 1024, sb = b % 1024, swz = sb ^ (((sb >> 9) & 1) << 5); R = (st >> 1) * 16 + swz / 64; C = (st & 1) * 32 + (swz % 64) / 2; }
template <class Epi>
DEV void gemm8_tile(const bf16_t* A, const bf16_t* Bt, int brow, int bcol, Epi& epi, unsigned char* smem) {
  constexpr int LD = 1024, HT = 128 * 64, NTK = LD / 64;
  const int tid = threadIdx.x, wid = tid >> 6, lane = tid & 63, wr = wid >> 2, wc = wid & 3, fr = lane & 15, fq = lane >> 4;
  bf16_t* shm = reinterpret_cast<bf16_t*>(smem);
#define G8_SA(b, h) (shm + ((b) * 2 + (h)) * HT)
#define G8_SB(b, h) (shm + (4 + (b) * 2 + (h)) * HT)
#ifndef EMU
  const int ldst = uniform_i((tid >> 6) * 1024);
#else
  const int ldst = tid * 16;
#endif
  unsigned voff[2];
#pragma unroll
  for (int i = 0; i < 2; ++i) { int r_, c_; g8_stage_rc(tid * 16 + i * 8192, r_, c_); voff[i] = (unsigned)(r_ * LD + c_) * 2u; }
#define G8_STAGE(PP, BASE, br, kt) do { \
    const unsigned char* _gb = reinterpret_cast<const unsigned char*>(BASE) + ((size_t)(br) * LD + (size_t)(kt) * 64) * 2; \
    _Pragma("unroll") for (int _i = 0; _i < 2; ++_i) glds16(_gb + voff[_i], reinterpret_cast<unsigned char*>(PP) + ldst + _i * 8192); } while (0)
#define G8_LDA(dst, b, h) do { _Pragma("unroll") for (int m = 0; m < 4; ++m) _Pragma("unroll") for (int k = 0; k < 2; ++k) \
    dst[m][k] = *reinterpret_cast<const bf16x8*>(reinterpret_cast<const unsigned char*>(G8_SA(b, h)) + g8_lds_byte(wr * 64 + m * 16 + fr, k * 32 + fq * 8)); } while (0)
#define G8_LDB(dst, b, h) do { _Pragma("unroll") for (int n = 0; n < 2; ++n) _Pragma("unroll") for (int k = 0; k < 2; ++k) \
    dst[n][k] = *reinterpret_cast<const bf16x8*>(reinterpret_cast<const unsigned char*>(G8_SB(b, h)) + g8_lds_byte(wc * 32 + n * 16 + fr, k * 32 + fq * 8)); } while (0)
#define G8_MMA(ai, bj, AT, BT) do { G8_PRIO(1); \
    _Pragma("unroll") for (int m = 0; m < 4; ++m) _Pragma("unroll") for (int n = 0; n < 2; ++n) _Pragma("unroll") for (int k = 0; k < 2; ++k) \
      acc[ai][bj][m][n] = mfma16(BT[n][k], AT[m][k], acc[ai][bj][m][n]); \
    G8_PRIO(0); } while (0)
  f32x4 acc[2][2][4][2];
#pragma unroll
  for (int a = 0; a < 2; ++a)
#pragma unroll
    for (int b = 0; b < 2; ++b)
#pragma unroll
      for (int m = 0; m < 4; ++m)
#pragma unroll
        for (int n = 0; n < 2; ++n) acc[a][b][m][n] = f32x4{0.f, 0.f, 0.f, 0.f};
  bf16x8 At[4][2], B0[2][2], B1[2][2];
  SYNC();
  G8_STAGE(G8_SB(0, 0), Bt, bcol, 0); G8_STAGE(G8_SA(0, 0), A, brow, 0);
  G8_STAGE(G8_SB(0, 1), Bt, bcol + 128, 0); G8_STAGE(G8_SA(0, 1), A, brow + 128, 0);
  if (wr == 1) G8_BAR();
  G8_WAIT_V(4); G8_BAR();
  G8_STAGE(G8_SB(1, 0), Bt, bcol, 1); G8_STAGE(G8_SA(1, 0), A, brow, 1); G8_STAGE(G8_SB(1, 1), Bt, bcol + 128, 1);
  G8_WAIT_V(6); G8_BAR();
#pragma unroll 1
  for (int t = 0; t < NTK - 2; t += 2) {
    G8_LDB(B0, 0, 0); G8_SCHED(); G8_LDA(At, 0, 0); G8_STAGE(G8_SA(1, 1), A, brow + 128, t + 1);
    G8_WAIT_L(8); G8_BAR(); G8_WAIT_L(0); G8_MMA(0, 0, At, B0); G8_BAR(); G8_SCHED();
    G8_LDB(B1, 0, 1); G8_STAGE(G8_SB(0, 0), Bt, bcol, t + 2);
    G8_BAR(); G8_WAIT_L(0); G8_MMA(0, 1, At, B1); G8_BAR();
    G8_LDA(At, 0, 1); G8_STAGE(G8_SA(0, 0), A, brow, t + 2);
    G8_BAR(); G8_WAIT_L(0); G8_MMA(1, 0, At, B0); G8_BAR(); G8_SCHED();
    G8_STAGE(G8_SB(0, 1), Bt, bcol + 128, t + 2);
    G8_WAIT_V(6); G8_BAR(); G8_MMA(1, 1, At, B1); G8_BAR();
    G8_LDB(B0, 1, 0); G8_SCHED(); G8_LDA(At, 1, 0); G8_STAGE(G8_SA(0, 1), A, brow + 128, t + 2);
    G8_WAIT_L(8); G8_BAR(); G8_WAIT_L(0); G8_MMA(0, 0, At, B0); G8_BAR(); G8_SCHED();
    G8_LDB(B1, 1, 1); G8_STAGE(G8_SB(1, 0), Bt, bcol, t + 3);
    G8_BAR(); G8_WAIT_L(0); G8_MMA(0, 1, At, B1); G8_BAR();
    G8_LDA(At, 1, 1); G8_STAGE(G8_SA(1, 0), A, brow, t + 3);
    G8_BAR(); G8_WAIT_L(0); G8_MMA(1, 0, At, B0); G8_BAR(); G8_SCHED();
    G8_STAGE(G8_SB(1, 1), Bt, bcol + 128, t + 3);
    G8_WAIT_V(6); G8_BAR(); G8_MMA(1, 1, At, B1); G8_BAR();
  }
  { G8_LDB(B0, 0, 0); G8_LDA(At, 0, 0); G8_STAGE(G8_SA(1, 1), A, brow + 128, NTK - 1);
    G8_BAR(); G8_WAIT_L(0); G8_MMA(0, 0, At, B0); G8_BAR();
    G8_LDB(B1, 0, 1); G8_BAR(); G8_WAIT_L(0); G8_MMA(0, 1, At, B1); G8_BAR();
    G8_LDA(At, 0, 1); G8_WAIT_V(4); G8_BAR(); G8_WAIT_L(0); G8_MMA(1, 0, At, B0); G8_MMA(1, 1, At, B1); G8_BAR(); }
  { G8_LDB(B0, 1, 0); G8_LDA(At, 1, 0); G8_WAIT_V(2); G8_BAR(); G8_WAIT_L(0); G8_MMA(0, 0, At, B0); G8_BAR();
    G8_LDB(B1, 1, 1); G8_WAIT_V(0); G8_BAR(); G8_WAIT_L(0); G8_MMA(0, 1, At, B1); G8_BAR();
    G8_LDA(At, 1, 1); G8_BAR(); G8_WAIT_L(0); G8_MMA(1, 0, At, B0); G8_MMA(1, 1, At, B1); G8_BAR(); }
  if (wr == 0) G8_BAR();
#undef G8_SA
#undef G8_SB
#undef G8_STAGE
#undef G8_LDA
#undef G8_LDB
#undef G8_MMA
  SYNC();
  const int te = tid_opaque(), wie = te >> 6, lae = te & 63, wre = wie >> 2, wce = wie & 3, fre = lae & 15, fqe = lae >> 4;
  if constexpr (IsTopk<Epi>::value) {
    float* S = reinterpret_cast<float*>(smem);
    float* pw = S + (wre * 64 + fre) * 129 + wce * 32 + fqe * 4;
    float ka[16], kb[16];
#pragma unroll
    for (int ai = 0; ai < 2; ++ai)
#pragma unroll
      for (int m = 0; m < 4; ++m)
#pragma unroll
        for (int n = 0; n < 2; ++n) {
          float* p = pw + (ai * 128 + m * 16) * 129 + n * 16;
          p[0] = acc[ai][0][m][n][0]; p[1] = acc[ai][0][m][n][1]; p[2] = acc[ai][0][m][n][2]; p[3] = acc[ai][0][m][n][3];
        }
    SYNC();
    topk_rows(S, ka, te);
    SYNC();
#pragma unroll
    for (int ai = 0; ai < 2; ++ai)
#pragma unroll
      for (int m = 0; m < 4; ++m)
#pragma unroll
        for (int n = 0; n < 2; ++n) {
          float* p = pw + (ai * 128 + m * 16) * 129 + n * 16;
          p[0] = acc[ai][1][m][n][0]; p[1] = acc[ai][1][m][n][1]; p[2] = acc[ai][1][m][n][2]; p[3] = acc[ai][1][m][n][3];
        }
    SYNC();
    topk_rows(S, kb, te);
    SYNC();
    if (lae < 32) {
      const int col = wie * 32 + lae;
      float* sb = reinterpret_cast<float*>(smem);
      unsigned char* ia = smem + 16 * 256 * 4;
      unsigned char* ib = ia + 16 * 256;
      route_row<256>(ka, kb, sb, ia, ib, col, epi.EIDX + (size_t)(brow + col) * 128, epi.EGT + (size_t)(brow + col) * 128, bcol >> 8);
    }
    return;
  }
  bf16_t* sbase = epi.stage_base(bcol, 256);
  if (sbase != nullptr) {
    bf16_t* T = reinterpret_cast<bf16_t*>(smem);
#pragma unroll
    for (int ai = 0; ai < 2; ++ai)
#pragma unroll
      for (int bj = 0; bj < 2; ++bj)
#pragma unroll
        for (int m = 0; m < 4; ++m)
#pragma unroll
          for (int n = 0; n < 2; ++n)
            st8(T + (ai * 128 + wre * 64 + m * 16 + fre) * 264 + bj * 128 + wce * 32 + n * 16 + fqe * 4,
                U2{pack2(acc[ai][bj][m][n][0], acc[ai][bj][m][n][1]), pack2(acc[ai][bj][m][n][2], acc[ai][bj][m][n][3])});
    SYNC();
    const int ldc = epi.stage_ld();
    bf16_t* dst = sbase + (size_t)brow * ldc + bcol;
#pragma unroll 4
    for (int p = 0; p < 16; ++p) {
      const int r = wie * 32 + p * 2 + (lae >> 5), c8 = (lae & 31) * 8;
      st16(dst + (size_t)r * ldc + c8, ld16(T + r * 264 + c8));
    }
  } else {
#pragma unroll
    for (int ai = 0; ai < 2; ++ai)
#pragma unroll
      for (int bj = 0; bj < 2; ++bj)
#pragma unroll
        for (int m = 0; m < 4; ++m)
#pragma unroll
          for (int n = 0; n < 2; ++n)
            epi(brow + ai * 128 + wre * 64 + m * 16 + fre, bcol + bj * 128 + wce * 32 + n * 16 + fqe * 4, acc[ai][bj][m][n]);
  }
}
#ifndef USE_G8
#define USE_G8 1
#endif
template <int BN, class Epi>
DEV void gemm_tile_sel(const bf16_t* A, int lda, const bf16_t* Bt, int ldb, int K, int m0, int n0, Epi& epi, unsigned char* smem) {
  if constexpr (BN == 256 && USE_G8) gemm8_tile(A, Bt, m0, n0, epi, smem); else gemm_tile<BN>(A, lda, Bt, ldb, K, m0, n0, epi, smem);
}
template <int BN, class Epi>
DEV void gemm_phase(const bf16_t* A, int lda, const bf16_t* Bt, int ldb, int M, int Npad, int K, Epi epi, unsigned char* smem) {
  const int ntn = Npad / BN, ntm = M / G_BM;
  if ((ntm & 7) == 0 && (gridDim.x & 7) == 0) {
    const int x = blockIdx.x & 7, jr = blockIdx.x >> 3, per = gridDim.x >> 3;
    const int nloc = (ntm >> 3) * ntn;
    for (int q = jr; q < nloc; q += per) gemm_tile_sel<BN>(A, lda, Bt, ldb, K, ((q / ntn) * 8 + x) * G_BM, (q % ntn) * BN, epi, smem);
  } else {
    for (int t = blockIdx.x; t < ntn * ntm; t += gridDim.x) gemm_tile_sel<BN>(A, lda, Bt, ldb, K, (t / ntn) * G_BM, (t % ntn) * BN, epi, smem);
  }
}
struct EpiStoreBf16 { bf16_t* C; int ldc;
  DEVM bf16_t* stage_base(int, int) const { return C; }
  DEVM int stage_ld() const { return ldc; }
  DEVM void operator()(int m, int n, f32x4 v) const { st8(C + (size_t)m * ldc + n, U2{pack2(v[0], v[1]), pack2(v[2], v[3])}); } };
struct EpiResid { float* X; const float* gate; float scale;
  DEVM bf16_t* stage_base(int, int) const { return nullptr; }
  DEVM int stage_ld() const { return 0; }
  DEVM void operator()(int m, int n, f32x4 v) const {
    const float* g = gate + (size_t)row_cond(m) * 6144 + n;
    float* x = X + (size_t)m * 1024 + n;
    F4 xv = ldf4(x), gv = ldf4(g);
    stf4(x, F4{xv.x + scale * gv.x * v[0], xv.y + scale * gv.y * v[1], xv.z + scale * gv.z * v[2], xv.w + scale * gv.w * v[3]});
  } };
struct EpiWF { bf16_t* W;
  DEVM bf16_t* stage_base(int, int) const { return nullptr; }
  DEVM int stage_ld() const { return 0; }
  DEVM void operator()(int m, int n, f32x4 v) const {
#pragma unroll
    for (int i = 0; i < 4; ++i) W[(size_t)(n + i) * 1024 + m] = (bf16_t)(pack2(v[i], 0.f) & 0xffffu);
  } };
DEV void phase_wf(const Params& P, int layer, unsigned char* smem) {
  for (int t = blockIdx.x; t < 64; t += gridDim.x) {
    const int hc = t >> 2, mt = t & 3;
    EpiWF epi{wsp<bf16_t>(P, OFF_WF) + (size_t)hc * 128 * 1024};
    gemm_tile<128>(wsp<bf16_t>(P, OFF_WPKQ) + (size_t)layer * 1024 * 2048 + hc * 128, 2048,
                   wsp<bf16_t>(P, OFF_KEYS) + ((size_t)layer * 16 + hc) * 128 * 128, 128, 128, mt * 256, 0, epi, smem);
  }
}


DEV void cmulr(float& ar, float& ai, float br, float bi) { float r = ar * br - ai * bi, i = ar * bi + ai * br; ar = r; ai = i; }
template <int LOGN, int NTHR> DEV void fft_radix8_pass(F2* x, const F2* tw, int h, bool inverse, int tl) {
  constexpr int N = 1 << LOGN;
  const int hq = h >> 2;
  const float R = 0.70710678118654752f;
  const int lhq = 31 - __builtin_clz((unsigned)hq);
#pragma unroll 1
  for (int g = tl; g < N / 8; g += NTHR) {
    const int b = g >> lhq, r = g & (hq - 1);
    F2* xp = x + b * 2 * h + r;
    float er[8], ei[8];
#pragma unroll
    for (int j = 0; j < 8; ++j) { F2 v = xp[j * hq]; er[j] = v.x; ei[j] = v.y; }
    const F2 t1 = tw[r << (LOGN - 3 - lhq)];
    const float c1 = t1.x; const float s1 = inverse ? -t1.y : t1.y;
    const float c2 = c1 * c1 - s1 * s1, s2 = 2.f * c1 * s1;
    const float c4 = c2 * c2 - s2 * s2, s4 = 2.f * c2 * s2;
    const float sg = inverse ? 1.f : -1.f;
    const float w8r[4] = {1.f, R, 0.f, -R}, w8i[4] = {0.f, sg * R, sg, sg * R};
    if (!inverse) {
#pragma unroll
      for (int j = 0; j < 4; ++j) {
        float ur = er[j], ui = ei[j], vr = er[j + 4], vi = ei[j + 4];
        er[j] = ur + vr; ei[j] = ui + vi;
        float tr = ur - vr, ti = ui - vi;
        float wr = c1, wi = s1; cmulr(wr, wi, w8r[j], w8i[j]);
        cmulr(tr, ti, wr, wi); er[j + 4] = tr; ei[j + 4] = ti;
      }
#pragma unroll
      for (int jj = 0; jj < 4; ++jj) {
        const int j = (jj & 1) + (jj >> 1) * 4;
        float ur = er[j], ui = ei[j], vr = er[j + 2], vi = ei[j + 2];
        er[j] = ur + vr; ei[j] = ui + vi;
        float tr = ur - vr, ti = ui - vi;
        float wr = c2, wi = s2; if (j & 1) { float t = wr; wr = wi; wi = -t; }
        cmulr(tr, ti, wr, wi); er[j + 2] = tr; ei[j + 2] = ti;
      }
#pragma unroll
      for (int j = 0; j < 8; j += 2) {
        float ur = er[j], ui = ei[j], vr = er[j + 1], vi = ei[j + 1];
        er[j] = ur + vr; ei[j] = ui + vi;
        float tr = ur - vr, ti = ui - vi;
        cmulr(tr, ti, c4, s4); er[j + 1] = tr; ei[j + 1] = ti;
      }
    } else {
#pragma unroll
      for (int j = 0; j < 8; j += 2) {
        float vr = er[j + 1], vi = ei[j + 1]; cmulr(vr, vi, c4, s4);
        float ur = er[j], ui = ei[j];
        er[j] = ur + vr; ei[j] = ui + vi; er[j + 1] = ur - vr; ei[j + 1] = ui - vi;
      }
#pragma unroll
      for (int jj = 0; jj < 4; ++jj) {
        const int j = (jj & 1) + (jj >> 1) * 4;
        float wr = c2, wi = s2; if (j & 1) { float t = wr; wr = -wi; wi = t; }
        float vr = er[j + 2], vi = ei[j + 2]; cmulr(vr, vi, wr, wi);
        float ur = er[j], ui = ei[j];
        er[j] = ur + vr; ei[j] = ui + vi; er[j + 2] = ur - vr; ei[j + 2] = ui - vi;
      }
#pragma unroll
      for (int j = 0; j < 4; ++j) {
        float wr = c1, wi = s1; cmulr(wr, wi, w8r[j], w8i[j]);
        float vr = er[j + 4], vi = ei[j + 4]; cmulr(vr, vi, wr, wi);
        float ur = er[j], ui = ei[j];
        er[j] = ur + vr; ei[j] = ui + vi; er[j + 4] = ur - vr; ei[j + 4] = ui - vi;
      }
    }
#pragma unroll
    for (int j = 0; j < 8; ++j) xp[j * hq] = F2{er[j], ei[j]};
  }
}
template <int LOGN, int NTHR> DEV void fft_radix2_last(F2* x, int tl) {
  constexpr int N = 1 << LOGN;
  for (int g = tl; g < N / 2; g += NTHR) {
    F2 u = x[2 * g], v = x[2 * g + 1];
    x[2 * g] = F2{u.x + v.x, u.y + v.y}; x[2 * g + 1] = F2{u.x - v.x, u.y - v.y};
  }
}
template <int LOGN, int NTHR> DEV void fft_fwd_t(F2* x, const F2* tw, int tl) {
  static_assert(LOGN % 3 == 0 || LOGN % 3 == 1, "fft size");
  int h = (1 << LOGN) / 2;
#pragma unroll 1
  for (int p = 0; p < LOGN / 3; ++p, h >>= 3) { fft_radix8_pass<LOGN, NTHR>(x, tw, h, false, tl); SYNC(); }
  if (LOGN % 3 == 1) { fft_radix2_last<LOGN, NTHR>(x, tl); SYNC(); }
}
template <int LOGN, int NTHR> DEV void fft_inv_t(F2* x, const F2* tw, int tl) {
  if (LOGN % 3 == 1) { fft_radix2_last<LOGN, NTHR>(x, tl); SYNC(); }
  int h = (LOGN % 3 == 1) ? 8 : 4;
#pragma unroll 1
  for (int p = 0; p < LOGN / 3; ++p, h <<= 3) { fft_radix8_pass<LOGN, NTHR>(x, tw, h, true, tl); SYNC(); }
}
template <int LOGN> DEV void fft_fill_twiddles(F2* tw) {
  for (int j = threadIdx.x; j < (1 << LOGN) / 8; j += NT) { float sn, cs; sincospif(-2.f * (float)j / (float)(1 << LOGN), &sn, &cs); tw[j] = F2{cs, sn}; }
}
constexpr size_t SM_TWL = 96 * 1024, SM_TWC = 112 * 1024;

template <int LOGN> DEV void hyena_filter_task(const Params& P, int c, unsigned char* smem) {
  constexpr int N = 1 << LOGN, L = N / 2;
  constexpr int h2base = (LOGN == LOG_NC) ? 0 : L_C;
  constexpr int kfoff = (LOGN == LOG_NC) ? 0 : 2 * L_C;
  F2* x = reinterpret_cast<F2*>(smem);
  float* w3s = reinterpret_cast<float*>(smem + (size_t)N * 8);
  float* red = w3s + 256;
  const int tid = threadIdx.x, lane = tid & 63, w = tid >> 6;
  if (tid < 256) { int f = tid >> 2, k = tid & 3; w3s[tid] = P.in[I_HYW3][(size_t)f * 2048 + (k >> 1) * 1024 + (k & 1) * 512 + c]; }
  float dec[4];
#pragma unroll
  for (int k = 0; k < 4; ++k) dec[k] = fabsf(P.in[I_HYDECAY][(k >> 1) * 1024 + (k & 1) * 512 + c]);
  if (tid == 0) x[L] = F2{0.f, 0.f};
  SYNC();
  const float* H2 = wsp<float>(P, OFF_H2) + (size_t)h2base * 64;
  float ss0 = 0.f, ss1 = 0.f;
  for (int i4 = tid * 4; i4 < L; i4 += NT * 4) {
    float acc[4][4];
#pragma unroll
    for (int pp = 0; pp < 4; ++pp)
#pragma unroll
      for (int k = 0; k < 4; ++k) acc[pp][k] = 0.f;
#pragma unroll 8
    for (int f = 0; f < 64; ++f) {
      const F4 hv = ldf4(H2 + (size_t)f * L + i4);
      const F4 ww = ldf4(w3s + f * 4);
      const float hh[4] = {hv.x, hv.y, hv.z, hv.w};
#pragma unroll
      for (int pp = 0; pp < 4; ++pp) { acc[pp][0] += hh[pp] * ww.x; acc[pp][1] += hh[pp] * ww.y; acc[pp][2] += hh[pp] * ww.z; acc[pp][3] += hh[pp] * ww.w; }
    }
#pragma unroll
    for (int pp = 0; pp < 4; ++pp) {
      const int i = i4 + pp;
      const float t = (float)i / (float)L;
      float hv[4];
#pragma unroll
      for (int k = 0; k < 4; ++k) hv[k] = acc[pp][k] * expf(-t * dec[k]);
      x[i] = F2{hv[0], hv[2]}; ss0 += hv[0] * hv[0]; ss1 += hv[2] * hv[2];
      if (i >= 1) { x[N - i] = F2{hv[1], hv[3]}; ss0 += hv[1] * hv[1]; ss1 += hv[3] * hv[3]; }
    }
  }
  ss0 = wave_sum(ss0); ss1 = wave_sum(ss1);
  if (lane == 0) { red[w] = ss0; red[NW + w] = ss1; }
  SYNC();
  float t0 = 0.f, t1 = 0.f;
#pragma unroll
  for (int i = 0; i < NW; ++i) { t0 += red[i]; t1 += red[NW + i]; }
  const float rs0 = rsqrtf(t0 + EPS), rs1 = rsqrtf(t1 + EPS);
  for (int j = tid; j < N; j += NT) { F2 v = x[j]; x[j] = F2{v.x * rs0, v.y * rs1}; }
  SYNC();
  fft_fwd_t<LOGN, NT>(x, reinterpret_cast<const F2*>(smem + (LOGN == LOG_NC ? SM_TWC : SM_TWL)), tid);
  F2* KF = wsp<F2>(P, OFF_KF);
  const float sc = 0.5f / (float)N;
  for (int p = tid; p < N; p += NT) {
    const int f = (int)(__brev((unsigned)p) >> (32 - LOGN));
    const int p2 = (int)(__brev((unsigned)((N - f) & (N - 1))) >> (32 - LOGN));
    F2 Z = x[p], Z2 = x[p2];
    KF[((size_t)c * 2 + 0) * KF_N + kfoff + p] = F2{(Z.x + Z2.x) * sc, (Z.y - Z2.y) * sc};
    KF[((size_t)c * 2 + 1) * KF_N + kfoff + p] = F2{(Z.y + Z2.y) * sc, -(Z.x - Z2.x) * sc};
  }
  SYNC();
}
DEV void phase_hyena_filters(const Params& P, unsigned char* smem) {
  fft_fill_twiddles<LOG_NL>(reinterpret_cast<F2*>(smem + SM_TWL)); fft_fill_twiddles<LOG_NC>(reinterpret_cast<F2*>(smem + SM_TWC));
  SYNC();
  for (int t = blockIdx.x; t < 1024; t += gridDim.x) {
    if (t < 512) hyena_filter_task<LOG_NL>(P, t, smem);
    else hyena_filter_task<LOG_NC>(P, t - 512, smem);
  }
}

DEV void hyena_conv_task(const Params& P, int task, unsigned char* smem) {
  bf16_t* T = reinterpret_cast<bf16_t*>(smem);
  const int rt = task / 6, ct = task % 6;
  const int r0 = rt * 64, c0 = ct * 256;
  const int tid = threadIdx.x, tl = tid >> 3, cg = (tid & 7) * 8;
  const int r = r0 + tl, pos = row_pos(r), L = r < NTOK_C ? L_C : L_L;
  const float* cw = P.in[I_HYCW]; const float* cb = P.in[I_HYCB];
#pragma unroll
  for (int sub = 0; sub < 4; ++sub) {
    const bf16_t* pr = wsp<bf16_t>(P, OFF_PROJ0) + (size_t)r * 2048 + c0 + sub * 64 + cg;
    const U4 z4{0u, 0u, 0u, 0u};
    U4 xm = pos > 0 ? ld16(pr - 2048) : z4, x0 = ld16(pr), xp = pos < L - 1 ? ld16(pr + 2048) : z4;
    const unsigned am[4] = {xm.x, xm.y, xm.z, xm.w}, a0[4] = {x0.x, x0.y, x0.z, x0.w}, ap[4] = {xp.x, xp.y, xp.z, xp.w};
#pragma unroll
    for (int j = 0; j < 8; ++j) {
      const int c = c0 + sub * 64 + cg + j;
      float vm = (j & 1) ? bfhi(am[j >> 1]) : bflo(am[j >> 1]);
      float v0 = (j & 1) ? bfhi(a0[j >> 1]) : bflo(a0[j >> 1]);
      float vp = (j & 1) ? bfhi(ap[j >> 1]) : bflo(ap[j >> 1]);
      float o = vm * cw[c] + v0 * cw[1536 + c] + vp * cw[3072 + c] + cb[c];
      T[(sub * 64 + cg + j) * 72 + tl] = f2bf(o);
    }
  }
  SYNC();
#pragma unroll
  for (int sub = 0; sub < 4; ++sub) {
    const int cl = sub * 64 + (tid >> 3), tc = (tid & 7) * 8;
    st16(wsp<bf16_t>(P, OFF_HT3) + (size_t)(c0 + cl) * NTOK + r0 + tc, ld16(T + cl * 72 + tc));
  }
  SYNC();
}
DEV void hyena_untranspose_task(const Params& P, int task, unsigned char* smem) {
  bf16_t* T = reinterpret_cast<bf16_t*>(smem);
  const int rt = task / 8, ct = task % 8;
  const int r0 = rt * 64, c0 = ct * 64;
  const int tid = threadIdx.x;
  {
    const int cl = tid >> 3, tc = (tid & 7) * 8;
    U4 v = ld16(wsp<bf16_t>(P, OFF_HYT) + (size_t)(c0 + cl) * NTOK + r0 + tc);
    const unsigned a[4] = {v.x, v.y, v.z, v.w};
#pragma unroll
    for (int j = 0; j < 8; ++j) T[(tc + j) * 72 + cl] = (bf16_t)((j & 1) ? (a[j >> 1] >> 16) : (a[j >> 1] & 0xffffu));
  }
  SYNC();
  {
    const int tl = tid >> 3, cc = (tid & 7) * 8;
    st16(wsp<bf16_t>(P, OFF_RA) + (size_t)(r0 + tl) * 1024 + c0 + cc, ld16(T + tl * 72 + cc));
  }
  SYNC();
}

template <int LOGN, int NTHR> DEV void hyena_main_item(const Params& P, int c, int pair, bool valid, F2* x, const F2* tw, int tl) {
  constexpr int N = 1 << LOGN, L = N / 2;
  constexpr bool CTX = (LOGN == LOG_NC);
  constexpr int kfoff = CTX ? 0 : 2 * L_C;
  constexpr int NI = (L + NTHR - 1) / NTHR;
  const int rowA = CTX ? (2 * pair) * L_C : NTOK_C + (2 * pair) * L_L, rowB = rowA + L;
  const bf16_t* VT = wsp<bf16_t>(P, OFF_HT3) + (size_t)c * NTOK;
  const bf16_t* G1T = VT + (size_t)512 * NTOK; const bf16_t* G2T = VT + (size_t)1024 * NTOK;
  bf16_t* HYT = wsp<bf16_t>(P, OFF_HYT) + (size_t)c * NTOK;
  const F2* KF0 = wsp<F2>(P, OFF_KF) + ((size_t)c * 2 + 0) * KF_N + kfoff;
  const F2* KF1 = KF0 + KF_N;
  const float bias0 = P.in[I_HYBIAS][c], bias1 = P.in[I_HYBIAS][512 + c];
  constexpr int NP = N / NTHR;
  float za[NI], zb[NI], g1a[NI], g1b[NI], g2a[NI], g2b[NI];
#pragma unroll
  for (int i = 0; i < NI; ++i) {
    const int t = tl + i * NTHR;
    const bool in = t < L;
    const int ta = rowA + (in ? t : 0), tb = rowB + (in ? t : 0);
    za[i] = bf2f(VT[ta]); zb[i] = bf2f(VT[tb]); g1a[i] = bf2f(G1T[ta]); g1b[i] = bf2f(G1T[tb]); g2a[i] = bf2f(G2T[ta]); g2b[i] = bf2f(G2T[tb]);
  }
  F2 k0[NP], k1[NP];
#pragma unroll
  for (int i = 0; i < NP; ++i) { k0[i] = KF0[tl + i * NTHR]; k1[i] = KF1[tl + i * NTHR]; }
#pragma unroll
  for (int i = 0; i < NI; ++i) { const int t = tl + i * NTHR; if (t < L) { x[t] = F2{za[i], zb[i]}; x[L + t] = F2{0.f, 0.f}; } }
  SYNC();
  fft_fwd_t<LOGN, NTHR>(x, tw, tl);
#pragma unroll
  for (int i = 0; i < NP; ++i) { const int p = tl + i * NTHR; const F2 v = x[p], k = k0[i]; x[p] = F2{v.x * k.x - v.y * k.y, v.x * k.y + v.y * k.x}; }
  SYNC();
  fft_inv_t<LOGN, NTHR>(x, tw, tl);
  F2 z1r[NI];
#pragma unroll
  for (int i = 0; i < NI; ++i) {
    const int t = tl + i * NTHR;
    if (t < L) {
      F2 cv = x[t];
      z1r[i] = F2{g1a[i] * (cv.x + bias0 * za[i]), g1b[i] * (cv.y + bias0 * zb[i])};
    } else z1r[i] = F2{0.f, 0.f};
  }
  SYNC();
#pragma unroll
  for (int i = 0; i < NI; ++i) { const int t = tl + i * NTHR; if (t < L) { x[t] = z1r[i]; x[L + t] = F2{0.f, 0.f}; } }
  SYNC();
  fft_fwd_t<LOGN, NTHR>(x, tw, tl);
#pragma unroll
  for (int i = 0; i < NP; ++i) { const int p = tl + i * NTHR; const F2 v = x[p], k = k1[i]; x[p] = F2{v.x * k.x - v.y * k.y, v.x * k.y + v.y * k.x}; }
  SYNC();
  fft_inv_t<LOGN, NTHR>(x, tw, tl);
  if (valid) {
#pragma unroll
    for (int i = 0; i < NI; ++i) {
      const int t = tl + i * NTHR;
      if (t < L) {
        F2 cv = x[t];
        HYT[rowA + t] = f2bf(g2a[i] * (cv.x + bias1 * z1r[i].x));
        HYT[rowB + t] = f2bf(g2b[i] * (cv.y + bias1 * z1r[i].y));
      }
    }
  }
  SYNC();
}

DEV void s5_load_u(const bf16_t* p, float* u) {
  U4 a = ld16(p), b = ld16(p + 8);
  u[0] = bflo(a.x); u[1] = bfhi(a.x); u[2] = bflo(a.y); u[3] = bfhi(a.y); u[4] = bflo(a.z); u[5] = bfhi(a.z); u[6] = bflo(a.w); u[7] = bfhi(a.w);
  u[8] = bflo(b.x); u[9] = bfhi(b.x); u[10] = bflo(b.y); u[11] = bfhi(b.y); u[12] = bflo(b.z); u[13] = bfhi(b.z); u[14] = bflo(b.w); u[15] = bfhi(b.w);
}
DEV void s5_u_load(const bf16_t* U, bf16x4* fu, int lr, int lq) {
#pragma unroll
  for (int st = 0; st < 2; ++st) { U2 v = ld8(U + (size_t)(st * 16 + lr) * 2048 + lq * 4); memcpy(&fu[st], &v, 8); }
}
DEV void s5_bb_load(const bf16_t* BB, U2* fb, int lr, int lq) {
#pragma unroll
  for (int pt = 0; pt < 8; ++pt) fb[pt] = ld8(BB + (size_t)(pt * 16 + lr) * 16 + lq * 4);
}
DEV void s5_bu_mma(const bf16x4* fu, const U2* fbv, bf16_t* Bu, int lr, int lq) {
#pragma unroll
  for (int pt = 0; pt < 8; ++pt) {
    bf16x4 fb; memcpy(&fb, &fbv[pt], 8);
#pragma unroll
    for (int st = 0; st < 2; ++st) {
      f32x4 d = mfma16k16(fb, fu[st], f32x4{0.f, 0.f, 0.f, 0.f});
      st8(Bu + (st * 16 + lr) * 136 + pt * 16 + lq * 4, U2{pack2(d[0], d[1]), pack2(d[2], d[3])});
    }
  }
}
DEV void phase_s5_pass1(const Params& P, unsigned char* smem) {
  const int lane = threadIdx.x & 63, w = threadIdx.x >> 6, lr = lane & 15, lq = lane >> 4;
  bf16_t* Bu = reinterpret_cast<bf16_t*>(smem) + (size_t)w * 32 * 136;
  const int ntask = (NTOK / 64) * 32;
  const int niter = (ntask + gridDim.x * NW - 1) / (gridDim.x * NW);
  const bf16_t* PR0 = wsp<bf16_t>(P, OFF_PROJ0) + 1536;
  const bf16_t* BB16 = wsp<bf16_t>(P, OFF_BB16);
  int t = blockIdx.x * NW + w;
  bool valid = t < ntask;
  int ch = valid ? t >> 5 : 0, g = t & 31;
  bf16x4 fu[2]; U2 fb[8];
  s5_u_load(PR0 + (size_t)(ch * 64) * 2048 + g * 16, fu, lr, lq);
  s5_bb_load(BB16 + (size_t)g * 128 * 16, fb, lr, lq);
  for (int it = 0; it < niter; ++it) {
    const bf16_t* U = PR0 + (size_t)(ch * 64) * 2048 + g * 16;
    const int tn = ((it + 1) * gridDim.x + blockIdx.x) * NW + w;
    const bool nvalid = tn < ntask;
    const int nch = nvalid ? tn >> 5 : 0, ng = tn & 31;
#pragma unroll 1
    for (int dir = 0; dir < 2; ++dir) {
      const size_t ip = ((size_t)dir * 32 + g) * 64 + lane;
      const F2 lam = wsp<F2>(P, OFF_LAMB)[ip];
      float hr = 0.f, hi = 0.f;
#pragma unroll 1
      for (int hf = 0; hf < 2; ++hf) {
        SYNC();
        s5_bu_mma(fu, fb, Bu, lr, lq);
        if (hf == 0) s5_u_load(U + (size_t)((dir ? 0 : 1) * 32) * 2048, fu, lr, lq);
        else if (dir == 0) { s5_u_load(U + (size_t)32 * 2048, fu, lr, lq); s5_bb_load(BB16 + ((size_t)32 + g) * 128 * 16, fb, lr, lq); }
        else { s5_u_load(PR0 + (size_t)(nch * 64) * 2048 + ng * 16, fu, lr, lq); s5_bb_load(BB16 + (size_t)ng * 128 * 16, fb, lr, lq); }
        SYNC();
#pragma unroll 8
        for (int s = 0; s < 32; ++s) {
          const int rl = dir ? 31 - s : s;
          const unsigned bv = *reinterpret_cast<const unsigned*>(Bu + rl * 136 + 2 * lane);
          const float nr = lam.x * hr - lam.y * hi + bflo(bv), ni = lam.x * hi + lam.y * hr + bfhi(bv);
          hr = nr; hi = ni;
        }
      }
      if (valid) wsp<F2>(P, OFF_S5C)[(((size_t)ch * 32 + g) * 2 + dir) * 64 + lane] = F2{hr, hi};
    }
    valid = nvalid; ch = nch; g = ng;
  }
}
DEV void phase_s5_carry(const Params& P) {
  const int lane = threadIdx.x & 63, w = threadIdx.x >> 6;
  const int ntask = NSEQ * 64;
  for (int t = blockIdx.x * NW + w; t < ntask; t += gridDim.x * NW) {
    const int seq = t >> 6, g = (t >> 1) & 31, dir = t & 1;
    const int c_first = seq_start(seq) / 64, n = seq_len(seq) / 64;
    const F2 lamT = wsp<F2>(P, OFF_LAMT)[((size_t)dir * 32 + g) * 64 + lane];
    float hr = 0.f, hi = 0.f;
    if (seq >= NB_C) {
      const size_t is = (((size_t)(seq - NB_C) * 2 + dir) * 32 + g) * 64 + lane;
      hr = P.in[I_S5RE][is]; hi = P.in[I_S5IM][is];
    }
    F2* SC = wsp<F2>(P, OFF_S5C) + ((size_t)g * 2 + dir) * 64 + lane;
    const int cstart = dir ? c_first + n - 1 : c_first, cstep = dir ? -1 : 1;
    for (int i0 = 0; i0 < n; i0 += 8) {
      F2 le[8];
#pragma unroll
      for (int u = 0; u < 8; ++u) { const int i = i0 + u < n ? i0 + u : n - 1; le[u] = SC[(size_t)(cstart + cstep * i) * (32 * 2 * 64)]; }
#pragma unroll
      for (int u = 0; u < 8; ++u) if (i0 + u < n) {
        SC[(size_t)(cstart + cstep * (i0 + u)) * (32 * 2 * 64)] = F2{hr, hi};
        float nr = lamT.x * hr - lamT.y * hi + le[u].x, ni = lamT.x * hi + lamT.y * hr + le[u].y; hr = nr; hi = ni;
      }
    }
    if (seq < NB_C) {
      const size_t io = (((size_t)seq * 2 + dir) * 32 + g) * 64 + lane;
      P.out[OUT_S5RE + io] = hr; P.out[OUT_S5IM + io] = hi;
    }
  }
}
DEV void phase_s5_pass2(const Params& P, unsigned char* smem) {
  const int lane = threadIdx.x & 63, w = threadIdx.x >> 6;
  const int lr = lane & 15, lq = lane >> 4;
  bf16_t* Bu = reinterpret_cast<bf16_t*>(smem) + (size_t)w * 32 * 136;
  bf16_t* Hs = reinterpret_cast<bf16_t*>(smem) + (size_t)(NW + w) * 32 * 136;
  const int ntask = (NTOK / 64) * 32;
  const int niter = (ntask + gridDim.x * NW - 1) / (gridDim.x * NW);
  const bf16_t* PR0 = wsp<bf16_t>(P, OFF_PROJ0) + 1536;
  const bf16_t* BB16 = wsp<bf16_t>(P, OFF_BB16);
  int t = blockIdx.x * NW + w;
  bool valid = t < ntask;
  int ch = valid ? t >> 5 : 0, g = t & 31;
  bf16x4 fu[2]; U2 fbb[8];
  s5_u_load(PR0 + (size_t)(ch * 64) * 2048 + g * 16, fu, lr, lq);
  s5_bb_load(BB16 + (size_t)g * 128 * 16, fbb, lr, lq);
  for (int it = 0; it < niter; ++it) {
    const int r0 = ch * 64;
    const bf16_t* U = PR0 + (size_t)r0 * 2048 + g * 16;
    const int tn = ((it + 1) * gridDim.x + blockIdx.x) * NW + w;
    const bool nvalid = tn < ntask;
    const int nch = nvalid ? tn >> 5 : 0, ng = tn & 31;
    const F4 dsk = ldf4(P.in[I_S5D] + g * 16 + lq * 4);
    U2 uu[4];
#pragma unroll
    for (int m = 0; m < 4; ++m) uu[m] = ld8(U + (size_t)(m * 16 + lr) * 2048 + lq * 4);
    f32x4 acc[4];
#pragma unroll
    for (int m = 0; m < 4; ++m) acc[m] = f32x4{0.f, 0.f, 0.f, 0.f};
#pragma unroll 1
    for (int dir = 0; dir < 2; ++dir) {
      const size_t ip = ((size_t)dir * 32 + g) * 64 + lane;
      const F2 lam = wsp<F2>(P, OFF_LAMB)[ip];
      const F2 h0 = wsp<F2>(P, OFF_S5C)[(((size_t)ch * 32 + g) * 2 + dir) * 64 + lane];
      float hr = h0.x, hi = h0.y;
      const bf16_t* CmT = wsp<bf16_t>(P, OFF_CMT) + ((size_t)dir * 32 + g) * 16 * 128;
      bf16x8 fa[4];
#pragma unroll
      for (int kk = 0; kk < 4; ++kk) fa[kk] = as_frag(ld16(CmT + lr * 128 + kk * 32 + lq * 8));
#pragma unroll 1
      for (int hf = 0; hf < 2; ++hf) {
        const int half = dir ? 1 - hf : hf;
        SYNC();
        s5_bu_mma(fu, fbb, Bu, lr, lq);
        if (hf == 0) s5_u_load(U + (size_t)((dir ? 0 : 1) * 32) * 2048, fu, lr, lq);
        else if (dir == 0) { s5_u_load(U + (size_t)32 * 2048, fu, lr, lq); s5_bb_load(BB16 + ((size_t)32 + g) * 128 * 16, fbb, lr, lq); }
        else { s5_u_load(PR0 + (size_t)(nch * 64) * 2048 + ng * 16, fu, lr, lq); s5_bb_load(BB16 + (size_t)ng * 128 * 16, fbb, lr, lq); }
        SYNC();
#pragma unroll 8
        for (int s = 0; s < 32; ++s) {
          const int rl = dir ? 31 - s : s;
          const unsigned bv = *reinterpret_cast<const unsigned*>(Bu + rl * 136 + 2 * lane);
          const float nr = lam.x * hr - lam.y * hi + bflo(bv), ni = lam.x * hi + lam.y * hr + bfhi(bv);
          hr = nr; hi = ni;
          *reinterpret_cast<unsigned*>(Hs + rl * 136 + 2 * lane) = pack2(hr, hi);
        }
        SYNC();
#pragma unroll
        for (int kk = 0; kk < 4; ++kk) {
#pragma unroll
          for (int m2 = 0; m2 < 2; ++m2) {
            bf16x8 fb = as_frag(ld16(Hs + (m2 * 16 + lr) * 136 + kk * 32 + lq * 8));
            if (half == 0) acc[m2] = mfma16(fa[kk], fb, acc[m2]); else acc[2 + m2] = mfma16(fa[kk], fb, acc[2 + m2]);
          }
        }
      }
    }
    if (valid) {
#pragma unroll
      for (int m = 0; m < 4; ++m) {
        const int row = r0 + m * 16 + lr;
        float y0 = gelu_f(acc[m][0] + dsk.x * bflo(uu[m].x)), y1 = gelu_f(acc[m][1] + dsk.y * bfhi(uu[m].x));
        float y2 = gelu_f(acc[m][2] + dsk.z * bflo(uu[m].y)), y3 = gelu_f(acc[m][3] + dsk.w * bfhi(uu[m].y));
        st8(wsp<bf16_t>(P, OFF_YS5) + (size_t)row * 512 + g * 16 + lq * 4, U2{pack2(y0, y1), pack2(y2, y3)});
      }
    }
    valid = nvalid; ch = nch; g = ng;
  }
}
struct EpiGlu { const bf16_t* Y; bf16_t* CAT; const float* b;
  DEVM bf16_t* stage_base(int, int) const { return nullptr; }
  DEVM int stage_ld() const { return 0; }
  DEVM void operator()(int m, int n, f32x4 v) const {
    U2 yy = ld8(Y + (size_t)m * 512 + n); F4 bb = ldf4(b + n);
    float o0 = bflo(yy.x) * sigmoid_f(v[0] + bb.x), o1 = bfhi(yy.x) * sigmoid_f(v[1] + bb.y);
    float o2 = bflo(yy.y) * sigmoid_f(v[2] + bb.z), o3 = bfhi(yy.y) * sigmoid_f(v[3] + bb.w);
    st8(CAT + (size_t)m * 1024 + 512 + n, U2{pack2(o0, o1), pack2(o2, o3)});
  } };

DEV void phase_l0_a(const Params& P, unsigned char* smem) {
  for (int t = blockIdx.x; t < (NTOK / 64) * 6; t += gridDim.x) hyena_conv_task(P, t, smem);
  phase_s5_pass1(P, smem);
}
#ifndef PROBE_SUB
#define PROBE_SUB 0
#endif
#ifndef PROBE_ML
#define PROBE_ML 0
#endif
DEV void phase_l0_b(const Params& P, unsigned char* smem) {
  constexpr int NLAT = 512 * (NB_L / 2), NCTX_ITEMS = 512 * (NB_C / 2), NCTX = (NCTX_ITEMS + NW - 1) / NW;
  const int lane = threadIdx.x & 63, w = threadIdx.x >> 6;
  fft_fill_twiddles<LOG_NL>(reinterpret_cast<F2*>(smem + SM_TWL)); fft_fill_twiddles<LOG_NC>(reinterpret_cast<F2*>(smem + SM_TWC));
  SYNC();
  for (int rep = 0; rep < ((PROBE_SUB & 1) ? 2 : 1); ++rep)
  for (int t = blockIdx.x; t < NLAT; t += gridDim.x)
    hyena_main_item<LOG_NL, NT>(P, t / (NB_L / 2), t % (NB_L / 2), true, reinterpret_cast<F2*>(smem), reinterpret_cast<const F2*>(smem + SM_TWL), threadIdx.x);
  for (int rep = 0; rep < ((PROBE_SUB & 2) ? 2 : 1); ++rep)
  for (int t = blockIdx.x; t < NCTX; t += gridDim.x) {
    const int item = t * NW + w;
    const bool valid = item < NCTX_ITEMS;
    const int it2 = valid ? item : 0;
    hyena_main_item<LOG_NC, 64>(P, it2 / (NB_C / 2), it2 % (NB_C / 2), valid, reinterpret_cast<F2*>(smem) + (size_t)w * (2 * L_C), reinterpret_cast<const F2*>(smem + SM_TWC), lane);
  }
  for (int rep = 0; rep < ((PROBE_SUB & 4) ? 2 : 1); ++rep)
  phase_s5_pass2(P, smem);
}
DEV void phase_l0_c(const Params& P, unsigned char* smem) {
  for (int t = blockIdx.x; t < (NTOK / 64) * 8; t += gridDim.x) hyena_untranspose_task(P, t, smem);
  gemm_phase<128>(wsp<bf16_t>(P, OFF_YS5), 512, wsp<bf16_t>(P, OFF_WGLU), 512, NTOK, 512, 512,
             EpiGlu{wsp<bf16_t>(P, OFF_YS5), wsp<bf16_t>(P, OFF_RA), P.in[I_S5GLUB]}, smem);
}


constexpr int PEER_TPW = 32;
constexpr int PEER_TILE = NW * PEER_TPW;
DEV int peer_my_slice() {
#ifndef EMU
  return (int)(xb_xcc_id() & 7u);
#else
  return (int)(blockIdx.x & 7);
#endif
}
DEV int peer_pull(unsigned* cnt, int* slot) {
  SYNC();
  if (threadIdx.x == 0) *slot = (int)atomicAdd(cnt, 1u);
  SYNC();
  return *slot;
}
DEV void peer_u_item(const Params& P, int tile_, int k_, int lane, int w) {
  const int tile = uniform_i(tile_), k = uniform_i(k_);
  const unsigned char* TU8 = wsp<unsigned char>(P, OFF_TAB8) + (size_t)k * (16384 * 128);
  const int sub = lane >> 3, chunk = lane & 7;
  const int row0 = tile * PEER_TILE + w * PEER_TPW;
  const bf16_t* XR = wsp<bf16_t>(P, OFF_RA) + (size_t)row0 * 1024 + k * 128 + chunk * 16;
  const unsigned short* EIT = wsp<unsigned short>(P, OFF_EIDX) + (size_t)row0 * 128 + 2 * lane;
  auto gather = [&](const unsigned t, int half, U4* u) {
#pragma unroll
    for (int g8 = 0; g8 < 8; ++g8) {
      const int g = half * 8 + g8;
      const unsigned pr = (unsigned)__shfl((int)t, sub * 8 + (g >> 1));
      const unsigned idx = (g & 1) ? (pr >> 16) : (pr & 0xffffu);
      u[g8] = ld16(TU8 + (unsigned)(idx * 128u + (unsigned)chunk * 16u));
    }
  };
  auto dots = [&](const U4* u, const f32x2_t* xa) {
    float res = 0.f;
#pragma unroll
    for (int g8 = 0; g8 < 8; ++g8) {
      const unsigned q[4] = {u[g8].x, u[g8].y, u[g8].z, u[g8].w};
      f32x2_t a2 = fp8lo2(q[0]) * xa[0];
      a2 = fp8hi2(q[0]) * xa[1] + a2;
#pragma unroll
      for (int j = 1; j < 4; ++j) { a2 = fp8lo2(q[j]) * xa[2 * j] + a2; a2 = fp8hi2(q[j]) * xa[2 * j + 1] + a2; }
      float acc = a2[0] + a2[1];
      acc = sum8_dpp(acc);
      if (chunk == g8) res = acc;
    }
    return res;
  };
  unsigned tcur = *reinterpret_cast<const unsigned*>(EIT), tnext = *reinterpret_cast<const unsigned*>(EIT + 128);
  U4 xr0 = ld16(XR), xr1 = ld16(XR + 8);
  U4 ua[8], ub[8];
  gather(tcur, 0, ua);
#pragma unroll 1
  for (int t = 0; t < PEER_TPW; ++t) {
    gather(tcur, 1, ub);
    f32x2_t xa[8];
    { const unsigned q[8] = {xr0.x, xr0.y, xr0.z, xr0.w, xr1.x, xr1.y, xr1.z, xr1.w};
#pragma unroll
      for (int j = 0; j < 8; ++j) { xa[j][0] = bflo(q[j]); xa[j][1] = bfhi(q[j]); } }
    const int tn = t + 1 < PEER_TPW ? t + 1 : PEER_TPW - 1;
    xr0 = ld16(XR + (size_t)tn * 1024); xr1 = ld16(XR + (size_t)tn * 1024 + 8);
    const float res0 = dots(ua, xa);
    gather(tnext, 0, ua);
    const float res1 = dots(ub, xa);
    {
      const int srcA = (lane >> 4) * 8 + (lane & 7), srcB = srcA + 32;
      const float a0 = __shfl(res0, srcA), a1 = __shfl(res1, srcA), b0 = __shfl(res0, srcB), b1 = __shfl(res1, srcB);
      bf16_t* pp = wsp<bf16_t>(P, OFF_PART) + ((size_t)k * NTOK + row0 + t) * 128;
      sth_nt(pp + lane, f2bf((lane & 8) ? a1 : a0)); sth_nt(pp + 64 + lane, f2bf((lane & 8) ? b1 : b0));
    }
    tcur = tnext;
    tnext = *reinterpret_cast<const unsigned*>(EIT + (size_t)(t + 2 < PEER_TPW ? t + 2 : PEER_TPW - 1) * 128);
  }
}
DEV void phase_peer_u(const Params& P, int layer, int rep, unsigned char* smem) {
  int* slot = reinterpret_cast<int*>(smem);
  unsigned* qc = reinterpret_cast<unsigned*>(P.ws + OFF_QCNT) + (layer * 2 + 0) * 8;
  const int tidq = tid_opaque();
  const int lane = tidq & 63, w = tidq >> 6;
  const int my = peer_my_slice();
  for (int s = 0; s < 8; ++s) {
    const int k = (my + s) & 7;
    for (;;) { const int t = peer_pull(qc + k, slot) - rep * (NTOK / PEER_TILE + (int)gridDim.x); if (t >= NTOK / PEER_TILE) break; peer_u_item(P, t, k, lane, w); }
  }
}
DEV void phase_peer_act(const Params& P, unsigned char* smem) {
  float* rs = reinterpret_cast<float*>(smem);
  const float* RSC = wsp<float>(P, OFF_RSC);
  for (int i = threadIdx.x * 4; i < 2 * 16384; i += NT * 4) stf4(rs + i, ldf4(RSC + i));
  SYNC();
  const bf16_t* PART = wsp<bf16_t>(P, OFF_PART);
  const unsigned short* EI = wsp<unsigned short>(P, OFF_EIDX);
  bf16_t* GT = wsp<bf16_t>(P, OFF_EGT);
  for (size_t i = ((size_t)blockIdx.x * NT + threadIdx.x) * 4; i < (size_t)NTOK * 128; i += (size_t)gridDim.x * NT * 4) {
    F4 d{0.f, 0.f, 0.f, 0.f};
#pragma unroll
    for (int k = 0; k < 8; ++k) { const U2 p = ld8(PART + (size_t)k * NTOK * 128 + i); d.x += bflo(p.x); d.y += bfhi(p.x); d.z += bflo(p.y); d.w += bfhi(p.y); }
    const U2 eq = ld8(EI + i), gq = ld8(GT + i);
    const unsigned e0 = eq.x & 0xffffu, e1 = eq.x >> 16, e2 = eq.y & 0xffffu, e3 = eq.y >> 16;
    st8(GT + i, U2{pack2(gelu_f(d.x * rs[e0]) * bflo(gq.x) * rs[16384 + e0], gelu_f(d.y * rs[e1]) * bfhi(gq.x) * rs[16384 + e1]),
                   pack2(gelu_f(d.z * rs[e2]) * bflo(gq.y) * rs[16384 + e2], gelu_f(d.w * rs[e3]) * bfhi(gq.y) * rs[16384 + e3])});
  }
}
DEV void peer_v_item(const Params& P, int layer, float xscale, int tile_, int k_, int lane, int w) {
  const int tile = uniform_i(tile_), k = uniform_i(k_);
  const unsigned char* TV8 = wsp<unsigned char>(P, OFF_TAB8) + (size_t)16384 * 1024 + (size_t)k * (16384 * 128);
  const float* G2 = wsp<float>(P, OFF_MOD) + (size_t)layer * NCOND * 6144 + 5 * 1024;
  const int sub = lane >> 3, chunk = lane & 7;
  const bool b5 = (lane & 32) != 0, b4 = (lane & 16) != 0, b3 = (lane & 8) != 0;
  const int row0 = tile * PEER_TILE + w * PEER_TPW;
  const unsigned short* EIT = wsp<unsigned short>(P, OFF_EIDX) + (size_t)row0 * 128 + 2 * lane;
  const bf16_t* ATT = wsp<bf16_t>(P, OFF_EGT) + (size_t)row0 * 128 + 2 * lane;
  const int c = k * 128 + chunk * 16 + (b5 ? 8 : 0) + (b4 ? 4 : 0) + (b3 ? 2 : 0);
  auto gather = [&](const unsigned t, const unsigned ta, int half, U4* u, float* av) {
#pragma unroll
    for (int g8 = 0; g8 < 8; ++g8) {
      const int g = half * 8 + g8, src = sub * 8 + (g >> 1);
      const unsigned pr = (unsigned)__shfl((int)t, src), pa = (unsigned)__shfl((int)ta, src);
      const unsigned idx = (g & 1) ? (pr >> 16) : (pr & 0xffffu);
      av[g8] = (g & 1) ? bfhi(pa) : bflo(pa);
      u[g8] = ld16(TV8 + (unsigned)(idx * 128u + (unsigned)chunk * 16u));
    }
  };
  auto axpy = [&](const U4* u, const float* av, f32x2_t* oa) {
#pragma unroll
    for (int g8 = 0; g8 < 8; ++g8) {
      const unsigned q[4] = {u[g8].x, u[g8].y, u[g8].z, u[g8].w};
      f32x2_t a2; a2[0] = av[g8]; a2[1] = av[g8];
#pragma unroll
      for (int j = 0; j < 4; ++j) { oa[2 * j] = fp8lo2(q[j]) * a2 + oa[2 * j]; oa[2 * j + 1] = fp8hi2(q[j]) * a2 + oa[2 * j + 1]; }
    }
  };
  unsigned tcur = *reinterpret_cast<const unsigned*>(EIT), tnext = *reinterpret_cast<const unsigned*>(EIT + 128);
  unsigned acur = *reinterpret_cast<const unsigned*>(ATT), anext = *reinterpret_cast<const unsigned*>(ATT + 128);
  U4 va[8], vb[8]; float aa[8], ab[8];
  gather(tcur, acur, 0, va, aa);
#pragma unroll 1
  for (int t = 0; t < PEER_TPW; ++t) {
    gather(tcur, acur, 1, vb, ab);
    f32x2_t oa2[8];
#pragma unroll
    for (int j = 0; j < 8; ++j) { oa2[j][0] = 0.f; oa2[j][1] = 0.f; }
    axpy(va, aa, oa2);
    gather(tnext, anext, 0, va, aa);
    axpy(vb, ab, oa2);
    float oa[16];
#pragma unroll
    for (int j = 0; j < 8; ++j) { oa[2 * j] = oa2[j][0]; oa[2 * j + 1] = oa2[j][1]; }
    const int row = row0 + t;
    float r8[8], r4[4], r2[2];
#pragma unroll
    for (int i = 0; i < 8; ++i) r8[i] = (b5 ? oa[8 + i] : oa[i]) + __shfl_xor(b5 ? oa[i] : oa[8 + i], 32);
#pragma unroll
    for (int i = 0; i < 4; ++i) r4[i] = (b4 ? r8[4 + i] : r8[i]) + __shfl_xor(b4 ? r8[i] : r8[4 + i], 16);
#pragma unroll
    for (int i = 0; i < 2; ++i) r2[i] = (b3 ? r4[2 + i] : r4[i]) + __shfl_xor(b3 ? r4[i] : r4[2 + i], 8);
    float* X = wsp<float>(P, OFF_X) + (size_t)row * 1024 + c;
    const float* g2 = G2 + (size_t)row_cond(row) * 6144 + c;
    F2 xv = ldf2_nt(X); const F2 gv = *reinterpret_cast<const F2*>(g2);
    xv.x += xscale * gv.x * r2[0]; xv.y += xscale * gv.y * r2[1];
    stf2_nt(X, xv);
    tcur = tnext; acur = anext;
    const int t2 = t + 2 < PEER_TPW ? t + 2 : PEER_TPW - 1;
    tnext = *reinterpret_cast<const unsigned*>(EIT + (size_t)t2 * 128); anext = *reinterpret_cast<const unsigned*>(ATT + (size_t)t2 * 128);
  }
}
DEV void phase_peer_v(const Params& P, int layer, float xscale, int rep, unsigned char* smem) {
  int* slot = reinterpret_cast<int*>(smem);
  unsigned* qc = reinterpret_cast<unsigned*>(P.ws + OFF_QCNT) + (layer * 2 + 1) * 8;
  const int tidq = tid_opaque();
  const int lane = tidq & 63, w = tidq >> 6;
  const int my = peer_my_slice();
  for (int s = 0; s < 8; ++s) {
    const int k = (my + s) & 7;
    for (;;) { const int t = peer_pull(qc + k, slot) - rep * (NTOK / PEER_TILE + (int)gridDim.x); if (t >= NTOK / PEER_TILE) break; peer_v_item(P, layer, xscale, t, k, lane, w); }
  }
}

struct EpiGates { float* GTS;
  DEVM bf16_t* stage_base(int, int) const { return nullptr; }
  DEVM int stage_ld() const { return 0; }
  DEVM void operator()(int m, int n, f32x4 v) const { if (n < 32) stf4(GTS + (size_t)m * 32 + n, F4{v[0], v[1], v[2], v[3]}); } };
DEV void phase_odin(const Params& P, unsigned char* smem) {
  gemm_phase<256>(wsp<bf16_t>(P, OFF_RA), 1024, wsp<bf16_t>(P, OFF_WODIN), 1024, NTOK, 4096, 1024, EpiStoreBf16{wsp<bf16_t>(P, OFF_PROJ1), 4096}, smem);
  EpiGates eg{wsp<float>(P, OFF_GATES)};
  for (int t = (int)gridDim.x - 1 - (int)blockIdx.x; t < NTOK / 256; t += gridDim.x)
    gemm_tile<128>(wsp<bf16_t>(P, OFF_RA), 1024, wsp<bf16_t>(P, OFF_WODIN) + (size_t)4096 * 1024, 1024, 1024, t * 256, 0, eg, smem);
}

DEV void phase_gate_scan(const Params& P) {
  const int lane = threadIdx.x & 63, w = threadIdx.x >> 6;
  const float* GTS = wsp<float>(P, OFF_GATES);
  float* GS = wsp<float>(P, OFF_GS);
  const int ntask = (NTOK / 128) * 16;
  for (int t = blockIdx.x * NW + w; t < ntask; t += gridDim.x * NW) {
    const int tc = t >> 4, head = (t >> 1) & 7, dir = t & 1;
    const float gbi = P.in[I_ODGATEB][dir * 8 + head], gbf = P.in[I_ODGATEB][16 + dir * 8 + head];
    float carry_b = 0.f, carry_m = -3.0e38f;
    float* out = GS + ((size_t)(tc * 8 + head) * 2 + dir) * 384;
#pragma unroll
    for (int hf = 0; hf < 2; ++hf) {
      const int s = lane + 64 * hf;
      const int row = tc * 128 + (dir ? 127 - s : s);
      const float ig = GTS[(size_t)row * 32 + dir * 8 + head] + gbi;
      const float fg = GTS[(size_t)row * 32 + 16 + dir * 8 + head] + gbf;
      float b = log_sigmoid_f(fg);
      for (int d = 1; d < 64; d <<= 1) { float o = __shfl_up(b, d); if (lane >= d) b += o; }
      b += carry_b;
      float c = ig - b, pm = c;
      for (int d = 1; d < 64; d <<= 1) { float o = __shfl_up(pm, d); if (lane >= d) pm = fmaxf(pm, o); }
      pm = fmaxf(pm, carry_m);
      carry_b = __shfl(b, 63); carry_m = __shfl(pm, 63);
      out[s] = b; out[128 + s] = c; out[256 + s] = pm;
    }
  }
}
DEV void phase_qkconv(const Params& P) {
  const bf16_t* PR = wsp<bf16_t>(P, OFF_PROJ1);
  bf16_t* QC = wsp<bf16_t>(P, OFF_QC); bf16_t* KC = wsp<bf16_t>(P, OFF_KC);
  const float* cw = P.in[I_MLCW]; const float* cbias = P.in[I_MLCB];
  const int tid = threadIdx.x;
  for (int t = blockIdx.x; t < (NTOK / 64) * 4; t += gridDim.x) {
    const int r0 = (t >> 2) * 64, c0 = (t & 3) * 512;
    const int c = c0 + (tid & 63) * 8;
    F4 w0a = ldf4(cw + c), w0b = ldf4(cw + c + 4), w1a = ldf4(cw + 2048 + c), w1b = ldf4(cw + 2048 + c + 4);
    F4 w2a = ldf4(cw + 4096 + c), w2b = ldf4(cw + 4096 + c + 4), ba = ldf4(cbias + c), bb = ldf4(cbias + c + 4);
    const float w0[8] = {w0a.x, w0a.y, w0a.z, w0a.w, w0b.x, w0b.y, w0b.z, w0b.w};
    const float w1[8] = {w1a.x, w1a.y, w1a.z, w1a.w, w1b.x, w1b.y, w1b.z, w1b.w};
    const float w2[8] = {w2a.x, w2a.y, w2a.z, w2a.w, w2b.x, w2b.y, w2b.z, w2b.w};
    const float bs[8] = {ba.x, ba.y, ba.z, ba.w, bb.x, bb.y, bb.z, bb.w};
    const float sc = c < 1024 ? 0.08838834764831845f : 1.f;
#pragma unroll 2
    for (int i = 0; i < 8; ++i) {
      const int item = i * NT + tid;
      const int row = r0 + (item >> 6);
      const int pos = row_pos(row), L = row < NTOK_C ? L_C : L_L;
      const bf16_t* p = PR + (size_t)row * 4096 + c;
      const U4 z4{0u, 0u, 0u, 0u};
      U4 xm = pos > 0 ? ld16(p - 4096) : z4, x0 = ld16(p), xp = pos < L - 1 ? ld16(p + 4096) : z4;
      const unsigned am[4] = {xm.x, xm.y, xm.z, xm.w}, a0[4] = {x0.x, x0.y, x0.z, x0.w}, ap[4] = {xp.x, xp.y, xp.z, xp.w};
      float o[8];
#pragma unroll
      for (int j = 0; j < 8; ++j) {
        float vm = (j & 1) ? bfhi(am[j >> 1]) : bflo(am[j >> 1]);
        float v0 = (j & 1) ? bfhi(a0[j >> 1]) : bflo(a0[j >> 1]);
        float vp = (j & 1) ? bfhi(ap[j >> 1]) : bflo(ap[j >> 1]);
        o[j] = silu_f(vm * w0[j] + v0 * w1[j] + vp * w2[j] + bs[j]) * sc;
      }
      bf16_t* dst = c < 1024 ? QC + (size_t)row * 1024 + c : KC + (size_t)row * 1024 + (c - 1024);
      st16(dst, U4{pack2(o[0], o[1]), pack2(o[2], o[3]), pack2(o[4], o[5]), pack2(o[6], o[7])});
    }
  }
}
constexpr int ML_LD = 136;
constexpr int ML_SLW = 64;
constexpr int ML_NSL = 128 / ML_SLW;
constexpr int ML_NVT = ML_SLW / 16 + 1;
constexpr int ML_VR = 16 * ML_NVT;
constexpr int ML_NVL = ML_SLW / 32;
constexpr int ML_LDV = ML_VR + 8;
DEV void phase_mlstm(const Params& P, unsigned char* smem) {
  bf16_t* Ks = reinterpret_cast<bf16_t*>(smem);
  bf16_t* Vn = Ks + 128 * ML_LD;
  bf16_t* Vwn = Vn + 128 * ML_LDV;
  bf16_t* Ct0 = Vwn + 128 * ML_LDV;
  float* cs = reinterpret_cast<float*>(Ct0 + 2 * ML_VR * ML_LD);
  float* Mt = cs + 128; float* bt = Mt + 128; float* misc = bt + 128;
  int* qslot = reinterpret_cast<int*>(misc + 8);
  unsigned* qcnt = reinterpret_cast<unsigned*>(P.ws + OFF_QCNT) + 32;
  const int tid = threadIdx.x, lane = tid & 63, w = tid >> 6, lr = lane & 15, lq = lane >> 4;
  const bf16_t* PR = wsp<bf16_t>(P, OFF_PROJ1);
  const bf16_t* QC = wsp<bf16_t>(P, OFF_QC); const bf16_t* KC = wsp<bf16_t>(P, OFF_KC);
  constexpr int TPS = 16 * ML_NSL;
  constexpr int NLAT = NB_L * TPS, NTASK = (NB_L + NB_C) * TPS;
  constexpr int TABG = 16;
  for (;;) {
    const int task = peer_pull(qcnt, qslot);
    if (task >= NTASK + TAB_TILES / TABG) break;
    if (task >= NTASK) {
      for (int i = 0; i < TABG; ++i) job_tab(P, 1, (task - NTASK) * TABG + i);
      continue;
    }
    const int seq = task < NLAT ? NB_C + task / TPS : (task - NLAT) / TPS;
    const int rem = task % TPS, head = rem / (2 * ML_NSL), dir = (rem / ML_NSL) & 1, sl = rem % ML_NSL;
    const int L = seq_len(seq), nchunk = L / 128, rbase = seq_start(seq);
    bf16_t* HO = wsp<bf16_t>(P, OFF_PROJ1) + (dir ? 1024 : 0);
    f32x4 Cacc[ML_NVT];
    float m_prev = 0.f;
#pragma unroll
    for (int vt = 0; vt < ML_NVT; ++vt) Cacc[vt] = f32x4{0.f, 0.f, 0.f, 0.f};
    if (seq >= NB_C) {
      const size_t sb = ((size_t)(seq - NB_C) * 2 + dir) * 8 + head;
      const float* C0 = P.in[I_MLC] + sb * 16384;
      const int k = 16 * w + lr;
#pragma unroll
      for (int vt = 0; vt < ML_NVT - 1; ++vt) { F4 c = ldf4(C0 + (size_t)k * 128 + sl * ML_SLW + 16 * vt + 4 * lq); Cacc[vt] = f32x4{c.x, c.y, c.z, c.w}; }
      if (lq == 0) Cacc[ML_NVT - 1][0] = P.in[I_MLN][sb * 128 + k];
      m_prev = P.in[I_MLM][sb];
    }
    if (tid < 128) {
      st16(Vn + tid * ML_LDV + ML_SLW, U4{0x3f80u, 0u, 0u, 0u}); st16(Vn + tid * ML_LDV + ML_SLW + 8, U4{0u, 0u, 0u, 0u});
      st16(Vn + tid * ML_LDV + ML_SLW + 16, U4{0u, 0u, 0u, 0u});
      st16(Vwn + tid * ML_LDV + ML_SLW + 8, U4{0u, 0u, 0u, 0u}); st16(Vwn + tid * ML_LDV + ML_SLW + 16, U4{0u, 0u, 0u, 0u});
    }
#pragma unroll
    for (int vt = 0; vt < ML_NVT; ++vt)
#pragma unroll
      for (int r = 0; r < 4; ++r) Ct0[(16 * vt + 4 * lq + r) * ML_LD + 16 * w + lr] = f2bf(Cacc[vt][r]);
    U4 kreg[4], vreg[ML_NVL], qreg[4]; float gsb[2] = {0.f, 0.f}, gsc[2] = {0.f, 0.f}, gsm[2] = {0.f, 0.f}; float cs_row = 0.f, pm_last = 0.f;
    const float* GSq = wsp<float>(P, OFF_GS);
    auto prefetch = [&](int ci) {
      {
        const int s = tid >> 2, cg = (tid & 3) * 32;
        const int off = ci * 128 + s;
        const int row = rbase + (dir ? L - 1 - off : off);
#pragma unroll
        for (int q8 = 0; q8 < 4; ++q8) kreg[q8] = ld16(KC + (size_t)row * 1024 + head * 128 + cg + q8 * 8);
#pragma unroll
        for (int i = 0; i < ML_NVL; ++i) vreg[i] = ld16(PR + (size_t)row * 4096 + 2048 + head * 128 + sl * ML_SLW + (tid & 3) * (ML_SLW / 4) + i * 8);
      }
      {
        const int off = ci * 128 + 16 * (w < 4 ? w : 11 - w) + lr;
        const int row = rbase + (dir ? L - 1 - off : off);
#pragma unroll
        for (int kk = 0; kk < 4; ++kk) qreg[kk] = ld16(QC + (size_t)row * 1024 + head * 128 + kk * 32 + lq * 8);
      }
      {
        const int tc = (rbase >> 7) + (dir ? nchunk - 1 - ci : ci);
        const float* g = GSq + ((size_t)(tc * 8 + head) * 2 + dir) * 384;
        cs_row = g[128 + (tid >> 2)]; pm_last = g[256 + 127];
        if (w == 0) {
#pragma unroll
          for (int hf = 0; hf < 2; ++hf) { gsb[hf] = g[lane + 64 * hf]; gsc[hf] = g[128 + lane + 64 * hf]; gsm[hf] = g[256 + lane + 64 * hf]; }
        }
      }
    };
    prefetch(0);
    for (int ci = 0; ci < nchunk; ++ci) {
      const bf16_t* Ct = Ct0 + (ci & 1) * ML_VR * ML_LD;
      bf16_t* Cn = Ct0 + ((ci + 1) & 1) * ML_VR * ML_LD;
      SYNC();
      if (w == 0) {
#pragma unroll
        for (int hf = 0; hf < 2; ++hf) { const int s = lane + 64 * hf; cs[s] = gsc[hf]; bt[s] = gsb[hf]; Mt[s] = fmaxf(m_prev, gsm[hf]); }
        if (lane == 63) { misc[0] = gsb[1]; misc[1] = fmaxf(m_prev, gsm[1]); }
      }
      {
        const int s = tid >> 2, cg = (tid & 3) * 32;
#pragma unroll
        for (int q8 = 0; q8 < 4; ++q8) st16(Ks + s * ML_LD + cg + q8 * 8, kreg[q8]);
        const float ws = __expf(cs_row - fmaxf(m_prev, pm_last));
#pragma unroll
        for (int i = 0; i < ML_NVL; ++i) {
          const int vc = (tid & 3) * (ML_SLW / 4) + i * 8;
          st16(Vn + s * ML_LDV + vc, vreg[i]);
          const unsigned va[4] = {vreg[i].x, vreg[i].y, vreg[i].z, vreg[i].w};
          st16(Vwn + s * ML_LDV + vc, U4{pack2(bflo(va[0]) * ws, bfhi(va[0]) * ws), pack2(bflo(va[1]) * ws, bfhi(va[1]) * ws),
                                          pack2(bflo(va[2]) * ws, bfhi(va[2]) * ws), pack2(bflo(va[3]) * ws, bfhi(va[3]) * ws)});
        }
        if ((tid & 3) == 0) st16(Vwn + s * ML_LDV + ML_SLW, U4{(unsigned)f2bf(ws), 0u, 0u, 0u});
      }
      bf16x8 qf[4];
#pragma unroll
      for (int kk = 0; kk < 4; ++kk) qf[kk] = as_frag(qreg[kk]);
      SYNC();
      prefetch(ci + 1 < nchunk ? ci + 1 : ci);
      const float M_last = misc[1], b_last = misc[0];
      const int tb = w < 4 ? w : 11 - w;
      const int t = 16 * tb + lr;
      const float M_t = Mt[t];
      f32x4 accn[ML_NVT];
#pragma unroll
      for (int vt = 0; vt < ML_NVT; ++vt) {
        accn[vt] = f32x4{0.f, 0.f, 0.f, 0.f};
#pragma unroll
        for (int kk = 0; kk < 4; ++kk) accn[vt] = mfma16(as_frag(ld16(Ct + (16 * vt + lr) * ML_LD + kk * 32 + lq * 8)), qf[kk], accn[vt]);
        const float wi = __expf(m_prev - M_t);
#pragma unroll
        for (int r = 0; r < 4; ++r) accn[vt][r] *= wi;
      }
      for (int j2 = 0; 2 * j2 <= tb; ++j2) {
        unsigned pk[4] = {0u, 0u, 0u, 0u};
#pragma unroll
        for (int hh = 0; hh < 2; ++hh) {
          const int i = 2 * j2 + hh;
          if (i <= tb) {
            f32x4 sa = f32x4{0.f, 0.f, 0.f, 0.f};
#pragma unroll
            for (int kk = 0; kk < 4; ++kk) sa = mfma16(as_frag(ld16(Ks + (16 * i + lr) * ML_LD + kk * 32 + lq * 8)), qf[kk], sa);
            float pv[4];
#pragma unroll
            for (int r = 0; r < 4; ++r) {
              const int s = 16 * i + 4 * lq + r;
              pv[r] = s <= t ? sa[r] * __expf(cs[s] - M_t) : 0.f;
            }
            pk[hh * 2] = pack2(pv[0], pv[1]); pk[hh * 2 + 1] = pack2(pv[2], pv[3]);
          }
        }
        const bf16x8 pf = as_frag(U4{pk[0], pk[1], pk[2], pk[3]});
#pragma unroll
        for (int vt = 0; vt < ML_NVT; ++vt) {
          const bf16_t* vp = Vn + (32 * j2 + 4 * lq + (lr >> 2)) * ML_LDV + 16 * vt + 4 * (lr & 3);
          accn[vt] = mfma16(as_frag2(lds_tr_read(vp), lds_tr_read(vp + 16 * ML_LDV)), pf, accn[vt]);
        }
      }
      {
        const float den = __shfl(accn[ML_NVT - 1][0], lr);
        const float flo = __expf(-(bt[t] + M_t));
        const float inv = 1.f / fmaxf(fabsf(den), flo);
        const int off = ci * 128 + t;
        const int row = dir ? rbase + L - 1 - off : rbase + off;
#pragma unroll
        for (int vt = 0; vt < ML_NVT - 1; ++vt)
          st8(HO + (size_t)row * HLD + head * 128 + sl * ML_SLW + 16 * vt + 4 * lq,
              U2{pack2(accn[vt][0] * inv, accn[vt][1] * inv), pack2(accn[vt][2] * inv, accn[vt][3] * inv)});
      }
      {
        const float keep = __expf(m_prev - M_last);
        bf16x8 kf[4];
#pragma unroll
        for (int ss = 0; ss < 4; ++ss) {
          const bf16_t* kp = Ks + (32 * ss + 8 * lq + (lr >> 2)) * ML_LD + 16 * w + 4 * (lr & 3);
          kf[ss] = as_frag2(lds_tr_read(kp), lds_tr_read(kp + 4 * ML_LD));
        }
#pragma unroll
        for (int vt = 0; vt < ML_NVT; ++vt) {
#pragma unroll
          for (int r = 0; r < 4; ++r) Cacc[vt][r] *= keep;
#pragma unroll
          for (int ss = 0; ss < 4; ++ss) {
            const bf16_t* wp = Vwn + (32 * ss + 8 * lq + (lr >> 2)) * ML_LDV + 16 * vt + 4 * (lr & 3);
            Cacc[vt] = mfma16(as_frag2(lds_tr_read(wp), lds_tr_read(wp + 4 * ML_LDV)), kf[ss], Cacc[vt]);
          }
#pragma unroll
          for (int r = 0; r < 4; ++r) Cn[(16 * vt + 4 * lq + r) * ML_LD + 16 * w + lr] = f2bf(Cacc[vt][r]);
        }
        m_prev = b_last + M_last;
      }
    }
    if (seq < NB_C) {
      const size_t sb = ((size_t)seq * 2 + dir) * 8 + head;
      const int k = 16 * w + lr;
#pragma unroll
      for (int vt = 0; vt < ML_NVT - 1; ++vt)
        stf4(P.out + OUT_MLC + sb * 16384 + (size_t)k * 128 + sl * ML_SLW + 16 * vt + 4 * lq, F4{Cacc[vt][0], Cacc[vt][1], Cacc[vt][2], Cacc[vt][3]});
      if (sl == 0 && lq == 0) P.out[OUT_MLN + sb * 128 + k] = Cacc[ML_NVT - 1][0];
      if (sl == 0 && tid == 0) P.out[OUT_MLM + sb] = m_prev;
    }
  }
}
DEV void phase_mlstm_norm(const Params& P) {
  const int lane = threadIdx.x & 63, w = threadIdx.x >> 6;
  const bf16_t* PR = wsp<bf16_t>(P, OFF_PROJ1);
  const bf16_t* HF = PR; const bf16_t* HB = PR + 1024;
  bf16_t* HN = wsp<bf16_t>(P, OFF_RA);
  for (int r = blockIdx.x * NW + w; r < NTOK; r += gridDim.x * NW) {
    float h[16], o[16];
#pragma unroll
    for (int hh = 0; hh < 2; ++hh) {
      const int c = hh * 512 + lane * 8;
      U4 a = ld16(HF + (size_t)r * HLD + c), b = ld16(HB + (size_t)r * HLD + c), ov = ld16(PR + (size_t)r * 4096 + 3072 + c);
      const unsigned aa[4] = {a.x, a.y, a.z, a.w}, bb[4] = {b.x, b.y, b.z, b.w}, oo[4] = {ov.x, ov.y, ov.z, ov.w};
#pragma unroll
      for (int j = 0; j < 4; ++j) {
        h[hh * 8 + 2 * j] = bflo(aa[j]) + bflo(bb[j]); h[hh * 8 + 2 * j + 1] = bfhi(aa[j]) + bfhi(bb[j]);
        o[hh * 8 + 2 * j] = bflo(oo[j]); o[hh * 8 + 2 * j + 1] = bfhi(oo[j]);
      }
    }
#pragma unroll
    for (int hh = 0; hh < 2; ++hh) {
      const int c = hh * 512 + lane * 8;
      float ss = 0.f;
#pragma unroll
      for (int j = 0; j < 8; ++j) ss += h[hh * 8 + j] * h[hh * 8 + j];
      ss += __shfl_xor(ss, 1); ss += __shfl_xor(ss, 2); ss += __shfl_xor(ss, 4); ss += __shfl_xor(ss, 8);
      const float rs = rsqrtf(ss * (1.f / 128.f) + EPS);
      const F4 g0 = ldf4(P.in[I_MLNORMG] + c), g1 = ldf4(P.in[I_MLNORMG] + c + 4);
      const float ng[8] = {g0.x, g0.y, g0.z, g0.w, g1.x, g1.y, g1.z, g1.w};
      unsigned pk[4];
#pragma unroll
      for (int j = 0; j < 4; ++j) pk[j] = pack2(h[hh * 8 + 2 * j] * rs * ng[2 * j] * silu_f(o[hh * 8 + 2 * j]), h[hh * 8 + 2 * j + 1] * rs * ng[2 * j + 1] * silu_f(o[hh * 8 + 2 * j + 1]));
      st16(HN + (size_t)r * 1024 + c, U4{pk[0], pk[1], pk[2], pk[3]});
    }
  }
}
DEV void phase_final(const Params& P) {
  const int lane = threadIdx.x & 63, w = threadIdx.x >> 6;
  const float* X = wsp<float>(P, OFF_X);
  const float* g = P.in[I_FINALG];
  F4 gq[4];
#pragma unroll
  for (int i = 0; i < 4; ++i) gq[i] = ldf4(g + i * 256 + lane * 4);
  for (int r = blockIdx.x * NW + w; r < NTOK; r += gridDim.x * NW) {
    const float* x = X + (size_t)r * 1024;
    F4 v[4]; float ss = 0.f;
#pragma unroll
    for (int i = 0; i < 4; ++i) { v[i] = ldf4(x + i * 256 + lane * 4); ss += v[i].x * v[i].x + v[i].y * v[i].y + v[i].z * v[i].z + v[i].w * v[i].w; }
    ss = wave_sum(ss);
    const float rs = rsqrtf(ss * (1.f / 1024.f) + EPS);
#pragma unroll
    for (int i = 0; i < 4; ++i) {
      const int c = i * 256 + lane * 4;
      const F4 gg = gq[i];
      stf4_nt(P.out + OUT_Y + (size_t)r * 1024 + c, F4{v[i].x * rs * gg.x, v[i].y * rs * gg.y, v[i].z * rs * gg.z, v[i].w * rs * gg.w});
    }
  }
}


constexpr int NPHASE = 25;
constexpr size_t SMEM_BYTES = 160 * 1024;
#ifndef ONLY_PHASE
#define ONLY_PHASE -1
#endif
#ifndef EXCL_MASK
#define EXCL_MASK 0u
#endif
#define PH_EN(k) ((ONLY_PHASE < 0 || ONLY_PHASE == (k)) && !(((EXCL_MASK) >> (k)) & 1u))
#ifndef PROBE_MASK
#define PROBE_MASK 0u
#endif
#ifndef PROBE_SYNC2
#define PROBE_SYNC2 0
#endif
#define PROBE_ON(k) (((PROBE_MASK) >> (k)) & 1u)
#define PROBE_SCALE(k) (PROBE_ON(k) ? 0.5f : 1.0f)
DEV void run_phase(const Params& P, int ph, unsigned char* smem, int rep = 0) {
  switch (ph) {
    case 0: if (PH_EN(0)) { phase_prep(P, smem); } break;
    case 1: if (PH_EN(1)) { phase_norm(P, 0, 0, false); phase_hyena_filters(P, smem); } break;
    case 2: if (PH_EN(2)) { gemm_phase<256>(wsp<bf16_t>(P, OFF_RA), 1024, wsp<bf16_t>(P, OFF_WEVIN), 1024, NTOK, 2048, 1024,
                       EpiStoreBf16{wsp<bf16_t>(P, OFF_PROJ0), 2048}, smem); } break;
    case 3: if (PH_EN(3)) { phase_l0_a(P, smem); } break;
    case 4: if (PH_EN(4)) { phase_s5_carry(P); } break;
    case 5: if (PH_EN(5)) { phase_l0_b(P, smem); } break;
    case 6: if (PH_EN(6)) { phase_l0_c(P, smem); } break;
    case 7: if (PH_EN(7)) { gemm_phase<128>(wsp<bf16_t>(P, OFF_RA), 1024, wsp<bf16_t>(P, OFF_WEVOUT), 1024, NTOK, 1024, 1024,
                       EpiResid{wsp<float>(P, OFF_X), wsp<float>(P, OFF_MOD) + 2 * 1024, PROBE_SCALE(7)}, smem); } break;
    case 8: if (PH_EN(8)) { phase_norm(P, 0, 1, true); phase_wf(P, 0, smem); } break;
    case 9: if (PH_EN(9)) { gemm_phase<256>(wsp<bf16_t>(P, OFF_RA), 1024, wsp<bf16_t>(P, OFF_WF), 1024, NTOK, 2048, 1024,
                       EpiTopk{wsp<unsigned short>(P, OFF_EIDX), wsp<bf16_t>(P, OFF_EGT)}, smem); } break;
    case 10: if (PH_EN(10)) { phase_peer_u(P, 0, rep, smem); } break;
    case 11: if (PH_EN(11)) { phase_peer_act(P, smem); } break;
    case 12: if (PH_EN(12)) { phase_peer_v(P, 0, PROBE_SCALE(12), rep, smem); } break;
    case 13: if (PH_EN(13)) { phase_norm(P, 1, 0, false); } break;
    case 14: if (PH_EN(14)) { phase_odin(P, smem); } break;
    case 15: if (PH_EN(15)) { phase_qkconv(P); phase_gate_scan(P); } break;
    case 16: if (PH_EN(16)) { phase_mlstm(P, smem); } break;
    case 17: if (PH_EN(17)) { phase_mlstm_norm(P); } break;
    case 18: if (PH_EN(18)) { gemm_phase<128>(wsp<bf16_t>(P, OFF_RA), 1024, wsp<bf16_t>(P, OFF_WODOUT), 1024, NTOK, 1024, 1024,
                        EpiResid{wsp<float>(P, OFF_X), wsp<float>(P, OFF_MOD) + (size_t)NCOND * 6144 + 2 * 1024, PROBE_SCALE(18)}, smem); } break;
    case 19: if (PH_EN(19)) { phase_norm(P, 1, 1, false); phase_wf(P, 1, smem); } break;
    case 20: if (PH_EN(20)) { gemm_phase<256>(wsp<bf16_t>(P, OFF_RA), 1024, wsp<bf16_t>(P, OFF_WF), 1024, NTOK, 2048, 1024,
                        EpiTopk{wsp<unsigned short>(P, OFF_EIDX), wsp<bf16_t>(P, OFF_EGT)}, smem); } break;
    case 21: if (PH_EN(21)) { phase_peer_u(P, 1, rep, smem); } break;
    case 22: if (PH_EN(22)) { phase_peer_act(P, smem); } break;
    case 23: if (PH_EN(23)) { phase_peer_v(P, 1, PROBE_SCALE(23), rep, smem); } break;
    case 24: if (PH_EN(24)) { phase_final(P); } break;
    default: break;
  }
}
#ifndef EMU
#define PHASE_SYNC(PH) do { if ((PH) == 1) GRID_SYNC(); else xcd_barrier(xb); } while (0)
#else
#define PHASE_SYNC(PH) GRID_SYNC()
#endif
template <int PH> DEV void run_phase_t(const Params& P, int ph_lo, int ph_hi, unsigned char* smem, const XcdBarrier& xb) {
  if (PH >= ph_lo && PH < ph_hi) {
    if (PH > ph_lo) { PHASE_SYNC(PH); if (PROBE_SYNC2) PHASE_SYNC(PH); }
    run_phase(P, PH, smem);
    if (PROBE_ON(PH)) { PHASE_SYNC(PH); run_phase(P, PH, smem, 1); }
  }
}
template <int... I> struct IntSeq {};
template <int N, int... I> struct MakeSeq : MakeSeq<N - 1, N - 1, I...> {};
template <int... I> struct MakeSeq<0, I...> { typedef IntSeq<I...> type; };
template <int... I> DEV void run_all(const Params& P, int lo, int hi, unsigned char* smem, const XcdBarrier& xb, IntSeq<I...>) {
  int dummy[] = {(run_phase_t<I>(P, lo, hi, smem, xb), 0)...};
  (void)dummy;
}
__global__ void __launch_bounds__(NT, 1) mega_kernel(Params P, int ph_lo, int ph_hi) {
  SMEM_DECL(smem);
#ifndef EMU
  volatile unsigned* st = reinterpret_cast<volatile unsigned*>(smem + SMEM_BYTES - 16);
  if (threadIdx.x == 0) { st[0] = 0u; st[1] = 0u; st[2] = 0u; st[3] = 0u; }
  __syncthreads();
  XcdBarrier xb = xcd_barrier_post(reinterpret_cast<unsigned*>(P.ws + OFF_BAR), st);
#else
  XcdBarrier xb{0};
#endif
  run_all(P, ph_lo, ph_hi, smem, xb, typename MakeSeq<NPHASE>::type());
}

#ifndef EMU
extern "C" void kernel_launch(void* const* d_in, const int* in_sizes, int n_in, void* d_out, int out_size, void* d_ws,
                              size_t ws_size, hipStream_t stream) {
  Params P{};
  for (int i = 0; i < 45; ++i) P.in[i] = (const float*)d_in[i];
  P.out = (float*)d_out; P.ws = (unsigned char*)d_ws;
  static int grid_blocks = 0;
  if (!grid_blocks) {
    int dev = 0, cus = 0, per_cu = 0;
    hipGetDevice(&dev);
    hipDeviceGetAttribute(&cus, hipDeviceAttributeMultiprocessorCount, dev);
    hipFuncSetAttribute((const void*)mega_kernel, hipFuncAttributeMaxDynamicSharedMemorySize, (int)SMEM_BYTES);
    hipOccupancyMaxActiveBlocksPerMultiprocessor(&per_cu, mega_kernel, NT, SMEM_BYTES);
    if (per_cu > 1) per_cu = 1;
    grid_blocks = cus * per_cu;
    if (grid_blocks <= 0) grid_blocks = 256;
  }
  hipMemsetAsync(P.ws + OFF_BAR, 0, SZ_BAR, stream);
  int lo = 0, hi = NPHASE;
  void* args[] = {&P, &lo, &hi};
  hipError_t e = hipLaunchCooperativeKernel((const void*)mega_kernel, dim3(grid_blocks), dim3(NT), args, (unsigned)SMEM_BYTES, stream);
  if (e != hipSuccess) fprintf(stderr, "cooperative launch failed: %s (grid %d)\n", hipGetErrorString(e), grid_blocks);
}
#endif
```

```cpp
#ifndef EMU
#include <hip/hip_runtime.h>
#include <hip/hip_cooperative_groups.h>
#include <cstdio>
#include <cstdint>
typedef __attribute__((ext_vector_type(8))) short bf16x8;
typedef __attribute__((ext_vector_type(4))) float f32x4;
#define DEV __device__ __forceinline__
#define DEVM __device__ __forceinline__
DEV f32x4 mfma16(bf16x8 a, bf16x8 b, f32x4 c) { return __builtin_amdgcn_mfma_f32_16x16x32_bf16(a, b, c, 0, 0, 0); }
typedef __attribute__((ext_vector_type(4))) short bf16x4;
DEV f32x4 mfma16k16(bf16x4 a, bf16x4 b, f32x4 c) { return __builtin_amdgcn_mfma_f32_16x16x16bf16_1k(a, b, c, 0, 0, 0); }
DEV float u2f(unsigned u) { return __uint_as_float(u); }
DEV unsigned f2u(float f) { return __float_as_uint(f); }
#define SYNC() __syncthreads()
#define GRID_SYNC() cooperative_groups::this_grid().sync()
#define SMEM_DECL(name) extern __shared__ __attribute__((aligned(16))) unsigned char name[]
DEV void glds16(const void* g, void* l) {
  __builtin_amdgcn_global_load_lds((const __attribute__((address_space(1))) unsigned*)g, (__attribute__((address_space(3))) unsigned*)l, 16, 0, 0);
}
DEV void glds_wait() { asm volatile("s_waitcnt vmcnt(0)" ::: "memory"); }
DEV void asm_wait_vm6() { asm volatile("s_waitcnt vmcnt(6)" ::: "memory"); }
DEV int tid_opaque() { int t = threadIdx.x; asm volatile("" : "+v"(t) :: "memory"); return t; }
template <int CTRL> DEV float dpp_mov(float v) { return __int_as_float(__builtin_amdgcn_mov_dpp(__float_as_int(v), CTRL, 0xF, 0xF, true)); }
#else
#define DEV static inline
#define DEVM inline
DEV f32x4 mfma16(bf16x8 a, bf16x8 b, f32x4 c) { return emu_mfma_16x16x32_bf16(a, b, c); }
typedef __attribute__((ext_vector_type(4))) short bf16x4;
DEV f32x4 mfma16k16(bf16x4 a, bf16x4 b, f32x4 c) {
  bf16x8 a8 = {0, 0, 0, 0, 0, 0, 0, 0}, b8 = {0, 0, 0, 0, 0, 0, 0, 0};
  const int q = tl_cur->lane >> 4;
  EmuFiber* f = tl_cur; EmuWave& w = f->blk->waves[f->wave]; int par = w.gen & 1; int l = f->lane;
  for (int j = 0; j < 4; ++j) { w.mbuf[par][l].a[j] = a[j]; w.mbuf[par][l].b[j] = b[j]; }
  emu_wave_barrier();
  int col = l & 15; f32x4 d = c; (void)a8; (void)b8; (void)q;
  for (int r = 0; r < 4; ++r) { int row = 4 * (l >> 4) + r; float acc = c[r];
    for (int k = 0; k < 16; ++k) acc += emu_bf2f(w.mbuf[par][row + 16 * (k >> 2)].a[k & 3]) * emu_bf2f(w.mbuf[par][col + 16 * (k >> 2)].b[k & 3]);
    d[r] = acc; }
  return d;
}
DEV float u2f(unsigned u) { float f; memcpy(&f, &u, 4); return f; }
DEV unsigned f2u(float f) { unsigned u; memcpy(&u, &f, 4); return u; }
#define SYNC() __syncthreads()
#define GRID_SYNC() emu_grid_sync()
#define SMEM_DECL(name) unsigned char* name = EMU_SMEM_PTR()
DEV void glds16(const void* g, void* l) { memcpy(l, g, 16); }
DEV void glds_wait() {}
DEV void asm_wait_vm6() {}
DEV int tid_opaque() { return threadIdx.x; }
template <int CTRL> DEV float dpp_mov(float v) { const int l = tl_cur->lane; const int src = CTRL == 0xB1 ? (l ^ 1) : CTRL == 0x4E ? (l ^ 2) : ((l & ~7) | (7 - (l & 7))); return emu_shfl(v, src); }
#endif

#ifndef CFG_BATCH
#define CFG_BATCH 32
#endif
#ifndef CFG_SEQ
#define CFG_SEQ 256
#endif
#ifndef CFG_DEC_BATCH
#define CFG_DEC_BATCH 4
#endif
#ifndef CFG_DEC_SEQ
#define CFG_DEC_SEQ 4096
#endif
constexpr int D = 1024;
constexpr int NB_C = CFG_BATCH, L_C = CFG_SEQ, NB_L = CFG_DEC_BATCH, L_L = CFG_DEC_SEQ;
constexpr int NTOK_C = NB_C * L_C, NTOK_L = NB_L * L_L, NTOK = NTOK_C + NTOK_L;
constexpr int NSEQ = NB_C + NB_L;
constexpr int NCOND = 1 + NB_L;
constexpr int NT = 512;
constexpr int NW = NT / 64;
constexpr float EPS = 1e-6f;
constexpr int clog2(int n) { return n <= 1 ? 0 : 1 + clog2(n / 2); }
constexpr int LOG_NC = clog2(2 * L_C), LOG_NL = clog2(2 * L_L);
static_assert((1 << LOG_NC) == 2 * L_C && (1 << LOG_NL) == 2 * L_L, "pow2 seq");
static_assert(L_C % 256 == 0 && L_L % 256 == 0, "seq multiple of 256");
static_assert(NB_C % 2 == 0 && NB_L % 2 == 0, "even batches");
constexpr int ODIN_N = 4128, ODIN_NPAD = 4352;

typedef unsigned short bf16_t;
DEV float bf2f(bf16_t h) { return u2f(((unsigned)h) << 16); }
DEV bf16_t f2bf(float f) { unsigned u = f2u(f); u += 0x7fffu + ((u >> 16) & 1u); return (bf16_t)(u >> 16); }
DEV unsigned pack2(float a, float b) { return (unsigned)f2bf(a) | ((unsigned)f2bf(b) << 16); }
DEV float bflo(unsigned u) { return u2f(u << 16); }
DEV float bfhi(unsigned u) { return u2f(u & 0xffff0000u); }
DEV float silu_f(float x) { return x / (1.f + __expf(-x)); }
DEV float sigmoid_f(float x) { return 1.f / (1.f + __expf(-x)); }
DEV float gelu_f(float x) { float u = 0.7978845608028654f * (x + 0.044715f * x * x * x); float e = __expf(-2.f * fabsf(u)); float t = (1.f - e) / (1.f + e); t = u < 0.f ? -t : t; return 0.5f * x * (1.f + t); }
DEV float log_sigmoid_f(float x) { return fminf(x, 0.f) - log1pf(__expf(-fabsf(x))); }
DEV float sum8_dpp(float v) { v += dpp_mov<0xB1>(v); v += dpp_mov<0x4E>(v); v += dpp_mov<0x141>(v); return v; }
DEV float wave_sum(float v) { for (int m = 32; m >= 1; m >>= 1) v += __shfl_xor(v, m); return v; }
DEV float wave_max(float v) { for (int m = 32; m >= 1; m >>= 1) v = fmaxf(v, __shfl_xor(v, m)); return v; }

typedef __attribute__((ext_vector_type(2))) float f32x2_t;
#ifndef EMU
DEV f32x2_t fp8lo2(unsigned w) { return __builtin_amdgcn_cvt_pk_f32_fp8((int)w, false); }
DEV f32x2_t fp8hi2(unsigned w) { return __builtin_amdgcn_cvt_pk_f32_fp8((int)w, true); }
DEV int uniform_i(int v) { return __builtin_amdgcn_readfirstlane(v); }
DEV unsigned pack_fp8x4(float a, float b, float c, float d) {
  int r = __builtin_amdgcn_cvt_pk_fp8_f32(a, b, 0, false);
  r = __builtin_amdgcn_cvt_pk_fp8_f32(c, d, r, true);
  return (unsigned)r;
}
DEV void unpack_fp8x4(unsigned w, float* o) {
  f32x2_t lo = __builtin_amdgcn_cvt_pk_f32_fp8((int)w, false), hi = __builtin_amdgcn_cvt_pk_f32_fp8((int)w, true);
  o[0] = lo[0]; o[1] = lo[1]; o[2] = hi[0]; o[3] = hi[1];
}
DEV void wave_sync() { __builtin_amdgcn_wave_barrier(); }
DEV void wave_lds_fence() { __syncthreads(); }
#else
DEV unsigned emu_enc_fp8(float x) {
  unsigned sgn = x < 0.f ? 0x80u : 0u; float ax = fabsf(x);
  if (!(ax == ax)) return 0x7fu;
  if (ax >= 448.f) return sgn | 0x7eu;
  if (ax < 0.015625f) { int q = (int)nearbyintf(ax * 512.f); return sgn | (unsigned)(q >= 8 ? 0x08 : q); }
  int e; float fr = frexpf(ax, &e);
  e -= 1; float m = fr * 2.f - 1.f;
  int qm = (int)nearbyintf(m * 8.f);
  if (qm == 8) { qm = 0; e += 1; }
  unsigned b = (unsigned)((e + 7) << 3) | (unsigned)qm;
  if (b > 0x7eu) b = 0x7eu;
  return sgn | b;
}
DEV float emu_dec_fp8(unsigned b) {
  unsigned e = (b >> 3) & 15u, m = b & 7u; float v = e == 0 ? (float)m * 0.001953125f : ldexpf(1.f + (float)m * 0.125f, (int)e - 7);
  return (b & 0x80u) ? -v : v;
}
DEV unsigned pack_fp8x4(float a, float b, float c, float d) { return emu_enc_fp8(a) | (emu_enc_fp8(b) << 8) | (emu_enc_fp8(c) << 16) | (emu_enc_fp8(d) << 24); }
DEV void unpack_fp8x4(unsigned w, float* o) { for (int i = 0; i < 4; ++i) o[i] = emu_dec_fp8((w >> (8 * i)) & 255u); }
DEV f32x2_t fp8lo2(unsigned w) { f32x2_t r; r[0] = emu_dec_fp8(w & 255u); r[1] = emu_dec_fp8((w >> 8) & 255u); return r; }
DEV f32x2_t fp8hi2(unsigned w) { f32x2_t r; r[0] = emu_dec_fp8((w >> 16) & 255u); r[1] = emu_dec_fp8((w >> 24) & 255u); return r; }
DEV int uniform_i(int v) { return v; }
DEV void wave_sync() { emu_wave_barrier(); }
DEV void wave_lds_fence() { __syncthreads(); }
#endif
struct U4 { unsigned x, y, z, w; };
struct U2 { unsigned x, y; };
struct F4 { float x, y, z, w; };
struct F2 { float x, y; };
DEV U4 ld16(const void* p) { return *reinterpret_cast<const U4*>(p); }
DEV void st16(void* p, U4 v) { *reinterpret_cast<U4*>(p) = v; }
DEV U2 ld8(const void* p) { return *reinterpret_cast<const U2*>(p); }
DEV void st8(void* p, U2 v) { *reinterpret_cast<U2*>(p) = v; }
DEV F4 ldf4(const float* p) { return *reinterpret_cast<const F4*>(p); }
DEV void stf4(float* p, F4 v) { *reinterpret_cast<F4*>(p) = v; }
#ifndef EMU
DEV F4 ldf4_nt(const float* p) { const f32x4 t = __builtin_nontemporal_load(reinterpret_cast<const f32x4*>(p)); return F4{t[0], t[1], t[2], t[3]}; }
DEV void stf4_nt(float* p, F4 v) { const f32x4 t = {v.x, v.y, v.z, v.w}; __builtin_nontemporal_store(t, reinterpret_cast<f32x4*>(p)); }
#else
DEV F4 ldf4_nt(const float* p) { return ldf4(p); }
DEV void stf4_nt(float* p, F4 v) { stf4(p, v); }
#endif
DEV bf16x8 as_frag(U4 v) { bf16x8 r; memcpy(&r, &v, 16); return r; }
DEV bf16x8 as_frag2(U2 a, U2 b) { U4 v{a.x, a.y, b.x, b.y}; return as_frag(v); }
#ifndef EMU
typedef short v4s_t __attribute__((ext_vector_type(4)));
DEV U2 lds_tr_read(const bf16_t* p) {
  const v4s_t r = __builtin_amdgcn_ds_read_tr16_b64_v4i16((__attribute__((address_space(3))) v4s_t*)p);
  U2 o; memcpy(&o, &r, 8); return o;
}
#else
DEV U2 lds_tr_read(const bf16_t* p) {
  const unsigned long long a = (unsigned long long)(uintptr_t)p;
  const int lane = threadIdx.x & 63, i = lane & 15, gb = lane & 48;
  unsigned short e[4];
  for (int q = 0; q < 4; ++q) {
    const int src = gb + 4 * q + (i >> 2);
    const unsigned lo = (unsigned)__shfl((int)(unsigned)(a & 0xffffffffull), src), hi = (unsigned)__shfl((int)(unsigned)(a >> 32), src);
    const bf16_t* rp = (const bf16_t*)(uintptr_t)(((unsigned long long)hi << 32) | lo);
    e[q] = rp[i & 3];
  }
  return U2{(unsigned)e[0] | ((unsigned)e[1] << 16), (unsigned)e[2] | ((unsigned)e[3] << 16)};
}
#endif

DEV int row_seq(int r) { return r < NTOK_C ? r / L_C : NB_C + (r - NTOK_C) / L_L; }
DEV int row_pos(int r) { return r < NTOK_C ? r % L_C : (r - NTOK_C) % L_L; }
DEV int row_cond(int r) { return r < NTOK_C ? 0 : 1 + (r - NTOK_C) / L_L; }
DEV int seq_start(int s) { return s < NB_C ? s * L_C : NTOK_C + (s - NB_C) * L_L; }
DEV int seq_len(int s) { return s < NB_C ? L_C : L_L; }


#ifndef EMU
#define XB_TMO      128
#define XB_XCNT(j)  (256  + 64 * (j))
#define XB_XSUB(j)  (1280 + 64 * (j))
#define XB_XGEN(j)  (2304 + 64 * (j))
#define XB_TOP      3328
#define XB_TOPGEN   3392
#define XCD_BAR_WORDS 3456
#define XB_SPIN_CAP (1u << 22)
#define LAS __attribute__((address_space(3)))
DEV unsigned xb_ld(unsigned* p) { return __hip_atomic_load(p, __ATOMIC_RELAXED, __HIP_MEMORY_SCOPE_AGENT); }
DEV unsigned xb_add(unsigned* p, unsigned v) { return __hip_atomic_fetch_add(p, v, __ATOMIC_RELAXED, __HIP_MEMORY_SCOPE_AGENT); }
DEV unsigned xb_xcc_id() { return (unsigned)__builtin_amdgcn_s_getreg((3 << 11) | 20) & 0xFu; }
#define XB_SPIN(cond, bar) do { unsigned _sp = 0; while (cond) { __builtin_amdgcn_s_sleep(1); \
    if ((++_sp & 255u) == 0u) { if (xb_ld(&(bar)[XB_TMO])) break; if (_sp > XB_SPIN_CAP) { atomicAdd(&(bar)[XB_TMO], 1u); break; } } } } while (0)
struct XcdBarrier { unsigned* bar; unsigned x; volatile unsigned* st; };
DEV XcdBarrier xcd_barrier_post(unsigned* bar, volatile unsigned* st) {
  XcdBarrier b; b.bar = bar; b.x = xb_xcc_id(); b.st = st;
  if (threadIdx.x == 0) (void)xb_add(&bar[XB_XCNT(b.x)], 1u);
  return b;
}
DEV void xcd_barrier_complete(unsigned* bar, unsigned x, unsigned& nloc, unsigned& nx) {
  const unsigned G = gridDim.x * gridDim.y * gridDim.z;
  unsigned sum, cnt, mine, sp = 0u;
  for (;;) {
    sum = 0u; cnt = 0u; mine = 0u;
#pragma unroll
    for (unsigned j = 0; j < 16; ++j) { const unsigned c = xb_ld(&bar[XB_XCNT(j)]); sum += c; cnt += (c > 0u) ? 1u : 0u; mine = (j == x) ? c : mine; }
    if (sum == G) break;
    __builtin_amdgcn_s_sleep(1);
    if ((++sp & 255u) == 0u) { if (xb_ld(&bar[XB_TMO])) break; if (sp > XB_SPIN_CAP) { atomicAdd(&bar[XB_TMO], 1u); break; } }
  }
  nloc = mine > 0u ? mine : 1u; nx = cnt > 0u ? cnt : 1u;
}
DEV void xcd_barrier(const XcdBarrier& b) {
  asm volatile("s_waitcnt vmcnt(0)" ::: "memory");
  __syncthreads();
  if (threadIdx.x == 0) {
    unsigned* bar = b.bar;
    __builtin_amdgcn_s_waitcnt(0);
    unsigned nloc = b.st[0], nx = b.st[1];
    if (nloc == 0u) { xcd_barrier_complete(bar, b.x, nloc, nx); b.st[0] = nloc; b.st[1] = nx; }
    const unsigned old = xb_add(&bar[XB_XSUB(b.x)], 1u);
    const unsigned gen = old / nloc;
    if (old + 1u == (gen + 1u) * nloc) {
      __builtin_amdgcn_fence(__ATOMIC_RELEASE, "agent");
      asm volatile("s_waitcnt vmcnt(0)" ::: "memory");
      const unsigned og = xb_add(&bar[XB_TOP], 1u);
      const unsigned tg = og / nx;
      if (og + 1u == (tg + 1u) * nx) xb_add(&bar[XB_TOPGEN], 1u);
      else XB_SPIN(xb_ld(&bar[XB_TOPGEN]) == tg, bar);
      __builtin_amdgcn_fence(__ATOMIC_ACQUIRE, "agent");
      xb_add(&bar[XB_XGEN(b.x)], 1u);
      asm volatile("s_waitcnt vmcnt(0)" ::: "memory");
    } else {
      XB_SPIN(xb_ld(&bar[XB_XGEN(b.x)]) == gen, bar);
      __builtin_amdgcn_fence(__ATOMIC_ACQUIRE, "agent");
      asm volatile("s_waitcnt vmcnt(0)" ::: "memory");
    }
  }
  __syncthreads();
}
#else
#define XCD_BAR_WORDS 3456
struct XcdBarrier { int dummy; };
#endif

constexpr size_t al256(size_t x) { return (x + 255) & ~(size_t)255; }
constexpr size_t OFF_BAR = 0;
constexpr size_t SZ_BAR = 16384;
constexpr size_t OFF_QCNT = OFF_BAR + 14336;
constexpr size_t OFF_MOD = OFF_BAR + SZ_BAR;
constexpr size_t SZ_MOD = al256((size_t)2 * NCOND * 6144 * 4);
constexpr size_t OFF_WEVIN = OFF_MOD + SZ_MOD;
constexpr size_t OFF_WGLU = OFF_WEVIN + (size_t)2048 * 1024 * 2;
constexpr size_t OFF_WEVOUT = OFF_WGLU + (size_t)512 * 512 * 2;
constexpr size_t OFF_WODIN = OFF_WEVOUT + (size_t)1024 * 1024 * 2;
constexpr size_t OFF_WODOUT = OFF_WODIN + (size_t)ODIN_NPAD * 1024 * 2;
constexpr size_t OFF_WPKQ = OFF_WODOUT + (size_t)1024 * 1024 * 2;
constexpr size_t OFF_KEYS = OFF_WPKQ + (size_t)2 * 2048 * 1024 * 2;
constexpr size_t OFF_H2 = OFF_KEYS + (size_t)2 * 16 * 128 * 128 * 2;
constexpr size_t OFF_LAMB = OFF_H2 + al256((size_t)(L_C + L_L) * 64 * 4);
constexpr size_t OFF_LAMT = OFF_LAMB + (size_t)2 * 32 * 64 * 8;
constexpr size_t OFF_BBAR = OFF_LAMT + (size_t)2 * 32 * 64 * 8;
constexpr size_t OFF_CMT = OFF_BBAR + (size_t)2 * 32 * 64 * 16 * 8;
constexpr size_t OFF_BB16 = OFF_CMT + (size_t)2 * 32 * 16 * 128 * 2;
constexpr size_t OFF_X = OFF_BB16 + (size_t)2 * 32 * 128 * 16 * 2;
constexpr size_t OFF_TAB = OFF_X + (size_t)NTOK * 1024 * 4;
constexpr size_t SZ_TAB = (size_t)2 * 16384 * 1024 * 2;
constexpr size_t OFF_RA = OFF_TAB + SZ_TAB;
constexpr size_t SZ_RA = (size_t)NTOK * 1024 * 2;
constexpr size_t OFF_RB = OFF_RA + SZ_RA;
constexpr size_t SZ_RB = (size_t)NTOK * 4096 * 2 + (size_t)NTOK * 32 * 4;
constexpr size_t OFF_RC = OFF_RB + al256(SZ_RB);
constexpr int KF_N = 2 * L_C + 2 * L_L;
constexpr size_t SZ_KF = (size_t)512 * 2 * KF_N * 8;
constexpr size_t SZ_RC = SZ_KF > (size_t)NTOK * 1024 * 2 ? SZ_KF : (size_t)NTOK * 1024 * 2;
constexpr size_t OFF_S5C = OFF_RC + al256(SZ_RC);
constexpr size_t SZ_S5C = (size_t)(NTOK / 64) * 32 * 2 * 64 * 8;
constexpr size_t WS_TOTAL = OFF_S5C + SZ_S5C;
constexpr size_t OFF_PROJ0 = OFF_RB;
constexpr size_t OFF_HT3 = OFF_RB + (size_t)NTOK * 2048 * 2;
constexpr size_t OFF_HYT = OFF_HT3 + (size_t)3 * 512 * NTOK * 2;
constexpr size_t OFF_Q = OFF_RB;
constexpr size_t OFF_WF = OFF_RB;
constexpr size_t OFF_SV = OFF_RB + (size_t)NTOK * 2048 * 2;
constexpr size_t OFF_SI = OFF_SV + (size_t)NTOK * 256 * 4;
constexpr size_t OFF_PART = OFF_RB;
constexpr size_t OFF_EIDX = OFF_SI + (size_t)NTOK * 256;
constexpr size_t OFF_EGT = OFF_EIDX + (size_t)NTOK * 128 * 4;
static_assert(OFF_EGT + (size_t)NTOK * 128 * 4 <= OFF_RB + SZ_RB, "peer buffers fit region B");
static_assert((size_t)8 * NTOK * 128 * 4 <= (size_t)NTOK * 2048 * 2, "PART fits the Q buffer");
constexpr size_t OFF_PROJ1 = OFF_RB;
constexpr size_t OFF_GATES = OFF_RB + (size_t)NTOK * 4096 * 2;
constexpr size_t OFF_KF = OFF_RC;
constexpr size_t OFF_QC = OFF_RA;
constexpr size_t OFF_KC = OFF_RC;
static_assert((size_t)NTOK * 1024 * 2 <= SZ_RC, "Kc fits region C");
constexpr size_t OFF_GS = OFF_S5C;
static_assert((size_t)(NTOK / 128) * 8 * 2 * 3 * 128 * 4 <= SZ_S5C, "GS fits");
constexpr int HLD = 4096;
constexpr size_t OFF_YS5 = OFF_TAB;

struct Params {
  const float* in[45];
  float* out;
  unsigned char* ws;
};
enum { I_XP = 0, I_XS, I_S5RE, I_S5IM, I_MLC, I_MLN, I_MLM, I_C, I_CCTX, I_NORMG, I_ADAW, I_ADAB, I_FINALG, I_EVWIN,
       I_HYCW, I_HYCB, I_HYW1, I_HYB1, I_HYW2, I_HYB2, I_HYW3, I_HYFREQ, I_HYDECAY, I_HYBIAS, I_S5ARE, I_S5AIM, I_S5BRE,
       I_S5BIM, I_S5CRE, I_S5CIM, I_S5LOGSTEP, I_S5D, I_S5GLUW, I_S5GLUB, I_EVWOUT, I_ODWIN, I_ODGATEB, I_MLCW, I_MLCB,
       I_MLNORMG, I_ODWOUT, I_PKWQ, I_PKKEYS, I_PKU, I_PKV };
constexpr size_t OUT_Y = 0;
constexpr size_t OUT_S5RE = (size_t)NTOK * 1024;
constexpr size_t OUT_S5IM = OUT_S5RE + (size_t)NB_C * 2 * 32 * 64;
constexpr size_t OUT_MLC = OUT_S5IM + (size_t)NB_C * 2 * 32 * 64;
constexpr size_t OUT_MLN = OUT_MLC + (size_t)NB_C * 2 * 8 * 128 * 128;
constexpr size_t OUT_MLM = OUT_MLN + (size_t)NB_C * 2 * 8 * 128;
constexpr size_t OUT_TOTAL = OUT_MLM + (size_t)NB_C * 2 * 8;

template <typename T> DEV T* wsp(const Params& P, size_t off) { return reinterpret_cast<T*>(P.ws + off); }

DEV void job_transpose(const float* src, bf16_t* dst, int K, int N, int Npad, int tile, unsigned char* smem) {
  float* t = reinterpret_cast<float*>(smem);
  const int ntn = Npad / 64;
  const int k0 = (tile / ntn) * 64, n0 = (tile % ntn) * 64;
  const int tid = threadIdx.x;
#pragma unroll
  for (int i = 0; i < 2; ++i) {
    const int e = tid + i * NT, kk = e >> 4, n4 = (e & 15) * 4;
    F4 v = (n0 + n4 < N) ? ldf4(src + (size_t)(k0 + kk) * N + n0 + n4) : F4{0.f, 0.f, 0.f, 0.f};
    float* tp = t + kk * 65 + n4; tp[0] = v.x; tp[1] = v.y; tp[2] = v.z; tp[3] = v.w;
  }
  SYNC();
  {
    const int nn = tid >> 3, k8 = (tid & 7) * 8;
    const float* tp = t + k8 * 65 + nn;
    st16(dst + (size_t)(n0 + nn) * K + k0 + k8, U4{pack2(tp[0], tp[65]), pack2(tp[130], tp[195]), pack2(tp[260], tp[325]), pack2(tp[390], tp[455])});
  }
  SYNC();
}
DEV void job_convert(const float* src, bf16_t* dst, int tile) {
  size_t e = (size_t)tile * 4096 + (size_t)threadIdx.x * 8;
  F4 a = ldf4(src + e), b = ldf4(src + e + 4);
  st16(dst + e, U4{pack2(a.x, a.y), pack2(a.z, a.w), pack2(b.x, b.y), pack2(b.z, b.w)});
}
DEV void job_mod(const Params& P, int task, unsigned char* smem) {
  float* sc = reinterpret_cast<float*>(smem);
  float* part = sc + NCOND * 1024;
  const int l = task / 96, ct = task % 96;
  const int tid = threadIdx.x, lane = tid & 63, w = tid >> 6;
  for (int e = tid; e < NCOND * 1024; e += NT) {
    int cb = e >> 10, k = e & 1023;
    float c = cb == 0 ? P.in[I_CCTX][k] : P.in[I_C][(size_t)(cb - 1) * 1024 + k];
    sc[e] = silu_f(c);
  }
  SYNC();
  const int n = ct * 64 + lane;
  const float* wp = P.in[I_ADAW] + (size_t)l * 1024 * 6144 + (size_t)(w * 128) * 6144 + n;
  float acc[NCOND];
#pragma unroll
  for (int cb = 0; cb < NCOND; ++cb) acc[cb] = 0.f;
#pragma unroll 8
  for (int k = 0; k < 128; ++k) {
    float wv = wp[(size_t)k * 6144];
#pragma unroll
    for (int cb = 0; cb < NCOND; ++cb) acc[cb] += sc[cb * 1024 + w * 128 + k] * wv;
  }
#pragma unroll
  for (int cb = 0; cb < NCOND; ++cb) part[(w * NCOND + cb) * 64 + lane] = acc[cb];
  SYNC();
  if (tid < NCOND * 64) {
    const int cb = tid >> 6, ln = tid & 63;
    float s = P.in[I_ADAB][(size_t)l * 6144 + ct * 64 + ln];
#pragma unroll
    for (int ww = 0; ww < NW; ++ww) s += part[(ww * NCOND + cb) * 64 + ln];
    wsp<float>(P, OFF_MOD)[((size_t)l * NCOND + cb) * 6144 + ct * 64 + ln] = s;
  }
  SYNC();
}
DEV void job_xinit(const Params& P, int tile) {
  const int lane = threadIdx.x & 63, w = threadIdx.x >> 6;
  const int r = tile * 8 + w;
  float* X = wsp<float>(P, OFF_X) + (size_t)r * 1024;
  if (r < NTOK_C) {
    const float* src = P.in[I_XP] + (size_t)r * 1024;
    for (int i = 0; i < 4; ++i) stf4(X + i * 256 + lane * 4, ldf4(src + i * 256 + lane * 4));
  } else {
    const int rl = r - NTOK_C;
    const float* src = P.in[I_XS] + (size_t)rl * 1024;
    const int pos = rl % L_L;
    const float prow = (float)(pos / 64), pcol = (float)(pos % 64);
    for (int i = 0; i < 4; ++i) {
      int c0 = i * 256 + lane * 4;
      F4 v = ldf4(src + c0);
      float o[4] = {v.x, v.y, v.z, v.w};
#pragma unroll
      for (int j = 0; j < 4; ++j) {
        int c = c0 + j;
        int half = c >> 9, cc = c & 511;
        int isc = cc >> 8, fi = cc & 255;
        float omega = exp2f(-(float)fi * (13.287712379549449f / 256.f));
        float ang = (half ? pcol : prow) * omega;
        o[j] += isc ? __cosf(ang) : __sinf(ang);
      }
      stf4(X + c0, F4{o[0], o[1], o[2], o[3]});
    }
  }
}
DEV void job_h2(const Params& P, int tile) {
  const int lane = threadIdx.x & 63, w = threadIdx.x >> 6;
  const int gi = tile * 8 + w;
  const int L = gi < L_C ? L_C : L_L;
  const int i = gi < L_C ? gi : gi - L_C;
  const float t = (float)i / (float)L;
  float z = 0.f;
  if (lane == 0) z = t;
  else if (lane <= 32) {
    int b = (lane - 1) & 15;
    float band = 1e-4f + (float)b * ((15.f - 1e-4f) / 15.f);
    float ang = 6.283185307179586f * t * band;
    z = lane <= 16 ? cosf(ang) : sinf(ang);
  }
  const float* w1 = P.in[I_HYW1]; const float* w2 = P.in[I_HYW2];
  const float fr = P.in[I_HYFREQ][lane];
  float a = P.in[I_HYB1][lane];
  for (int j = 0; j < 33; ++j) a += __shfl(z, j) * w1[j * 64 + lane];
  float h1 = sinf(fr * a);
  float a2 = P.in[I_HYB2][lane];
  for (int j = 0; j < 64; ++j) a2 += __shfl(h1, j) * w2[j * 64 + lane];
  float h2 = sinf(fr * a2);
  wsp<float>(P, OFF_H2)[(gi < L_C ? (size_t)0 : (size_t)64 * L_C) + (size_t)lane * L + i] = h2;
}
DEV void job_s5p(const Params& P, int task) {
  const int dir = task >> 5, g = task & 31;
  const int p = threadIdx.x & 63, jg = threadIdx.x >> 6;
  const size_t ip = ((size_t)dir * 32 + g) * 64 + p;
  const float are = P.in[I_S5ARE][ip], aim = P.in[I_S5AIM][ip];
  const float dt = expf(P.in[I_S5LOGSTEP][dir * 32 + g]);
  const float mag = expf(are * dt);
  const float sn = sinf(aim * dt), cs = cosf(aim * dt);
  const float lre = mag * cs, lim = mag * sn;
  const float nre = lre - 1.f, nim = lim;
  const float den = are * are + aim * aim;
  const float fre = (nre * are + nim * aim) / den, fim = (nim * are - nre * aim) / den;
  if (jg == 0) {
    wsp<F2>(P, OFF_LAMB)[ip] = F2{lre, lim};
    float xr = lre, xi = lim;
    for (int s = 0; s < 6; ++s) { float nr = xr * xr - xi * xi, ni = 2.f * xr * xi; xr = nr; xi = ni; }
    wsp<F2>(P, OFF_LAMT)[ip] = F2{xr, xi};
  }
  for (int jj = 0; jj < 2; ++jj) {
    int j = jg * 2 + jj;
    float bre = P.in[I_S5BRE][ip * 16 + j], bim = P.in[I_S5BIM][ip * 16 + j];
    wsp<F2>(P, OFF_BBAR)[ip * 16 + j] = F2{fre * bre - fim * bim, fre * bim + fim * bre};
    { bf16_t* bb = wsp<bf16_t>(P, OFF_BB16) + (((size_t)dir * 32 + g) * 128 + 2 * p) * 16 + j; bb[0] = f2bf(fre * bre - fim * bim); bb[16] = f2bf(fre * bim + fim * bre); }
    size_t ic = (((size_t)dir * 32 + g) * 16 + j) * 64 + p;
    unsigned v = pack2(P.in[I_S5CRE][ic], -P.in[I_S5CIM][ic]);
    *reinterpret_cast<unsigned*>(wsp<bf16_t>(P, OFF_CMT) + (((size_t)dir * 32 + g) * 16 + j) * 128 + 2 * p) = v;
  }
}

constexpr int J0_EVIN = 0;
constexpr int J0_GLU = J0_EVIN + 16 * 32;
constexpr int J0_EVOUT = J0_GLU + 8 * 8;
constexpr int J0_ODIN = J0_EVOUT + 16 * 16;
constexpr int J0_ODOUT = J0_ODIN + 16 * (ODIN_NPAD / 64);
constexpr int J0_PKQ0 = J0_ODOUT + 16 * 16;
constexpr int J0_PKQ1 = J0_PKQ0 + 16 * 32;
constexpr int J0_KEYS = J0_PKQ1 + 16 * 32;
constexpr int J0_MOD = J0_KEYS + 128;
constexpr int J0_XINIT = J0_MOD + 2 * 96;
constexpr int J0_H2 = J0_XINIT + NTOK / 8;
constexpr int J0_S5P = J0_H2 + (L_C + L_L) / 8;
constexpr int J0_END = J0_S5P + 64;
constexpr int TAB_TILES = 2 * 16384 / 8;
constexpr size_t OFF_TAB8 = OFF_TAB;
constexpr size_t OFF_RSC = OFF_TAB + (size_t)2 * 16384 * 1024;
DEV void job_tab(const Params& P, int layer, int t) {
  const int lane = threadIdx.x & 63, w = threadIdx.x >> 6;
  const int row = t * 8 + w;
  const int which = row >> 14, r = row & 16383;
  const float* src = P.in[which ? I_PKV : I_PKU] + ((size_t)layer * 16384 + r) * 1024 + lane * 4;
  F4 v[4]; float am = 0.f;
#pragma unroll
  for (int i = 0; i < 4; ++i) { v[i] = ldf4_nt(src + i * 256); am = fmaxf(am, fmaxf(fmaxf(fabsf(v[i].x), fabsf(v[i].y)), fmaxf(fabsf(v[i].z), fabsf(v[i].w)))); }
  am = wave_max(am);
  const float sc = am > 0.f ? 240.f / am : 1.f;
  unsigned char* dst = wsp<unsigned char>(P, OFF_TAB8) + (size_t)which * 16384 * 1024 + (size_t)(lane >> 5) * (16384 * 128) + (size_t)r * 128 + (lane & 31) * 4;
#pragma unroll
  for (int i = 0; i < 4; ++i)
    *reinterpret_cast<unsigned*>(dst + (size_t)(2 * i) * (16384 * 128)) = pack_fp8x4(v[i].x * sc, v[i].y * sc, v[i].z * sc, v[i].w * sc);
  if (lane == 0) wsp<float>(P, OFF_RSC)[row] = am > 0.f ? am / 240.f : 1.f;
}

DEV void phase_prep(const Params& P, unsigned char* smem) {
  for (int t = blockIdx.x; t < J0_END; t += gridDim.x) {
    if (t < J0_GLU) job_transpose(P.in[I_EVWIN], wsp<bf16_t>(P, OFF_WEVIN), 1024, 2048, 2048, t - J0_EVIN, smem);
    else if (t < J0_EVOUT) job_transpose(P.in[I_S5GLUW], wsp<bf16_t>(P, OFF_WGLU), 512, 512, 512, t - J0_GLU, smem);
    else if (t < J0_ODIN) job_transpose(P.in[I_EVWOUT], wsp<bf16_t>(P, OFF_WEVOUT), 1024, 1024, 1024, t - J0_EVOUT, smem);
    else if (t < J0_ODOUT) job_transpose(P.in[I_ODWIN], wsp<bf16_t>(P, OFF_WODIN), 1024, ODIN_N, ODIN_NPAD, t - J0_ODIN, smem);
    else if (t < J0_PKQ0) job_transpose(P.in[I_ODWOUT], wsp<bf16_t>(P, OFF_WODOUT), 1024, 1024, 1024, t - J0_ODOUT, smem);
    else if (t < J0_KEYS) job_convert(P.in[I_PKWQ], wsp<bf16_t>(P, OFF_WPKQ), t - J0_PKQ0);
    else if (t < J0_MOD) job_convert(P.in[I_PKKEYS], wsp<bf16_t>(P, OFF_KEYS), t - J0_KEYS);
    else if (t < J0_XINIT) job_mod(P, t - J0_MOD, smem);
    else if (t < J0_H2) job_xinit(P, t - J0_XINIT);
    else if (t < J0_S5P) job_h2(P, t - J0_H2);
    else job_s5p(P, t - J0_S5P);
  }
}

DEV void phase_norm(const Params& P, int layer, int which, bool with_tab) {
  const int lane = threadIdx.x & 63, w = threadIdx.x >> 6;
  const float* X = wsp<float>(P, OFF_X);
  bf16_t* XN = wsp<bf16_t>(P, OFF_RA);
  const float* g = P.in[I_NORMG] + ((size_t)layer * 2 + which) * 1024;
  F4 gg[4], sh[4], sc[4];
#pragma unroll
  for (int i = 0; i < 4; ++i) gg[i] = ldf4(g + i * 256 + lane * 4);
  int ccur = -1;
  if (with_tab && !(w & 1)) for (int t = blockIdx.x; t < TAB_TILES; t += gridDim.x) job_tab(P, layer, t);
  for (int r = blockIdx.x * NW + w; r < NTOK; r += gridDim.x * NW) {
    const float* x = X + (size_t)r * 1024;
    const int cd = row_cond(r);
    if (cd != ccur) {
      const float* mod = wsp<float>(P, OFF_MOD) + ((size_t)layer * NCOND + cd) * 6144 + (which ? 3 * 1024 : 0);
#pragma unroll
      for (int i = 0; i < 4; ++i) { sh[i] = ldf4(mod + i * 256 + lane * 4); sc[i] = ldf4(mod + 1024 + i * 256 + lane * 4); }
      ccur = cd;
    }
    F4 v[4]; float ss = 0.f;
#pragma unroll
    for (int i = 0; i < 4; ++i) { v[i] = ldf4(x + i * 256 + lane * 4); ss += v[i].x * v[i].x + v[i].y * v[i].y + v[i].z * v[i].z + v[i].w * v[i].w; }
    ss = wave_sum(ss);
    const float rs = rsqrtf(ss * (1.f / 1024.f) + EPS);
#pragma unroll
    for (int i = 0; i < 4; ++i) {
      int c = i * 256 + lane * 4;
      float o0 = v[i].x * rs * gg[i].x * (1.f + sc[i].x) + sh[i].x, o1 = v[i].y * rs * gg[i].y * (1.f + sc[i].y) + sh[i].y;
      float o2 = v[i].z * rs * gg[i].z * (1.f + sc[i].z) + sh[i].z, o3 = v[i].w * rs * gg[i].w * (1.f + sc[i].w) + sh[i].w;
      st8(XN + (size_t)r * 1024 + c, U2{pack2(o0, o1), pack2(o2, o3)});
    }
  }
  if (with_tab && (w & 1)) for (int t = blockIdx.x; t < TAB_TILES; t += gridDim.x) job_tab(P, layer, t);
}

DEV void cswap_desc(float& a, float& b) { const float hi = fmaxf(a, b), lo = fminf(a, b); a = hi; b = lo; }
DEV void bitonic_sort16_desc(float* v) {
#pragma unroll
  for (int k = 2; k <= 16; k <<= 1)
#pragma unroll
    for (int jj = k >> 1; jj >= 1; jj >>= 1)
#pragma unroll
      for (int i = 0; i < 16; ++i) {
        const int l = i ^ jj;
        if (l > i) { if ((i & k) == 0) cswap_desc(v[i], v[l]); else cswap_desc(v[l], v[i]); }
      }
}
DEV void sort16_net_desc(float* v) {
#define CS(i, j) cswap_desc(v[i], v[j])
  CS(0, 13); CS(1, 12); CS(2, 15); CS(3, 14); CS(4, 8); CS(5, 6); CS(7, 11); CS(9, 10);
  CS(0, 5); CS(1, 7); CS(2, 9); CS(3, 4); CS(6, 13); CS(8, 14); CS(10, 15); CS(11, 12);
  CS(0, 1); CS(2, 3); CS(4, 5); CS(6, 8); CS(7, 9); CS(10, 11); CS(12, 13); CS(14, 15);
  CS(0, 2); CS(1, 3); CS(4, 10); CS(5, 11); CS(6, 7); CS(8, 9); CS(12, 14); CS(13, 15);
  CS(1, 2); CS(3, 12); CS(4, 6); CS(5, 7); CS(8, 10); CS(9, 11); CS(13, 14);
  CS(1, 4); CS(2, 6); CS(5, 8); CS(7, 10); CS(9, 13); CS(11, 14);
  CS(2, 4); CS(3, 6); CS(9, 12); CS(11, 13);
  CS(3, 5); CS(6, 8); CS(7, 9); CS(10, 12);
  CS(3, 4); CS(5, 6); CS(7, 8); CS(9, 10); CS(11, 12);
  CS(6, 7); CS(8, 9);
#undef CS
}
DEV void bitonic_merge16_desc(float* v) {
#pragma unroll
  for (int jj = 8; jj >= 1; jj >>= 1)
#pragma unroll
    for (int i = 0; i < 16; ++i) { const int l = i ^ jj; if (l > i) cswap_desc(v[i], v[l]); }
}
DEV float pack_key(float v, int idx) { return u2f((f2u(v) & 0xffffff80u) | (unsigned)(127 - idx)); }
struct EpiTopk { unsigned short* EIDX; bf16_t* EGT;
  DEVM bf16_t* stage_base(int, int) const { return nullptr; }
  DEVM int stage_ld() const { return 0; }
  DEVM void operator()(int, int, f32x4) const {} };
template <class E> struct IsTopk { static constexpr bool value = false; };
template <> struct IsTopk<EpiTopk> { static constexpr bool value = true; };
DEV void topk_rows(const float* S, float* best, int tid) {
  const int lane = tid & 63, w = tid >> 6;
  const int row = 32 * w + (lane & 31), half = lane >> 5;
  const float* sr = S + row * 129 + half * 64;
#pragma unroll
  for (int g = 0; g < 4; ++g) {
    float v[16];
#pragma unroll
    for (int i = 0; i < 16; ++i) v[i] = pack_key(sr[g * 16 + i], half * 64 + g * 16 + i);
    sort16_net_desc(v);
    if (g == 0) {
#pragma unroll
      for (int i = 0; i < 16; ++i) best[i] = v[i];
    } else {
#pragma unroll
      for (int i = 0; i < 16; ++i) best[i] = fmaxf(best[i], v[15 - i]);
      bitonic_merge16_desc(best);
    }
  }
  float oth[16];
#pragma unroll
  for (int i = 0; i < 16; ++i) oth[i] = __shfl_xor(best[15 - i], 32);
#pragma unroll
  for (int i = 0; i < 16; ++i) best[i] = fmaxf(best[i], oth[i]);
  bitonic_merge16_desc(best);
}
template <int ST>
DEV void route_row(const float* ka, const float* kb, float* sb, unsigned char* ia, unsigned char* ib, int col, unsigned short* EI, bf16_t* GT, int head) {
  float* ct = reinterpret_cast<float*>(ib + 16 * ST);
  float a[8];
  const float b0 = u2f(f2u(kb[0]) & 0xffffff80u);
#pragma unroll
  for (int i = 0; i < 16; ++i) {
    const unsigned ua = f2u(ka[i]), ub = f2u(kb[i]);
    const float av = u2f(ua & 0xffffff80u);
    if (i < 8) a[i] = av; else ct[(i - 8) * ST + col] = av + b0;
    sb[i * ST + col] = u2f(ub & 0xffffff80u);
    ia[i * ST + col] = (unsigned char)(127u - (ua & 127u)); ib[i * ST + col] = (unsigned char)(127u - (ub & 127u));
  }
  ct[8 * ST + col] = -3.0e38f;
  float cur[8];
#pragma unroll
  for (int i = 0; i < 8; ++i) cur[i] = a[i] + b0;
  float curT = ct[col];
  int tp = 0;
  unsigned jp = 0u;
  float best[16]; int ex[16];
#pragma unroll
  for (int o2 = 0; o2 < 16; ++o2) {
    float bv = cur[0]; int bi = 0;
#pragma unroll
    for (int i = 1; i < 8; ++i) if (cur[i] > bv) { bv = cur[i]; bi = i; }
    const bool tail = curT > bv;
    best[o2] = tail ? curT : bv;
    const int j = (int)((jp >> (4 * bi)) & 15u);
    const int ra = tail ? 8 + tp : bi, cb = tail ? 0 : j;
    ex[o2] = (int)ia[ra * ST + col] * 128 + (int)ib[cb * ST + col];
    const int jn = j + 1;
    float nv = -3.0e38f;
    if ((bi + 1) * (jn + 1) <= 16) {
      float av = a[0];
#pragma unroll
      for (int i = 1; i < 8; ++i) av = (i == bi) ? a[i] : av;
      nv = av + sb[(jn & 15) * ST + col];
    }
    const int tq = tp + 1 < 8 ? tp + 1 : 8;
    const float nt = ct[tq * ST + col];
    const int bsel = tail ? 8 : bi;
#pragma unroll
    for (int i = 0; i < 8; ++i) cur[i] = (i == bsel) ? nv : cur[i];
    jp += tail ? 0u : (1u << (4 * bi));
    curT = tail ? nt : curT; tp = tail ? tq : tp;
  }
  float sum = 0.f;
  const float bmax = best[0];
#pragma unroll
  for (int o2 = 0; o2 < 16; ++o2) { best[o2] = __expf(best[o2] - bmax); sum += best[o2]; }
  const float inv = 1.f / sum;
#pragma unroll
  for (int o2 = 0; o2 < 16; ++o2) {
    const int pos = (o2 & 7) * 16 + head * 2 + (o2 >> 3);
    EI[pos] = (unsigned short)ex[o2]; GT[pos] = f2bf(best[o2] * inv);
  }
}

constexpr int G_BM = 256, G_BK = 64;
template <int BN, class Epi>
DEV void gemm_tile(const bf16_t* A, int lda, const bf16_t* Bt, int ldb, int K, int m0, int n0, Epi& epi, unsigned char* smem) {
  constexpr int BUFB = (G_BM + BN) * 128;
  constexpr int NST = BN == 256 ? 2 : 3;
  constexpr int MI = BN == 256 ? 8 : 4;
  constexpr int NBP = BN / 64;
  const int tid = threadIdx.x, lane = tid & 63, w = tid >> 6;
  const int wm = BN == 256 ? (w >> 2) : (w >> 1), wn = BN == 256 ? (w & 3) : (w & 1);
  const int lr = lane & 15, lq = lane >> 4;
  f32x4 acc[MI][4];
#pragma unroll
  for (int i = 0; i < MI; ++i)
#pragma unroll
    for (int j = 0; j < 4; ++j) acc[i][j] = f32x4{0.f, 0.f, 0.f, 0.f};
  const int prow = lane >> 3, pslot = (lane & 7) ^ prow;
  auto stage = [&](unsigned char* buf, int k0) {
#pragma unroll
    for (int i = 0; i < 4; ++i) {
      const int piece = w * 4 + i;
      glds16(A + (size_t)(m0 + piece * 8 + prow) * lda + k0 + pslot * 8, buf + piece * 1024 + lane * 16);
    }
#pragma unroll
    for (int i = 0; i < NBP; ++i) {
      const int piece = w * NBP + i;
      glds16(Bt + (size_t)(n0 + piece * 8 + prow) * ldb + k0 + pslot * 8, buf + G_BM * 128 + piece * 1024 + lane * 16);
    }
  };
  auto compute = [&](const unsigned char* As) {
    const unsigned char* Bs = As + G_BM * 128;
#pragma unroll
    for (int kk = 0; kk < 2; ++kk) {
      bf16x8 fa[MI], fb[4];
#pragma unroll
      for (int j = 0; j < 4; ++j) {
        const int r = IsTopk<Epi>::value ? (j >> 1) * 128 + wn * 32 + (j & 1) * 16 + lr : wn * 64 + j * 16 + lr;
        fb[j] = as_frag(ld16(Bs + r * 128 + (((kk * 4 + lq) ^ (r & 7)) << 4)));
      }
#pragma unroll
      for (int i = 0; i < MI; ++i) { const int r = wm * (16 * MI) + i * 16 + lr; fa[i] = as_frag(ld16(As + r * 128 + (((kk * 4 + lq) ^ (r & 7)) << 4))); }
#pragma unroll
      for (int i = 0; i < MI; ++i)
#pragma unroll
        for (int j = 0; j < 4; ++j) acc[i][j] = mfma16(fb[j], fa[i], acc[i][j]);
    }
  };
  const int nk = K / G_BK;
  SYNC();
#pragma unroll
  for (int p = 0; p < NST - 1; ++p) if (p < nk) stage(smem + p * BUFB, p * G_BK);
  for (int kt = 0; kt < nk; ++kt) {
    if (NST == 3 && kt + 1 < nk) asm_wait_vm6(); else glds_wait();
    SYNC();
    SYNC();
    if (kt + NST - 1 < nk) stage(smem + ((kt + NST - 1) % NST) * BUFB, (kt + NST - 1) * G_BK);
    compute(smem + (kt % NST) * BUFB);
  }
  SYNC();
  if constexpr (IsTopk<Epi>::value) {
    static_assert(BN == 256, "top-k epilogue needs the 256-wide tile");
    float* S = reinterpret_cast<float*>(smem);
    const int te = tid, le = lane, we = w;
    float* pw = S + (wm * (16 * MI) + lr) * 129 + wn * 32 + lq * 4;
    float ka[16], kb[16];
#pragma unroll
    for (int i = 0; i < MI; ++i)
#pragma unroll
      for (int j = 0; j < 2; ++j) {
        float* p = pw + i * 16 * 129 + j * 16;
        p[0] = acc[i][j][0]; p[1] = acc[i][j][1]; p[2] = acc[i][j][2]; p[3] = acc[i][j][3];
      }
    SYNC();
    topk_rows(S, ka, te);
    SYNC();
#pragma unroll
    for (int i = 0; i < MI; ++i)
#pragma unroll
      for (int j = 0; j < 2; ++j) {
        float* p = pw + i * 16 * 129 + j * 16;
        p[0] = acc[i][2 + j][0]; p[1] = acc[i][2 + j][1]; p[2] = acc[i][2 + j][2]; p[3] = acc[i][2 + j][3];
      }
    SYNC();
    topk_rows(S, kb, te);
    SYNC();
    if (le < 32) {
      const int col = we * 32 + le;
      float* sb = reinterpret_cast<float*>(smem);
      unsigned char* ia = smem + 16 * 256 * 4;
      unsigned char* ib = ia + 16 * 256;
      route_row<256>(ka, kb, sb, ia, ib, col, epi.EIDX + (size_t)(m0 + col) * 128, epi.EGT + (size_t)(m0 + col) * 128, n0 >> 8);
    }
    return;
  }
  bf16_t* sbase = epi.stage_base(n0, BN);
  if (sbase != nullptr) {
    bf16_t* T = reinterpret_cast<bf16_t*>(smem) + (size_t)w * (16 * MI) * 68;
#pragma unroll
    for (int i = 0; i < MI; ++i)
#pragma unroll
      for (int j = 0; j < 4; ++j) st8(T + (i * 16 + lr) * 68 + j * 16 + lq * 4, U2{pack2(acc[i][j][0], acc[i][j][1]), pack2(acc[i][j][2], acc[i][j][3])});
    wave_lds_fence();
    const int ldc = epi.stage_ld();
    bf16_t* dst = sbase + (size_t)(m0 + wm * (16 * MI)) * ldc + n0 + wn * 64;
#pragma unroll
    for (int p = 0; p < 2 * MI; ++p) {
      const int r = p * 8 + (lane >> 3), c8 = (lane & 7) * 8;
      const U2 a = ld8(T + r * 68 + c8), b = ld8(T + r * 68 + c8 + 4);
      st16(dst + (size_t)r * ldc + c8, U4{a.x, a.y, b.x, b.y});
    }
  } else {
#pragma unroll
    for (int i = 0; i < MI; ++i)
#pragma unroll
      for (int j = 0; j < 4; ++j) epi(m0 + wm * (16 * MI) + i * 16 + lr, n0 + wn * 64 + j * 16 + lq * 4, acc[i][j]);
  }
  SYNC();
}
#ifndef EMU
#define G8_BAR() __builtin_amdgcn_s_barrier()
#define G8_WAIT_V(n) asm volatile("s_waitcnt vmcnt(" #n ")" ::: "memory")
#define G8_WAIT_L(n) asm volatile("s_waitcnt lgkmcnt(" #n ")" ::: "memory")
#define G8_SCHED() __builtin_amdgcn_sched_barrier(0)
#define G8_PRIO(p) __builtin_amdgcn_s_setprio(p)
#else
#define G8_BAR() SYNC()
#define G8_WAIT_V(n) do {} while (0)
#define G8_WAIT_L(n) do {} while (0)
#define G8_SCHED() do {} while (0)
#define G8_PRIO(p) do {} while (0)
#endif
DEV int g8_lds_byte(int r, int c) { const int st = (r >> 4) * 2 + (c >> 5), rr = r & 15, cc = c & 31, ob = rr * 64 + cc * 2; return st * 1024 + (ob ^ (((ob >> 9) & 1) << 5)); }
DEV void g8_stage_rc(int b, int& R, int& C) { const int st = b / 1024, sb = b % 1024, swz = sb ^ (((sb >> 9) & 1) << 5); R = (st >> 1) * 16 + swz / 64; C = (st & 1) * 32 + (swz % 64) / 2; }
template <class Epi>
DEV void gemm8_tile(const bf16_t* A, const bf16_t* Bt, int brow, int bcol, Epi& epi, unsigned char* smem) {
  constexpr int LD = 1024, HT = 128 * 64, NTK = LD / 64;
  const int tid = threadIdx.x, wid = tid >> 6, lane = tid & 63, wr = wid >> 2, wc = wid & 3, fr = lane & 15, fq = lane >> 4;
  bf16_t* shm = reinterpret_cast<bf16_t*>(smem);
#define G8_SA(b, h) (shm + ((b) * 2 + (h)) * HT)
#define G8_SB(b, h) (shm + (4 + (b) * 2 + (h)) * HT)
#ifndef EMU
  const int ldst = uniform_i((tid >> 6) * 1024);
#else
  const int ldst = tid * 16;
#endif
  unsigned voff[2];
#pragma unroll
  for (int i = 0; i < 2; ++i) { int r_, c_; g8_stage_rc(tid * 16 + i * 8192, r_, c_); voff[i] = (unsigned)(r_ * LD + c_) * 2u; }
#define G8_STAGE(PP, BASE, br, kt) do { \
    const unsigned char* _gb = reinterpret_cast<const unsigned char*>(BASE) + ((size_t)(br) * LD + (size_t)(kt) * 64) * 2; \
    _Pragma("unroll") for (int _i = 0; _i < 2; ++_i) glds16(_gb + voff[_i], reinterpret_cast<unsigned char*>(PP) + ldst + _i * 8192); } while (0)
#define G8_LDA(dst, b, h) do { _Pragma("unroll") for (int m = 0; m < 4; ++m) _Pragma("unroll") for (int k = 0; k < 2; ++k) \
    dst[m][k] = *reinterpret_cast<const bf16x8*>(reinterpret_cast<const unsigned char*>(G8_SA(b, h)) + g8_lds_byte(wr * 64 + m * 16 + fr, k * 32 + fq * 8)); } while (0)
#define G8_LDB(dst, b, h) do { _Pragma("unroll") for (int n = 0; n < 2; ++n) _Pragma("unroll") for (int k = 0; k < 2; ++k) \
    dst[n][k] = *reinterpret_cast<const bf16x8*>(reinterpret_cast<const unsigned char*>(G8_SB(b, h)) + g8_lds_byte(wc * 32 + n * 16 + fr, k * 32 + fq * 8)); } while (0)
#define G8_MMA(ai, bj, AT, BT) do { G8_PRIO(1); \
    _Pragma("unroll") for (int m = 0; m < 4; ++m) _Pragma("unroll") for (int n = 0; n < 2; ++n) _Pragma("unroll") for (int k = 0; k < 2; ++k) \
      acc[ai][bj][m][n] = mfma16(BT[n][k], AT[m][k], acc[ai][bj][m][n]); \
    G8_PRIO(0); } while (0)
  f32x4 acc[2][2][4][2];
#pragma unroll
  for (int a = 0; a < 2; ++a)
#pragma unroll
    for (int b = 0; b < 2; ++b)
#pragma unroll
      for (int m = 0; m < 4; ++m)
#pragma unroll
        for (int n = 0; n < 2; ++n) acc[a][b][m][n] = f32x4{0.f, 0.f, 0.f, 0.f};
  bf16x8 At[4][2], B0[2][2], B1[2][2];
  SYNC();
  G8_STAGE(G8_SB(0, 0), Bt, bcol, 0); G8_STAGE(G8_SA(0, 0), A, brow, 0);
  G8_STAGE(G8_SB(0, 1), Bt, bcol + 128, 0); G8_STAGE(G8_SA(0, 1), A, brow + 128, 0);
  if (wr == 1) G8_BAR();
  G8_WAIT_V(4); G8_BAR();
  G8_STAGE(G8_SB(1, 0), Bt, bcol, 1); G8_STAGE(G8_SA(1, 0), A, brow, 1); G8_STAGE(G8_SB(1, 1), Bt, bcol + 128, 1);
  G8_WAIT_V(6); G8_BAR();
#pragma unroll 1
  for (int t = 0; t < NTK - 2; t += 2) {
    G8_LDB(B0, 0, 0); G8_SCHED(); G8_LDA(At, 0, 0); G8_STAGE(G8_SA(1, 1), A, brow + 128, t + 1);
    G8_WAIT_L(8); G8_BAR(); G8_WAIT_L(0); G8_MMA(0, 0, At, B0); G8_BAR(); G8_SCHED();
    G8_LDB(B1, 0, 1); G8_STAGE(G8_SB(0, 0), Bt, bcol, t + 2);
    G8_BAR(); G8_WAIT_L(0); G8_MMA(0, 1, At, B1); G8_BAR();
    G8_LDA(At, 0, 1); G8_STAGE(G8_SA(0, 0), A, brow, t + 2);
    G8_BAR(); G8_WAIT_L(0); G8_MMA(1, 0, At, B0); G8_BAR(); G8_SCHED();
    G8_STAGE(G8_SB(0, 1), Bt, bcol + 128, t + 2);
    G8_WAIT_V(6); G8_BAR(); G8_MMA(1, 1, At, B1); G8_BAR();
    G8_LDB(B0, 1, 0); G8_SCHED(); G8_LDA(At, 1, 0); G8_STAGE(G8_SA(0, 1), A, brow + 128, t + 2);
    G8_WAIT_L(8); G8_BAR(); G8_WAIT_L(0); G8_MMA(0, 0, At, B0); G8_BAR(); G8_SCHED();
    G8_LDB(B1, 1, 1); G8_STAGE(G8_SB(1, 0), Bt, bcol, t + 3);
    G8_BAR(); G8_WAIT_L(0); G8_MMA(0, 1, At, B1); G8_BAR();
    G8_LDA(At, 1, 1); G8_STAGE(G8_SA(1, 0), A, brow, t + 3);
    G8_BAR(); G8_WAIT_L(0); G8_MMA(1, 0, At, B0); G8_BAR(); G8_SCHED();
    G8_STAGE(G8_SB(1, 1), Bt, bcol + 128, t + 3);
    G8_WAIT_V(6); G8_BAR(); G8_MMA(1, 1, At, B1); G8_BAR();
  }
  { G8_LDB(B0, 0, 0); G8_LDA(At, 0, 0); G8_STAGE(G8_SA(1, 1), A, brow + 128, NTK - 1);
    G8_BAR(); G8_WAIT_L(0); G8_MMA(0, 0, At, B0); G8_BAR();
    G8_LDB(B1, 0, 1); G8_BAR(); G8_WAIT_L(0); G8_MMA(0, 1, At, B1); G8_BAR();
    G8_LDA(At, 0, 1); G8_WAIT_V(4); G8_BAR(); G8_WAIT_L(0); G8_MMA(1, 0, At, B0); G8_MMA(1, 1, At, B1); G8_BAR(); }
  { G8_LDB(B0, 1, 0); G8_LDA(At, 1, 0); G8_WAIT_V(2); G8_BAR(); G8_WAIT_L(0); G8_MMA(0, 0, At, B0); G8_BAR();
    G8_LDB(B1, 1, 1); G8_WAIT_V(0); G8_BAR(); G8_WAIT_L(0); G8_MMA(0, 1, At, B1); G8_BAR();
    G8_LDA(At, 1, 1); G8_BAR(); G8_WAIT_L(0); G8_MMA(1, 0, At, B0); G8_MMA(1, 1, At, B1); G8_BAR(); }
  if (wr == 0) G8_BAR();
#undef G8_SA
#undef G8_SB
#undef G8_STAGE
#undef G8_LDA
#undef G8_LDB
#undef G8_MMA
  SYNC();
  const int te = tid_opaque(), wie = te >> 6, lae = te & 63, wre = wie >> 2, wce = wie & 3, fre = lae & 15, fqe = lae >> 4;
  if constexpr (IsTopk<Epi>::value) {
    float* S = reinterpret_cast<float*>(smem);
    float* pw = S + (wre * 64 + fre) * 129 + wce * 32 + fqe * 4;
    float ka[16], kb[16];
#pragma unroll
    for (int ai = 0; ai < 2; ++ai)
#pragma unroll
      for (int m = 0; m < 4; ++m)
#pragma unroll
        for (int n = 0; n < 2; ++n) {
          float* p = pw + (ai * 128 + m * 16) * 129 + n * 16;
          p[0] = acc[ai][0][m][n][0]; p[1] = acc[ai][0][m][n][1]; p[2] = acc[ai][0][m][n][2]; p[3] = acc[ai][0][m][n][3];
        }
    SYNC();
    topk_rows(S, ka, te);
    SYNC();
#pragma unroll
    for (int ai = 0; ai < 2; ++ai)
#pragma unroll
      for (int m = 0; m < 4; ++m)
#pragma unroll
        for (int n = 0; n < 2; ++n) {
          float* p = pw + (ai * 128 + m * 16) * 129 + n * 16;
          p[0] = acc[ai][1][m][n][0]; p[1] = acc[ai][1][m][n][1]; p[2] = acc[ai][1][m][n][2]; p[3] = acc[ai][1][m][n][3];
        }
    SYNC();
    topk_rows(S, kb, te);
    SYNC();
    if (lae < 32) {
      const int col = wie * 32 + lae;
      float* sb = reinterpret_cast<float*>(smem);
      unsigned char* ia = smem + 16 * 256 * 4;
      unsigned char* ib = ia + 16 * 256;
      route_row<256>(ka, kb, sb, ia, ib, col, epi.EIDX + (size_t)(brow + col) * 128, epi.EGT + (size_t)(brow + col) * 128, bcol >> 8);
    }
    return;
  }
  bf16_t* sbase = epi.stage_base(bcol, 256);
  if (sbase != nullptr) {
    bf16_t* T = reinterpret_cast<bf16_t*>(smem);
#pragma unroll
    for (int ai = 0; ai < 2; ++ai)
#pragma unroll
      for (int bj = 0; bj < 2; ++bj)
#pragma unroll
        for (int m = 0; m < 4; ++m)
#pragma unroll
          for (int n = 0; n < 2; ++n)
            st8(T + (ai * 128 + wre * 64 + m * 16 + fre) * 264 + bj * 128 + wce * 32 + n * 16 + fqe * 4,
                U2{pack2(acc[ai][bj][m][n][0], acc[ai][bj][m][n][1]), pack2(acc[ai][bj][m][n][2], acc[ai][bj][m][n][3])});
    SYNC();
    const int ldc = epi.stage_ld();
    bf16_t* dst = sbase + (size_t)brow * ldc + bcol;
#pragma unroll 4
    for (int p = 0; p < 16; ++p) {
      const int r = wie * 32 + p * 2 + (lae >> 5), c8 = (lae & 31) * 8;
      st16(dst + (size_t)r * ldc + c8, ld16(T + r * 264 + c8));
    }
  } else {
#pragma unroll
    for (int ai = 0; ai < 2; ++ai)
#pragma unroll
      for (int bj = 0; bj < 2; ++bj)
#pragma unroll
        for (int m = 0; m < 4; ++m)
#pragma unroll
          for (int n = 0; n < 2; ++n)
            epi(brow + ai * 128 + wre * 64 + m * 16 + fre, bcol + bj * 128 + wce * 32 + n * 16 + fqe * 4, acc[ai][bj][m][n]);
  }
}
#ifndef USE_G8
#define USE_G8 1
#endif
template <int BN, class Epi>
DEV void gemm_tile_sel(const bf16_t* A, int lda, const bf16_t* Bt, int ldb, int K, int m0, int n0, Epi& epi, unsigned char* smem) {
  if constexpr (BN == 256 && USE_G8) gemm8_tile(A, Bt, m0, n0, epi, smem); else gemm_tile<BN>(A, lda, Bt, ldb, K, m0, n0, epi, smem);
}
template <int BN, class Epi>
DEV void gemm_phase(const bf16_t* A, int lda, const bf16_t* Bt, int ldb, int M, int Npad, int K, Epi epi, unsigned char* smem) {
  const int ntn = Npad / BN, ntm = M / G_BM;
  if ((ntm & 7) == 0 && (gridDim.x & 7) == 0) {
    const int x = blockIdx.x & 7, jr = blockIdx.x >> 3, per = gridDim.x >> 3;
    const int nloc = (ntm >> 3) * ntn;
    for (int q = jr; q < nloc; q += per) gemm_tile_sel<BN>(A, lda, Bt, ldb, K, ((q / ntn) * 8 + x) * G_BM, (q % ntn) * BN, epi, smem);
  } else {
    for (int t = blockIdx.x; t < ntn * ntm; t += gridDim.x) gemm_tile_sel<BN>(A, lda, Bt, ldb, K, (t / ntn) * G_BM, (t % ntn) * BN, epi, smem);
  }
}
struct EpiStoreBf16 { bf16_t* C; int ldc;
  DEVM bf16_t* stage_base(int, int) const { return C; }
  DEVM int stage_ld() const { return ldc; }
  DEVM void operator()(int m, int n, f32x4 v) const { st8(C + (size_t)m * ldc + n, U2{pack2(v[0], v[1]), pack2(v[2], v[3])}); } };
struct EpiResid { float* X; const float* gate; float scale;
  DEVM bf16_t* stage_base(int, int) const { return nullptr; }
  DEVM int stage_ld() const { return 0; }
  DEVM void operator()(int m, int n, f32x4 v) const {
    const float* g = gate + (size_t)row_cond(m) * 6144 + n;
    float* x = X + (size_t)m * 1024 + n;
    F4 xv = ldf4(x), gv = ldf4(g);
    stf4(x, F4{xv.x + scale * gv.x * v[0], xv.y + scale * gv.y * v[1], xv.z + scale * gv.z * v[2], xv.w + scale * gv.w * v[3]});
  } };
struct EpiWF { bf16_t* W;
  DEVM bf16_t* stage_base(int, int) const { return nullptr; }
  DEVM int stage_ld() const { return 0; }
  DEVM void operator()(int m, int n, f32x4 v) const {
#pragma unroll
    for (int i = 0; i < 4; ++i) W[(size_t)(n + i) * 1024 + m] = (bf16_t)(pack2(v[i], 0.f) & 0xffffu);
  } };
DEV void phase_wf(const Params& P, int layer, unsigned char* smem) {
  for (int t = blockIdx.x; t < 64; t += gridDim.x) {
    const int hc = t >> 2, mt = t & 3;
    EpiWF epi{wsp<bf16_t>(P, OFF_WF) + (size_t)hc * 128 * 1024};
    gemm_tile<128>(wsp<bf16_t>(P, OFF_WPKQ) + (size_t)layer * 1024 * 2048 + hc * 128, 2048,
                   wsp<bf16_t>(P, OFF_KEYS) + ((size_t)layer * 16 + hc) * 128 * 128, 128, 128, mt * 256, 0, epi, smem);
  }
}


DEV void cmulr(float& ar, float& ai, float br, float bi) { float r = ar * br - ai * bi, i = ar * bi + ai * br; ar = r; ai = i; }
template <int LOGN, int NTHR> DEV void fft_radix8_pass(F2* x, const F2* tw, int h, bool inverse, int tl) {
  constexpr int N = 1 << LOGN;
  const int hq = h >> 2;
  const float R = 0.70710678118654752f;
  const int lhq = 31 - __builtin_clz((unsigned)hq);
#pragma unroll 1
  for (int g = tl; g < N / 8; g += NTHR) {
    const int b = g >> lhq, r = g & (hq - 1);
    F2* xp = x + b * 2 * h + r;
    float er[8], ei[8];
#pragma unroll
    for (int j = 0; j < 8; ++j) { F2 v = xp[j * hq]; er[j] = v.x; ei[j] = v.y; }
    const F2 t1 = tw[r << (LOGN - 3 - lhq)];
    const float c1 = t1.x; const float s1 = inverse ? -t1.y : t1.y;
    const float c2 = c1 * c1 - s1 * s1, s2 = 2.f * c1 * s1;
    const float c4 = c2 * c2 - s2 * s2, s4 = 2.f * c2 * s2;
    const float sg = inverse ? 1.f : -1.f;
    const float w8r[4] = {1.f, R, 0.f, -R}, w8i[4] = {0.f, sg * R, sg, sg * R};
    if (!inverse) {
#pragma unroll
      for (int j = 0; j < 4; ++j) {
        float ur = er[j], ui = ei[j], vr = er[j + 4], vi = ei[j + 4];
        er[j] = ur + vr; ei[j] = ui + vi;
        float tr = ur - vr, ti = ui - vi;
        float wr = c1, wi = s1; cmulr(wr, wi, w8r[j], w8i[j]);
        cmulr(tr, ti, wr, wi); er[j + 4] = tr; ei[j + 4] = ti;
      }
#pragma unroll
      for (int jj = 0; jj < 4; ++jj) {
        const int j = (jj & 1) + (jj >> 1) * 4;
        float ur = er[j], ui = ei[j], vr = er[j + 2], vi = ei[j + 2];
        er[j] = ur + vr; ei[j] = ui + vi;
        float tr = ur - vr, ti = ui - vi;
        float wr = c2, wi = s2; if (j & 1) { float t = wr; wr = wi; wi = -t; }
        cmulr(tr, ti, wr, wi); er[j + 2] = tr; ei[j + 2] = ti;
      }
#pragma unroll
      for (int j = 0; j < 8; j += 2) {
        float ur = er[j], ui = ei[j], vr = er[j + 1], vi = ei[j + 1];
        er[j] = ur + vr; ei[j] = ui + vi;
        float tr = ur - vr, ti = ui - vi;
        cmulr(tr, ti, c4, s4); er[j + 1] = tr; ei[j + 1] = ti;
      }
    } else {
#pragma unroll
      for (int j = 0; j < 8; j += 2) {
        float vr = er[j + 1], vi = ei[j + 1]; cmulr(vr, vi, c4, s4);
        float ur = er[j], ui = ei[j];
        er[j] = ur + vr; ei[j] = ui + vi; er[j + 1] = ur - vr; ei[j + 1] = ui - vi;
      }
#pragma unroll
      for (int jj = 0; jj < 4; ++jj) {
        const int j = (jj & 1) + (jj >> 1) * 4;
        float wr = c2, wi = s2; if (j & 1) { float t = wr; wr = -wi; wi = t; }
        float vr = er[j + 2], vi = ei[j + 2]; cmulr(vr, vi, wr, wi);
        float ur = er[j], ui = ei[j];
        er[j] = ur + vr; ei[j] = ui + vi; er[j + 2] = ur - vr; ei[j + 2] = ui - vi;
      }
#pragma unroll
      for (int j = 0; j < 4; ++j) {
        float wr = c1, wi = s1; cmulr(wr, wi, w8r[j], w8i[j]);
        float vr = er[j + 4], vi = ei[j + 4]; cmulr(vr, vi, wr, wi);
        float ur = er[j], ui = ei[j];
        er[j] = ur + vr; ei[j] = ui + vi; er[j + 4] = ur - vr; ei[j + 4] = ui - vi;
      }
    }
#pragma unroll
    for (int j = 0; j < 8; ++j) xp[j * hq] = F2{er[j], ei[j]};
  }
}
template <int LOGN, int NTHR> DEV void fft_radix2_last(F2* x, int tl) {
  constexpr int N = 1 << LOGN;
  for (int g = tl; g < N / 2; g += NTHR) {
    F2 u = x[2 * g], v = x[2 * g + 1];
    x[2 * g] = F2{u.x + v.x, u.y + v.y}; x[2 * g + 1] = F2{u.x - v.x, u.y - v.y};
  }
}
template <int LOGN, int NTHR> DEV void fft_fwd_t(F2* x, const F2* tw, int tl) {
  static_assert(LOGN % 3 == 0 || LOGN % 3 == 1, "fft size");
  int h = (1 << LOGN) / 2;
#pragma unroll 1
  for (int p = 0; p < LOGN / 3; ++p, h >>= 3) { fft_radix8_pass<LOGN, NTHR>(x, tw, h, false, tl); SYNC(); }
  if (LOGN % 3 == 1) { fft_radix2_last<LOGN, NTHR>(x, tl); SYNC(); }
}
template <int LOGN, int NTHR> DEV void fft_inv_t(F2* x, const F2* tw, int tl) {
  if (LOGN % 3 == 1) { fft_radix2_last<LOGN, NTHR>(x, tl); SYNC(); }
  int h = (LOGN % 3 == 1) ? 8 : 4;
#pragma unroll 1
  for (int p = 0; p < LOGN / 3; ++p, h <<= 3) { fft_radix8_pass<LOGN, NTHR>(x, tw, h, true, tl); SYNC(); }
}
template <int LOGN> DEV void fft_fill_twiddles(F2* tw) {
  for (int j = threadIdx.x; j < (1 << LOGN) / 8; j += NT) { float sn, cs; sincospif(-2.f * (float)j / (float)(1 << LOGN), &sn, &cs); tw[j] = F2{cs, sn}; }
}
constexpr size_t SM_TWL = 96 * 1024, SM_TWC = 112 * 1024;

template <int LOGN> DEV void hyena_filter_task(const Params& P, int c, unsigned char* smem) {
  constexpr int N = 1 << LOGN, L = N / 2;
  constexpr int h2base = (LOGN == LOG_NC) ? 0 : L_C;
  constexpr int kfoff = (LOGN == LOG_NC) ? 0 : 2 * L_C;
  F2* x = reinterpret_cast<F2*>(smem);
  float* w3s = reinterpret_cast<float*>(smem + (size_t)N * 8);
  float* red = w3s + 256;
  const int tid = threadIdx.x, lane = tid & 63, w = tid >> 6;
  if (tid < 256) { int f = tid >> 2, k = tid & 3; w3s[tid] = P.in[I_HYW3][(size_t)f * 2048 + (k >> 1) * 1024 + (k & 1) * 512 + c]; }
  float dec[4];
#pragma unroll
  for (int k = 0; k < 4; ++k) dec[k] = fabsf(P.in[I_HYDECAY][(k >> 1) * 1024 + (k & 1) * 512 + c]);
  if (tid == 0) x[L] = F2{0.f, 0.f};
  SYNC();
  const float* H2 = wsp<float>(P, OFF_H2) + (size_t)h2base * 64;
  float ss0 = 0.f, ss1 = 0.f;
  for (int i4 = tid * 4; i4 < L; i4 += NT * 4) {
    float acc[4][4];
#pragma unroll
    for (int pp = 0; pp < 4; ++pp)
#pragma unroll
      for (int k = 0; k < 4; ++k) acc[pp][k] = 0.f;
#pragma unroll 8
    for (int f = 0; f < 64; ++f) {
      const F4 hv = ldf4(H2 + (size_t)f * L + i4);
      const F4 ww = ldf4(w3s + f * 4);
      const float hh[4] = {hv.x, hv.y, hv.z, hv.w};
#pragma unroll
      for (int pp = 0; pp < 4; ++pp) { acc[pp][0] += hh[pp] * ww.x; acc[pp][1] += hh[pp] * ww.y; acc[pp][2] += hh[pp] * ww.z; acc[pp][3] += hh[pp] * ww.w; }
    }
#pragma unroll
    for (int pp = 0; pp < 4; ++pp) {
      const int i = i4 + pp;
      const float t = (float)i / (float)L;
      float hv[4];
#pragma unroll
      for (int k = 0; k < 4; ++k) hv[k] = acc[pp][k] * expf(-t * dec[k]);
      x[i] = F2{hv[0], hv[2]}; ss0 += hv[0] * hv[0]; ss1 += hv[2] * hv[2];
      if (i >= 1) { x[N - i] = F2{hv[1], hv[3]}; ss0 += hv[1] * hv[1]; ss1 += hv[3] * hv[3]; }
    }
  }
  ss0 = wave_sum(ss0); ss1 = wave_sum(ss1);
  if (lane == 0) { red[w] = ss0; red[NW + w] = ss1; }
  SYNC();
  float t0 = 0.f, t1 = 0.f;
#pragma unroll
  for (int i = 0; i < NW; ++i) { t0 += red[i]; t1 += red[NW + i]; }
  const float rs0 = rsqrtf(t0 + EPS), rs1 = rsqrtf(t1 + EPS);
  for (int j = tid; j < N; j += NT) { F2 v = x[j]; x[j] = F2{v.x * rs0, v.y * rs1}; }
  SYNC();
  fft_fwd_t<LOGN, NT>(x, reinterpret_cast<const F2*>(smem + (LOGN == LOG_NC ? SM_TWC : SM_TWL)), tid);
  F2* KF = wsp<F2>(P, OFF_KF);
  const float sc = 0.5f / (float)N;
  for (int p = tid; p < N; p += NT) {
    const int f = (int)(__brev((unsigned)p) >> (32 - LOGN));
    const int p2 = (int)(__brev((unsigned)((N - f) & (N - 1))) >> (32 - LOGN));
    F2 Z = x[p], Z2 = x[p2];
    KF[((size_t)c * 2 + 0) * KF_N + kfoff + p] = F2{(Z.x + Z2.x) * sc, (Z.y - Z2.y) * sc};
    KF[((size_t)c * 2 + 1) * KF_N + kfoff + p] = F2{(Z.y + Z2.y) * sc, -(Z.x - Z2.x) * sc};
  }
  SYNC();
}
DEV void phase_hyena_filters(const Params& P, unsigned char* smem) {
  fft_fill_twiddles<LOG_NL>(reinterpret_cast<F2*>(smem + SM_TWL)); fft_fill_twiddles<LOG_NC>(reinterpret_cast<F2*>(smem + SM_TWC));
  SYNC();
  for (int t = blockIdx.x; t < 1024; t += gridDim.x) {
    if (t < 512) hyena_filter_task<LOG_NL>(P, t, smem);
    else hyena_filter_task<LOG_NC>(P, t - 512, smem);
  }
}

DEV void hyena_conv_task(const Params& P, int task, unsigned char* smem) {
  bf16_t* T = reinterpret_cast<bf16_t*>(smem);
  const int rt = task / 6, ct = task % 6;
  const int r0 = rt * 64, c0 = ct * 256;
  const int tid = threadIdx.x, tl = tid >> 3, cg = (tid & 7) * 8;
  const int r = r0 + tl, pos = row_pos(r), L = r < NTOK_C ? L_C : L_L;
  const float* cw = P.in[I_HYCW]; const float* cb = P.in[I_HYCB];
#pragma unroll
  for (int sub = 0; sub < 4; ++sub) {
    const bf16_t* pr = wsp<bf16_t>(P, OFF_PROJ0) + (size_t)r * 2048 + c0 + sub * 64 + cg;
    const U4 z4{0u, 0u, 0u, 0u};
    U4 xm = pos > 0 ? ld16(pr - 2048) : z4, x0 = ld16(pr), xp = pos < L - 1 ? ld16(pr + 2048) : z4;
    const unsigned am[4] = {xm.x, xm.y, xm.z, xm.w}, a0[4] = {x0.x, x0.y, x0.z, x0.w}, ap[4] = {xp.x, xp.y, xp.z, xp.w};
#pragma unroll
    for (int j = 0; j < 8; ++j) {
      const int c = c0 + sub * 64 + cg + j;
      float vm = (j & 1) ? bfhi(am[j >> 1]) : bflo(am[j >> 1]);
      float v0 = (j & 1) ? bfhi(a0[j >> 1]) : bflo(a0[j >> 1]);
      float vp = (j & 1) ? bfhi(ap[j >> 1]) : bflo(ap[j >> 1]);
      float o = vm * cw[c] + v0 * cw[1536 + c] + vp * cw[3072 + c] + cb[c];
      T[(sub * 64 + cg + j) * 72 + tl] = f2bf(o);
    }
  }
  SYNC();
#pragma unroll
  for (int sub = 0; sub < 4; ++sub) {
    const int cl = sub * 64 + (tid >> 3), tc = (tid & 7) * 8;
    st16(wsp<bf16_t>(P, OFF_HT3) + (size_t)(c0 + cl) * NTOK + r0 + tc, ld16(T + cl * 72 + tc));
  }
  SYNC();
}
DEV void hyena_untranspose_task(const Params& P, int task, unsigned char* smem) {
  bf16_t* T = reinterpret_cast<bf16_t*>(smem);
  const int rt = task / 8, ct = task % 8;
  const int r0 = rt * 64, c0 = ct * 64;
  const int tid = threadIdx.x;
  {
    const int cl = tid >> 3, tc = (tid & 7) * 8;
    U4 v = ld16(wsp<bf16_t>(P, OFF_HYT) + (size_t)(c0 + cl) * NTOK + r0 + tc);
    const unsigned a[4] = {v.x, v.y, v.z, v.w};
#pragma unroll
    for (int j = 0; j < 8; ++j) T[(tc + j) * 72 + cl] = (bf16_t)((j & 1) ? (a[j >> 1] >> 16) : (a[j >> 1] & 0xffffu));
  }
  SYNC();
  {
    const int tl = tid >> 3, cc = (tid & 7) * 8;
    st16(wsp<bf16_t>(P, OFF_RA) + (size_t)(r0 + tl) * 1024 + c0 + cc, ld16(T + tl * 72 + cc));
  }
  SYNC();
}

template <int LOGN, int NTHR> DEV void hyena_main_item(const Params& P, int c, int pair, bool valid, F2* x, const F2* tw, int tl) {
  constexpr int N = 1 << LOGN, L = N / 2;
  constexpr bool CTX = (LOGN == LOG_NC);
  constexpr int kfoff = CTX ? 0 : 2 * L_C;
  constexpr int NI = (L + NTHR - 1) / NTHR;
  const int rowA = CTX ? (2 * pair) * L_C : NTOK_C + (2 * pair) * L_L, rowB = rowA + L;
  const bf16_t* VT = wsp<bf16_t>(P, OFF_HT3) + (size_t)c * NTOK;
  const bf16_t* G1T = VT + (size_t)512 * NTOK; const bf16_t* G2T = VT + (size_t)1024 * NTOK;
  bf16_t* HYT = wsp<bf16_t>(P, OFF_HYT) + (size_t)c * NTOK;
  const F2* KF0 = wsp<F2>(P, OFF_KF) + ((size_t)c * 2 + 0) * KF_N + kfoff;
  const F2* KF1 = KF0 + KF_N;
  const float bias0 = P.in[I_HYBIAS][c], bias1 = P.in[I_HYBIAS][512 + c];
  constexpr int NP = N / NTHR;
  float za[NI], zb[NI], g1a[NI], g1b[NI], g2a[NI], g2b[NI];
#pragma unroll
  for (int i = 0; i < NI; ++i) {
    const int t = tl + i * NTHR;
    const bool in = t < L;
    const int ta = rowA + (in ? t : 0), tb = rowB + (in ? t : 0);
    za[i] = bf2f(VT[ta]); zb[i] = bf2f(VT[tb]); g1a[i] = bf2f(G1T[ta]); g1b[i] = bf2f(G1T[tb]); g2a[i] = bf2f(G2T[ta]); g2b[i] = bf2f(G2T[tb]);
  }
  F2 k0[NP], k1[NP];
#pragma unroll
  for (int i = 0; i < NP; ++i) { k0[i] = KF0[tl + i * NTHR]; k1[i] = KF1[tl + i * NTHR]; }
#pragma unroll
  for (int i = 0; i < NI; ++i) { const int t = tl + i * NTHR; if (t < L) { x[t] = F2{za[i], zb[i]}; x[L + t] = F2{0.f, 0.f}; } }
  SYNC();
  fft_fwd_t<LOGN, NTHR>(x, tw, tl);
#pragma unroll
  for (int i = 0; i < NP; ++i) { const int p = tl + i * NTHR; const F2 v = x[p], k = k0[i]; x[p] = F2{v.x * k.x - v.y * k.y, v.x * k.y + v.y * k.x}; }
  SYNC();
  fft_inv_t<LOGN, NTHR>(x, tw, tl);
  F2 z1r[NI];
#pragma unroll
  for (int i = 0; i < NI; ++i) {
    const int t = tl + i * NTHR;
    if (t < L) {
      F2 cv = x[t];
      z1r[i] = F2{g1a[i] * (cv.x + bias0 * za[i]), g1b[i] * (cv.y + bias0 * zb[i])};
    } else z1r[i] = F2{0.f, 0.f};
  }
  SYNC();
#pragma unroll
  for (int i = 0; i < NI; ++i) { const int t = tl + i * NTHR; if (t < L) { x[t] = z1r[i]; x[L + t] = F2{0.f, 0.f}; } }
  SYNC();
  fft_fwd_t<LOGN, NTHR>(x, tw, tl);
#pragma unroll
  for (int i = 0; i < NP; ++i) { const int p = tl + i * NTHR; const F2 v = x[p], k = k1[i]; x[p] = F2{v.x * k.x - v.y * k.y, v.x * k.y + v.y * k.x}; }
  SYNC();
  fft_inv_t<LOGN, NTHR>(x, tw, tl);
  if (valid) {
#pragma unroll
    for (int i = 0; i < NI; ++i) {
      const int t = tl + i * NTHR;
      if (t < L) {
        F2 cv = x[t];
        HYT[rowA + t] = f2bf(g2a[i] * (cv.x + bias1 * z1r[i].x));
        HYT[rowB + t] = f2bf(g2b[i] * (cv.y + bias1 * z1r[i].y));
      }
    }
  }
  SYNC();
}

DEV void s5_load_u(const bf16_t* p, float* u) {
  U4 a = ld16(p), b = ld16(p + 8);
  u[0] = bflo(a.x); u[1] = bfhi(a.x); u[2] = bflo(a.y); u[3] = bfhi(a.y); u[4] = bflo(a.z); u[5] = bfhi(a.z); u[6] = bflo(a.w); u[7] = bfhi(a.w);
  u[8] = bflo(b.x); u[9] = bfhi(b.x); u[10] = bflo(b.y); u[11] = bfhi(b.y); u[12] = bflo(b.z); u[13] = bfhi(b.z); u[14] = bflo(b.w); u[15] = bfhi(b.w);
}
DEV void s5_u_load(const bf16_t* U, bf16x4* fu, int lr, int lq) {
#pragma unroll
  for (int st = 0; st < 2; ++st) { U2 v = ld8(U + (size_t)(st * 16 + lr) * 2048 + lq * 4); memcpy(&fu[st], &v, 8); }
}
DEV void s5_bb_load(const bf16_t* BB, U2* fb, int lr, int lq) {
#pragma unroll
  for (int pt = 0; pt < 8; ++pt) fb[pt] = ld8(BB + (size_t)(pt * 16 + lr) * 16 + lq * 4);
}
DEV void s5_bu_mma(const bf16x4* fu, const U2* fbv, bf16_t* Bu, int lr, int lq) {
#pragma unroll
  for (int pt = 0; pt < 8; ++pt) {
    bf16x4 fb; memcpy(&fb, &fbv[pt], 8);
#pragma unroll
    for (int st = 0; st < 2; ++st) {
      f32x4 d = mfma16k16(fb, fu[st], f32x4{0.f, 0.f, 0.f, 0.f});
      st8(Bu + (st * 16 + lr) * 136 + pt * 16 + lq * 4, U2{pack2(d[0], d[1]), pack2(d[2], d[3])});
    }
  }
}
DEV void phase_s5_pass1(const Params& P, unsigned char* smem) {
  const int lane = threadIdx.x & 63, w = threadIdx.x >> 6, lr = lane & 15, lq = lane >> 4;
  bf16_t* Bu = reinterpret_cast<bf16_t*>(smem) + (size_t)w * 32 * 136;
  const int ntask = (NTOK / 64) * 32;
  const int niter = (ntask + gridDim.x * NW - 1) / (gridDim.x * NW);
  const bf16_t* PR0 = wsp<bf16_t>(P, OFF_PROJ0) + 1536;
  const bf16_t* BB16 = wsp<bf16_t>(P, OFF_BB16);
  int t = blockIdx.x * NW + w;
  bool valid = t < ntask;
  int ch = valid ? t >> 5 : 0, g = t & 31;
  bf16x4 fu[2]; U2 fb[8];
  s5_u_load(PR0 + (size_t)(ch * 64) * 2048 + g * 16, fu, lr, lq);
  s5_bb_load(BB16 + (size_t)g * 128 * 16, fb, lr, lq);
  for (int it = 0; it < niter; ++it) {
    const bf16_t* U = PR0 + (size_t)(ch * 64) * 2048 + g * 16;
    const int tn = ((it + 1) * gridDim.x + blockIdx.x) * NW + w;
    const bool nvalid = tn < ntask;
    const int nch = nvalid ? tn >> 5 : 0, ng = tn & 31;
#pragma unroll 1
    for (int dir = 0; dir < 2; ++dir) {
      const size_t ip = ((size_t)dir * 32 + g) * 64 + lane;
      const F2 lam = wsp<F2>(P, OFF_LAMB)[ip];
      float hr = 0.f, hi = 0.f;
#pragma unroll 1
      for (int hf = 0; hf < 2; ++hf) {
        SYNC();
        s5_bu_mma(fu, fb, Bu, lr, lq);
        if (hf == 0) s5_u_load(U + (size_t)((dir ? 0 : 1) * 32) * 2048, fu, lr, lq);
        else if (dir == 0) { s5_u_load(U + (size_t)32 * 2048, fu, lr, lq); s5_bb_load(BB16 + ((size_t)32 + g) * 128 * 16, fb, lr, lq); }
        else { s5_u_load(PR0 + (size_t)(nch * 64) * 2048 + ng * 16, fu, lr, lq); s5_bb_load(BB16 + (size_t)ng * 128 * 16, fb, lr, lq); }
        SYNC();
#pragma unroll 8
        for (int s = 0; s < 32; ++s) {
          const int rl = dir ? 31 - s : s;
          const unsigned bv = *reinterpret_cast<const unsigned*>(Bu + rl * 136 + 2 * lane);
          const float nr = lam.x * hr - lam.y * hi + bflo(bv), ni = lam.x * hi + lam.y * hr + bfhi(bv);
          hr = nr; hi = ni;
        }
      }
      if (valid) wsp<F2>(P, OFF_S5C)[(((size_t)ch * 32 + g) * 2 + dir) * 64 + lane] = F2{hr, hi};
    }
    valid = nvalid; ch = nch; g = ng;
  }
}
DEV void phase_s5_carry(const Params& P) {
  const int lane = threadIdx.x & 63, w = threadIdx.x >> 6;
  const int ntask = NSEQ * 64;
  for (int t = blockIdx.x * NW + w; t < ntask; t += gridDim.x * NW) {
    const int seq = t >> 6, g = (t >> 1) & 31, dir = t & 1;
    const int c_first = seq_start(seq) / 64, n = seq_len(seq) / 64;
    const F2 lamT = wsp<F2>(P, OFF_LAMT)[((size_t)dir * 32 + g) * 64 + lane];
    float hr = 0.f, hi = 0.f;
    if (seq >= NB_C) {
      const size_t is = (((size_t)(seq - NB_C) * 2 + dir) * 32 + g) * 64 + lane;
      hr = P.in[I_S5RE][is]; hi = P.in[I_S5IM][is];
    }
    F2* SC = wsp<F2>(P, OFF_S5C) + ((size_t)g * 2 + dir) * 64 + lane;
    const int cstart = dir ? c_first + n - 1 : c_first, cstep = dir ? -1 : 1;
    for (int i0 = 0; i0 < n; i0 += 8) {
      F2 le[8];
#pragma unroll
      for (int u = 0; u < 8; ++u) { const int i = i0 + u < n ? i0 + u : n - 1; le[u] = SC[(size_t)(cstart + cstep * i) * (32 * 2 * 64)]; }
#pragma unroll
      for (int u = 0; u < 8; ++u) if (i0 + u < n) {
        SC[(size_t)(cstart + cstep * (i0 + u)) * (32 * 2 * 64)] = F2{hr, hi};
        float nr = lamT.x * hr - lamT.y * hi + le[u].x, ni = lamT.x * hi + lamT.y * hr + le[u].y; hr = nr; hi = ni;
      }
    }
    if (seq < NB_C) {
      const size_t io = (((size_t)seq * 2 + dir) * 32 + g) * 64 + lane;
      P.out[OUT_S5RE + io] = hr; P.out[OUT_S5IM + io] = hi;
    }
  }
}
DEV void phase_s5_pass2(const Params& P, unsigned char* smem) {
  const int lane = threadIdx.x & 63, w = threadIdx.x >> 6;
  const int lr = lane & 15, lq = lane >> 4;
  bf16_t* Bu = reinterpret_cast<bf16_t*>(smem) + (size_t)w * 32 * 136;
  bf16_t* Hs = reinterpret_cast<bf16_t*>(smem) + (size_t)(NW + w) * 32 * 136;
  const int ntask = (NTOK / 64) * 32;
  const int niter = (ntask + gridDim.x * NW - 1) / (gridDim.x * NW);
  const bf16_t* PR0 = wsp<bf16_t>(P, OFF_PROJ0) + 1536;
  const bf16_t* BB16 = wsp<bf16_t>(P, OFF_BB16);
  int t = blockIdx.x * NW + w;
  bool valid = t < ntask;
  int ch = valid ? t >> 5 : 0, g = t & 31;
  bf16x4 fu[2]; U2 fbb[8];
  s5_u_load(PR0 + (size_t)(ch * 64) * 2048 + g * 16, fu, lr, lq);
  s5_bb_load(BB16 + (size_t)g * 128 * 16, fbb, lr, lq);
  for (int it = 0; it < niter; ++it) {
    const int r0 = ch * 64;
    const bf16_t* U = PR0 + (size_t)r0 * 2048 + g * 16;
    const int tn = ((it + 1) * gridDim.x + blockIdx.x) * NW + w;
    const bool nvalid = tn < ntask;
    const int nch = nvalid ? tn >> 5 : 0, ng = tn & 31;
    const F4 dsk = ldf4(P.in[I_S5D] + g * 16 + lq * 4);
    U2 uu[4];
#pragma unroll
    for (int m = 0; m < 4; ++m) uu[m] = ld8(U + (size_t)(m * 16 + lr) * 2048 + lq * 4);
    f32x4 acc[4];
#pragma unroll
    for (int m = 0; m < 4; ++m) acc[m] = f32x4{0.f, 0.f, 0.f, 0.f};
#pragma unroll 1
    for (int dir = 0; dir < 2; ++dir) {
      const size_t ip = ((size_t)dir * 32 + g) * 64 + lane;
      const F2 lam = wsp<F2>(P, OFF_LAMB)[ip];
      const F2 h0 = wsp<F2>(P, OFF_S5C)[(((size_t)ch * 32 + g) * 2 + dir) * 64 + lane];
      float hr = h0.x, hi = h0.y;
      const bf16_t* CmT = wsp<bf16_t>(P, OFF_CMT) + ((size_t)dir * 32 + g) * 16 * 128;
      bf16x8 fa[4];
#pragma unroll
      for (int kk = 0; kk < 4; ++kk) fa[kk] = as_frag(ld16(CmT + lr * 128 + kk * 32 + lq * 8));
#pragma unroll 1
      for (int hf = 0; hf < 2; ++hf) {
        const int half = dir ? 1 - hf : hf;
        SYNC();
        s5_bu_mma(fu, fbb, Bu, lr, lq);
        if (hf == 0) s5_u_load(U + (size_t)((dir ? 0 : 1) * 32) * 2048, fu, lr, lq);
        else if (dir == 0) { s5_u_load(U + (size_t)32 * 2048, fu, lr, lq); s5_bb_load(BB16 + ((size_t)32 + g) * 128 * 16, fbb, lr, lq); }
        else { s5_u_load(PR0 + (size_t)(nch * 64) * 2048 + ng * 16, fu, lr, lq); s5_bb_load(BB16 + (size_t)ng * 128 * 16, fbb, lr, lq); }
        SYNC();
#pragma unroll 8
        for (int s = 0; s < 32; ++s) {
          const int rl = dir ? 31 - s : s;
          const unsigned bv = *reinterpret_cast<const unsigned*>(Bu + rl * 136 + 2 * lane);
          const float nr = lam.x * hr - lam.y * hi + bflo(bv), ni = lam.x * hi + lam.y * hr + bfhi(bv);
          hr = nr; hi = ni;
          *reinterpret_cast<unsigned*>(Hs + rl * 136 + 2 * lane) = pack2(hr, hi);
        }
        SYNC();
#pragma unroll
        for (int kk = 0; kk < 4; ++kk) {
#pragma unroll
          for (int m2 = 0; m2 < 2; ++m2) {
            bf16x8 fb = as_frag(ld16(Hs + (m2 * 16 + lr) * 136 + kk * 32 + lq * 8));
            if (half == 0) acc[m2] = mfma16(fa[kk], fb, acc[m2]); else acc[2 + m2] = mfma16(fa[kk], fb, acc[2 + m2]);
          }
        }
      }
    }
    if (valid) {
#pragma unroll
      for (int m = 0; m < 4; ++m) {
        const int row = r0 + m * 16 + lr;
        float y0 = gelu_f(acc[m][0] + dsk.x * bflo(uu[m].x)), y1 = gelu_f(acc[m][1] + dsk.y * bfhi(uu[m].x));
        float y2 = gelu_f(acc[m][2] + dsk.z * bflo(uu[m].y)), y3 = gelu_f(acc[m][3] + dsk.w * bfhi(uu[m].y));
        st8(wsp<bf16_t>(P, OFF_YS5) + (size_t)row * 512 + g * 16 + lq * 4, U2{pack2(y0, y1), pack2(y2, y3)});
      }
    }
    valid = nvalid; ch = nch; g = ng;
  }
}
struct EpiGlu { const bf16_t* Y; bf16_t* CAT; const float* b;
  DEVM bf16_t* stage_base(int, int) const { return nullptr; }
  DEVM int stage_ld() const { return 0; }
  DEVM void operator()(int m, int n, f32x4 v) const {
    U2 yy = ld8(Y + (size_t)m * 512 + n); F4 bb = ldf4(b + n);
    float o0 = bflo(yy.x) * sigmoid_f(v[0] + bb.x), o1 = bfhi(yy.x) * sigmoid_f(v[1] + bb.y);
    float o2 = bflo(yy.y) * sigmoid_f(v[2] + bb.z), o3 = bfhi(yy.y) * sigmoid_f(v[3] + bb.w);
    st8(CAT + (size_t)m * 1024 + 512 + n, U2{pack2(o0, o1), pack2(o2, o3)});
  } };

DEV void phase_l0_a(const Params& P, unsigned char* smem) {
  for (int t = blockIdx.x; t < (NTOK / 64) * 6; t += gridDim.x) hyena_conv_task(P, t, smem);
  phase_s5_pass1(P, smem);
}
#ifndef PROBE_SUB
#define PROBE_SUB 0
#endif
#ifndef PROBE_ML
#define PROBE_ML 0
#endif
DEV void phase_l0_b(const Params& P, unsigned char* smem) {
  constexpr int NLAT = 512 * (NB_L / 2), NCTX_ITEMS = 512 * (NB_C / 2), NCTX = (NCTX_ITEMS + NW - 1) / NW;
  const int lane = threadIdx.x & 63, w = threadIdx.x >> 6;
  fft_fill_twiddles<LOG_NL>(reinterpret_cast<F2*>(smem + SM_TWL)); fft_fill_twiddles<LOG_NC>(reinterpret_cast<F2*>(smem + SM_TWC));
  SYNC();
  for (int rep = 0; rep < ((PROBE_SUB & 1) ? 2 : 1); ++rep)
  for (int t = blockIdx.x; t < NLAT; t += gridDim.x)
    hyena_main_item<LOG_NL, NT>(P, t / (NB_L / 2), t % (NB_L / 2), true, reinterpret_cast<F2*>(smem), reinterpret_cast<const F2*>(smem + SM_TWL), threadIdx.x);
  for (int rep = 0; rep < ((PROBE_SUB & 2) ? 2 : 1); ++rep)
  for (int t = blockIdx.x; t < NCTX; t += gridDim.x) {
    const int item = t * NW + w;
    const bool valid = item < NCTX_ITEMS;
    const int it2 = valid ? item : 0;
    hyena_main_item<LOG_NC, 64>(P, it2 / (NB_C / 2), it2 % (NB_C / 2), valid, reinterpret_cast<F2*>(smem) + (size_t)w * (2 * L_C), reinterpret_cast<const F2*>(smem + SM_TWC), lane);
  }
  for (int rep = 0; rep < ((PROBE_SUB & 4) ? 2 : 1); ++rep)
  phase_s5_pass2(P, smem);
}
DEV void phase_l0_c(const Params& P, unsigned char* smem) {
  for (int t = blockIdx.x; t < (NTOK / 64) * 8; t += gridDim.x) hyena_untranspose_task(P, t, smem);
  gemm_phase<128>(wsp<bf16_t>(P, OFF_YS5), 512, wsp<bf16_t>(P, OFF_WGLU), 512, NTOK, 512, 512,
             EpiGlu{wsp<bf16_t>(P, OFF_YS5), wsp<bf16_t>(P, OFF_RA), P.in[I_S5GLUB]}, smem);
}


constexpr int PEER_TPW = 32;
constexpr int PEER_TILE = NW * PEER_TPW;
DEV int peer_my_slice() {
#ifndef EMU
  return (int)(xb_xcc_id() & 7u);
#else
  return (int)(blockIdx.x & 7);
#endif
}
DEV int peer_pull(unsigned* cnt, int* slot) {
  SYNC();
  if (threadIdx.x == 0) *slot = (int)atomicAdd(cnt, 1u);
  SYNC();
  return *slot;
}
DEV void peer_u_item(const Params& P, int tile_, int k_, int lane, int w) {
  const int tile = uniform_i(tile_), k = uniform_i(k_);
  const unsigned char* TU8 = wsp<unsigned char>(P, OFF_TAB8) + (size_t)k * (16384 * 128);
  const int sub = lane >> 3, chunk = lane & 7;
  const int row0 = tile * PEER_TILE + w * PEER_TPW;
  const bf16_t* XR = wsp<bf16_t>(P, OFF_RA) + (size_t)row0 * 1024 + k * 128 + chunk * 16;
  const unsigned short* EIT = wsp<unsigned short>(P, OFF_EIDX) + (size_t)row0 * 128 + 2 * lane;
  auto gather = [&](const unsigned t, int half, U4* u) {
#pragma unroll
    for (int g8 = 0; g8 < 8; ++g8) {
      const int g = half * 8 + g8;
      const unsigned pr = (unsigned)__shfl((int)t, sub * 8 + (g >> 1));
      const unsigned idx = (g & 1) ? (pr >> 16) : (pr & 0xffffu);
      u[g8] = ld16(TU8 + (unsigned)(idx * 128u + (unsigned)chunk * 16u));
    }
  };
  auto dots = [&](const U4* u, const f32x2_t* xa) {
    float res = 0.f;
#pragma unroll
    for (int g8 = 0; g8 < 8; ++g8) {
      const unsigned q[4] = {u[g8].x, u[g8].y, u[g8].z, u[g8].w};
      f32x2_t a2 = fp8lo2(q[0]) * xa[0];
      a2 = fp8hi2(q[0]) * xa[1] + a2;
#pragma unroll
      for (int j = 1; j < 4; ++j) { a2 = fp8lo2(q[j]) * xa[2 * j] + a2; a2 = fp8hi2(q[j]) * xa[2 * j + 1] + a2; }
      float acc = a2[0] + a2[1];
      acc = sum8_dpp(acc);
      if (chunk == g8) res = acc;
    }
    return res;
  };
  unsigned tcur = *reinterpret_cast<const unsigned*>(EIT), tnext = *reinterpret_cast<const unsigned*>(EIT + 128);
  U4 xr0 = ld16(XR), xr1 = ld16(XR + 8);
  U4 ua[8], ub[8];
  gather(tcur, 0, ua);
#pragma unroll 1
  for (int t = 0; t < PEER_TPW; ++t) {
    gather(tcur, 1, ub);
    f32x2_t xa[8];
    { const unsigned q[8] = {xr0.x, xr0.y, xr0.z, xr0.w, xr1.x, xr1.y, xr1.z, xr1.w};
#pragma unroll
      for (int j = 0; j < 8; ++j) { xa[j][0] = bflo(q[j]); xa[j][1] = bfhi(q[j]); } }
    const int tn = t + 1 < PEER_TPW ? t + 1 : PEER_TPW - 1;
    xr0 = ld16(XR + (size_t)tn * 1024); xr1 = ld16(XR + (size_t)tn * 1024 + 8);
    const float res0 = dots(ua, xa);
    gather(tnext, 0, ua);
    const float res1 = dots(ub, xa);
    {
      const int srcA = (lane >> 4) * 8 + (lane & 7), srcB = srcA + 32;
      const float a0 = __shfl(res0, srcA), a1 = __shfl(res1, srcA), b0 = __shfl(res0, srcB), b1 = __shfl(res1, srcB);
      bf16_t* pp = wsp<bf16_t>(P, OFF_PART) + ((size_t)k * NTOK + row0 + t) * 128;
      pp[lane] = f2bf((lane & 8) ? a1 : a0); pp[64 + lane] = f2bf((lane & 8) ? b1 : b0);
    }
    tcur = tnext;
    tnext = *reinterpret_cast<const unsigned*>(EIT + (size_t)(t + 2 < PEER_TPW ? t + 2 : PEER_TPW - 1) * 128);
  }
}
DEV void phase_peer_u(const Params& P, int layer, int rep, unsigned char* smem) {
  int* slot = reinterpret_cast<int*>(smem);
  unsigned* qc = reinterpret_cast<unsigned*>(P.ws + OFF_QCNT) + (layer * 2 + 0) * 8;
  const int tidq = tid_opaque();
  const int lane = tidq & 63, w = tidq >> 6;
  const int my = peer_my_slice();
  for (int s = 0; s < 8; ++s) {
    const int k = (my + s) & 7;
    for (;;) { const int t = peer_pull(qc + k, slot) - rep * (NTOK / PEER_TILE + (int)gridDim.x); if (t >= NTOK / PEER_TILE) break; peer_u_item(P, t, k, lane, w); }
  }
}
DEV void phase_peer_act(const Params& P, unsigned char* smem) {
  float* rs = reinterpret_cast<float*>(smem);
  const float* RSC = wsp<float>(P, OFF_RSC);
  for (int i = threadIdx.x * 4; i < 2 * 16384; i += NT * 4) stf4(rs + i, ldf4(RSC + i));
  SYNC();
  const bf16_t* PART = wsp<bf16_t>(P, OFF_PART);
  const unsigned short* EI = wsp<unsigned short>(P, OFF_EIDX);
  bf16_t* GT = wsp<bf16_t>(P, OFF_EGT);
  for (size_t i = ((size_t)blockIdx.x * NT + threadIdx.x) * 4; i < (size_t)NTOK * 128; i += (size_t)gridDim.x * NT * 4) {
    F4 d{0.f, 0.f, 0.f, 0.f};
#pragma unroll
    for (int k = 0; k < 8; ++k) { const U2 p = ld8(PART + (size_t)k * NTOK * 128 + i); d.x += bflo(p.x); d.y += bfhi(p.x); d.z += bflo(p.y); d.w += bfhi(p.y); }
    const U2 eq = ld8(EI + i), gq = ld8(GT + i);
    const unsigned e0 = eq.x & 0xffffu, e1 = eq.x >> 16, e2 = eq.y & 0xffffu, e3 = eq.y >> 16;
    st8(GT + i, U2{pack2(gelu_f(d.x * rs[e0]) * bflo(gq.x) * rs[16384 + e0], gelu_f(d.y * rs[e1]) * bfhi(gq.x) * rs[16384 + e1]),
                   pack2(gelu_f(d.z * rs[e2]) * bflo(gq.y) * rs[16384 + e2], gelu_f(d.w * rs[e3]) * bfhi(gq.y) * rs[16384 + e3])});
  }
}
DEV void peer_v_item(const Params& P, int layer, float xscale, int tile_, int k_, int lane, int w) {
  const int tile = uniform_i(tile_), k = uniform_i(k_);
  const unsigned char* TV8 = wsp<unsigned char>(P, OFF_TAB8) + (size_t)16384 * 1024 + (size_t)k * (16384 * 128);
  const float* G2 = wsp<float>(P, OFF_MOD) + (size_t)layer * NCOND * 6144 + 5 * 1024;
  const int sub = lane >> 3, chunk = lane & 7;
  const bool b5 = (lane & 32) != 0, b4 = (lane & 16) != 0, b3 = (lane & 8) != 0;
  const int row0 = tile * PEER_TILE + w * PEER_TPW;
  const unsigned short* EIT = wsp<unsigned short>(P, OFF_EIDX) + (size_t)row0 * 128 + 2 * lane;
  const bf16_t* ATT = wsp<bf16_t>(P, OFF_EGT) + (size_t)row0 * 128 + 2 * lane;
  const int c = k * 128 + chunk * 16 + (b5 ? 8 : 0) + (b4 ? 4 : 0) + (b3 ? 2 : 0);
  auto gather = [&](const unsigned t, const unsigned ta, int half, U4* u, float* av) {
#pragma unroll
    for (int g8 = 0; g8 < 8; ++g8) {
      const int g = half * 8 + g8, src = sub * 8 + (g >> 1);
      const unsigned pr = (unsigned)__shfl((int)t, src), pa = (unsigned)__shfl((int)ta, src);
      const unsigned idx = (g & 1) ? (pr >> 16) : (pr & 0xffffu);
      av[g8] = (g & 1) ? bfhi(pa) : bflo(pa);
      u[g8] = ld16(TV8 + (unsigned)(idx * 128u + (unsigned)chunk * 16u));
    }
  };
  auto axpy = [&](const U4* u, const float* av, f32x2_t* oa) {
#pragma unroll
    for (int g8 = 0; g8 < 8; ++g8) {
      const unsigned q[4] = {u[g8].x, u[g8].y, u[g8].z, u[g8].w};
      f32x2_t a2; a2[0] = av[g8]; a2[1] = av[g8];
#pragma unroll
      for (int j = 0; j < 4; ++j) { oa[2 * j] = fp8lo2(q[j]) * a2 + oa[2 * j]; oa[2 * j + 1] = fp8hi2(q[j]) * a2 + oa[2 * j + 1]; }
    }
  };
  unsigned tcur = *reinterpret_cast<const unsigned*>(EIT), tnext = *reinterpret_cast<const unsigned*>(EIT + 128);
  unsigned acur = *reinterpret_cast<const unsigned*>(ATT), anext = *reinterpret_cast<const unsigned*>(ATT + 128);
  U4 va[8], vb[8]; float aa[8], ab[8];
  gather(tcur, acur, 0, va, aa);
#pragma unroll 1
  for (int t = 0; t < PEER_TPW; ++t) {
    gather(tcur, acur, 1, vb, ab);
    f32x2_t oa2[8];
#pragma unroll
    for (int j = 0; j < 8; ++j) { oa2[j][0] = 0.f; oa2[j][1] = 0.f; }
    axpy(va, aa, oa2);
    gather(tnext, anext, 0, va, aa);
    axpy(vb, ab, oa2);
    float oa[16];
#pragma unroll
    for (int j = 0; j < 8; ++j) { oa[2 * j] = oa2[j][0]; oa[2 * j + 1] = oa2[j][1]; }
    const int row = row0 + t;
    float r8[8], r4[4], r2[2];
#pragma unroll
    for (int i = 0; i < 8; ++i) r8[i] = (b5 ? oa[8 + i] : oa[i]) + __shfl_xor(b5 ? oa[i] : oa[8 + i], 32);
#pragma unroll
    for (int i = 0; i < 4; ++i) r4[i] = (b4 ? r8[4 + i] : r8[i]) + __shfl_xor(b4 ? r8[i] : r8[4 + i], 16);
#pragma unroll
    for (int i = 0; i < 2; ++i) r2[i] = (b3 ? r4[2 + i] : r4[i]) + __shfl_xor(b3 ? r4[i] : r4[2 + i], 8);
    float* X = wsp<float>(P, OFF_X) + (size_t)row * 1024 + c;
    const float* g2 = G2 + (size_t)row_cond(row) * 6144 + c;
    F2 xv = *reinterpret_cast<F2*>(X); const F2 gv = *reinterpret_cast<const F2*>(g2);
    xv.x += xscale * gv.x * r2[0]; xv.y += xscale * gv.y * r2[1];
    *reinterpret_cast<F2*>(X) = xv;
    tcur = tnext; acur = anext;
    const int t2 = t + 2 < PEER_TPW ? t + 2 : PEER_TPW - 1;
    tnext = *reinterpret_cast<const unsigned*>(EIT + (size_t)t2 * 128); anext = *reinterpret_cast<const unsigned*>(ATT + (size_t)t2 * 128);
  }
}
DEV void phase_peer_v(const Params& P, int layer, float xscale, int rep, unsigned char* smem) {
  int* slot = reinterpret_cast<int*>(smem);
  unsigned* qc = reinterpret_cast<unsigned*>(P.ws + OFF_QCNT) + (layer * 2 + 1) * 8;
  const int tidq = tid_opaque();
  const int lane = tidq & 63, w = tidq >> 6;
  const int my = peer_my_slice();
  for (int s = 0; s < 8; ++s) {
    const int k = (my + s) & 7;
    for (;;) { const int t = peer_pull(qc + k, slot) - rep * (NTOK / PEER_TILE + (int)gridDim.x); if (t >= NTOK / PEER_TILE) break; peer_v_item(P, layer, xscale, t, k, lane, w); }
  }
}

struct EpiGates { float* GTS;
  DEVM bf16_t* stage_base(int, int) const { return nullptr; }
  DEVM int stage_ld() const { return 0; }
  DEVM void operator()(int m, int n, f32x4 v) const { if (n < 32) stf4(GTS + (size_t)m * 32 + n, F4{v[0], v[1], v[2], v[3]}); } };
DEV void phase_odin(const Params& P, unsigned char* smem) {
  gemm_phase<256>(wsp<bf16_t>(P, OFF_RA), 1024, wsp<bf16_t>(P, OFF_WODIN), 1024, NTOK, 4096, 1024, EpiStoreBf16{wsp<bf16_t>(P, OFF_PROJ1), 4096}, smem);
  EpiGates eg{wsp<float>(P, OFF_GATES)};
  for (int t = (int)gridDim.x - 1 - (int)blockIdx.x; t < NTOK / 256; t += gridDim.x)
    gemm_tile<128>(wsp<bf16_t>(P, OFF_RA), 1024, wsp<bf16_t>(P, OFF_WODIN) + (size_t)4096 * 1024, 1024, 1024, t * 256, 0, eg, smem);
}

DEV void phase_gate_scan(const Params& P) {
  const int lane = threadIdx.x & 63, w = threadIdx.x >> 6;
  const float* GTS = wsp<float>(P, OFF_GATES);
  float* GS = wsp<float>(P, OFF_GS);
  const int ntask = (NTOK / 128) * 16;
  for (int t = blockIdx.x * NW + w; t < ntask; t += gridDim.x * NW) {
    const int tc = t >> 4, head = (t >> 1) & 7, dir = t & 1;
    const float gbi = P.in[I_ODGATEB][dir * 8 + head], gbf = P.in[I_ODGATEB][16 + dir * 8 + head];
    float carry_b = 0.f, carry_m = -3.0e38f;
    float* out = GS + ((size_t)(tc * 8 + head) * 2 + dir) * 384;
#pragma unroll
    for (int hf = 0; hf < 2; ++hf) {
      const int s = lane + 64 * hf;
      const int row = tc * 128 + (dir ? 127 - s : s);
      const float ig = GTS[(size_t)row * 32 + dir * 8 + head] + gbi;
      const float fg = GTS[(size_t)row * 32 + 16 + dir * 8 + head] + gbf;
      float b = log_sigmoid_f(fg);
      for (int d = 1; d < 64; d <<= 1) { float o = __shfl_up(b, d); if (lane >= d) b += o; }
      b += carry_b;
      float c = ig - b, pm = c;
      for (int d = 1; d < 64; d <<= 1) { float o = __shfl_up(pm, d); if (lane >= d) pm = fmaxf(pm, o); }
      pm = fmaxf(pm, carry_m);
      carry_b = __shfl(b, 63); carry_m = __shfl(pm, 63);
      out[s] = b; out[128 + s] = c; out[256 + s] = pm;
    }
  }
}
DEV void phase_qkconv(const Params& P) {
  const bf16_t* PR = wsp<bf16_t>(P, OFF_PROJ1);
  bf16_t* QC = wsp<bf16_t>(P, OFF_QC); bf16_t* KC = wsp<bf16_t>(P, OFF_KC);
  const float* cw = P.in[I_MLCW]; const float* cbias = P.in[I_MLCB];
  const int tid = threadIdx.x;
  for (int t = blockIdx.x; t < (NTOK / 64) * 4; t += gridDim.x) {
    const int r0 = (t >> 2) * 64, c0 = (t & 3) * 512;
    const int c = c0 + (tid & 63) * 8;
    F4 w0a = ldf4(cw + c), w0b = ldf4(cw + c + 4), w1a = ldf4(cw + 2048 + c), w1b = ldf4(cw + 2048 + c + 4);
    F4 w2a = ldf4(cw + 4096 + c), w2b = ldf4(cw + 4096 + c + 4), ba = ldf4(cbias + c), bb = ldf4(cbias + c + 4);
    const float w0[8] = {w0a.x, w0a.y, w0a.z, w0a.w, w0b.x, w0b.y, w0b.z, w0b.w};
    const float w1[8] = {w1a.x, w1a.y, w1a.z, w1a.w, w1b.x, w1b.y, w1b.z, w1b.w};
    const float w2[8] = {w2a.x, w2a.y, w2a.z, w2a.w, w2b.x, w2b.y, w2b.z, w2b.w};
    const float bs[8] = {ba.x, ba.y, ba.z, ba.w, bb.x, bb.y, bb.z, bb.w};
    const float sc = c < 1024 ? 0.08838834764831845f : 1.f;
#pragma unroll 2
    for (int i = 0; i < 8; ++i) {
      const int item = i * NT + tid;
      const int row = r0 + (item >> 6);
      const int pos = row_pos(row), L = row < NTOK_C ? L_C : L_L;
      const bf16_t* p = PR + (size_t)row * 4096 + c;
      const U4 z4{0u, 0u, 0u, 0u};
      U4 xm = pos > 0 ? ld16(p - 4096) : z4, x0 = ld16(p), xp = pos < L - 1 ? ld16(p + 4096) : z4;
      const unsigned am[4] = {xm.x, xm.y, xm.z, xm.w}, a0[4] = {x0.x, x0.y, x0.z, x0.w}, ap[4] = {xp.x, xp.y, xp.z, xp.w};
      float o[8];
#pragma unroll
      for (int j = 0; j < 8; ++j) {
        float vm = (j & 1) ? bfhi(am[j >> 1]) : bflo(am[j >> 1]);
        float v0 = (j & 1) ? bfhi(a0[j >> 1]) : bflo(a0[j >> 1]);
        float vp = (j & 1) ? bfhi(ap[j >> 1]) : bflo(ap[j >> 1]);
        o[j] = silu_f(vm * w0[j] + v0 * w1[j] + vp * w2[j] + bs[j]) * sc;
      }
      bf16_t* dst = c < 1024 ? QC + (size_t)row * 1024 + c : KC + (size_t)row * 1024 + (c - 1024);
      st16(dst, U4{pack2(o[0], o[1]), pack2(o[2], o[3]), pack2(o[4], o[5]), pack2(o[6], o[7])});
    }
  }
}
constexpr int ML_LD = 136;
constexpr int ML_SLW = 64;
constexpr int ML_NSL = 128 / ML_SLW;
constexpr int ML_NVT = ML_SLW / 16 + 1;
constexpr int ML_VR = 16 * ML_NVT;
constexpr int ML_NVL = ML_SLW / 32;
constexpr int ML_LDV = ML_VR + 8;
DEV void phase_mlstm(const Params& P, unsigned char* smem) {
  bf16_t* Ks = reinterpret_cast<bf16_t*>(smem);
  bf16_t* Vn = Ks + 128 * ML_LD;
  bf16_t* Vwn = Vn + 128 * ML_LDV;
  bf16_t* Ct0 = Vwn + 128 * ML_LDV;
  float* cs = reinterpret_cast<float*>(Ct0 + 2 * ML_VR * ML_LD);
  float* Mt = cs + 128; float* bt = Mt + 128; float* misc = bt + 128;
  int* qslot = reinterpret_cast<int*>(misc + 8);
  unsigned* qcnt = reinterpret_cast<unsigned*>(P.ws + OFF_QCNT) + 32;
  const int tid = threadIdx.x, lane = tid & 63, w = tid >> 6, lr = lane & 15, lq = lane >> 4;
  const bf16_t* PR = wsp<bf16_t>(P, OFF_PROJ1);
  const bf16_t* QC = wsp<bf16_t>(P, OFF_QC); const bf16_t* KC = wsp<bf16_t>(P, OFF_KC);
  constexpr int TPS = 16 * ML_NSL;
  constexpr int NLAT = NB_L * TPS, NTASK = (NB_L + NB_C) * TPS;
  constexpr int TABG = 16;
  for (;;) {
    const int task = peer_pull(qcnt, qslot);
    if (task >= NTASK + TAB_TILES / TABG) break;
    if (task >= NTASK) {
      for (int i = 0; i < TABG; ++i) job_tab(P, 1, (task - NTASK) * TABG + i);
      continue;
    }
    const int seq = task < NLAT ? NB_C + task / TPS : (task - NLAT) / TPS;
    const int rem = task % TPS, head = rem / (2 * ML_NSL), dir = (rem / ML_NSL) & 1, sl = rem % ML_NSL;
    const int L = seq_len(seq), nchunk = L / 128, rbase = seq_start(seq);
    bf16_t* HO = wsp<bf16_t>(P, OFF_PROJ1) + (dir ? 1024 : 0);
    f32x4 Cacc[ML_NVT];
    float m_prev = 0.f;
#pragma unroll
    for (int vt = 0; vt < ML_NVT; ++vt) Cacc[vt] = f32x4{0.f, 0.f, 0.f, 0.f};
    if (seq >= NB_C) {
      const size_t sb = ((size_t)(seq - NB_C) * 2 + dir) * 8 + head;
      const float* C0 = P.in[I_MLC] + sb * 16384;
      const int k = 16 * w + lr;
#pragma unroll
      for (int vt = 0; vt < ML_NVT - 1; ++vt) { F4 c = ldf4(C0 + (size_t)k * 128 + sl * ML_SLW + 16 * vt + 4 * lq); Cacc[vt] = f32x4{c.x, c.y, c.z, c.w}; }
      if (lq == 0) Cacc[ML_NVT - 1][0] = P.in[I_MLN][sb * 128 + k];
      m_prev = P.in[I_MLM][sb];
    }
    if (tid < 128) {
      st16(Vn + tid * ML_LDV + ML_SLW, U4{0x3f80u, 0u, 0u, 0u}); st16(Vn + tid * ML_LDV + ML_SLW + 8, U4{0u, 0u, 0u, 0u});
      st16(Vn + tid * ML_LDV + ML_SLW + 16, U4{0u, 0u, 0u, 0u});
      st16(Vwn + tid * ML_LDV + ML_SLW + 8, U4{0u, 0u, 0u, 0u}); st16(Vwn + tid * ML_LDV + ML_SLW + 16, U4{0u, 0u, 0u, 0u});
    }
#pragma unroll
    for (int vt = 0; vt < ML_NVT; ++vt)
#pragma unroll
      for (int r = 0; r < 4; ++r) Ct0[(16 * vt + 4 * lq + r) * ML_LD + 16 * w + lr] = f2bf(Cacc[vt][r]);
    U4 kreg[4], vreg[ML_NVL], qreg[4]; float gsb[2] = {0.f, 0.f}, gsc[2] = {0.f, 0.f}, gsm[2] = {0.f, 0.f}; float cs_row = 0.f, pm_last = 0.f;
    const float* GSq = wsp<float>(P, OFF_GS);
    auto prefetch = [&](int ci) {
      {
        const int s = tid >> 2, cg = (tid & 3) * 32;
        const int off = ci * 128 + s;
        const int row = rbase + (dir ? L - 1 - off : off);
#pragma unroll
        for (int q8 = 0; q8 < 4; ++q8) kreg[q8] = ld16(KC + (size_t)row * 1024 + head * 128 + cg + q8 * 8);
#pragma unroll
        for (int i = 0; i < ML_NVL; ++i) vreg[i] = ld16(PR + (size_t)row * 4096 + 2048 + head * 128 + sl * ML_SLW + (tid & 3) * (ML_SLW / 4) + i * 8);
      }
      {
        const int off = ci * 128 + 16 * (w < 4 ? w : 11 - w) + lr;
        const int row = rbase + (dir ? L - 1 - off : off);
#pragma unroll
        for (int kk = 0; kk < 4; ++kk) qreg[kk] = ld16(QC + (size_t)row * 1024 + head * 128 + kk * 32 + lq * 8);
      }
      {
        const int tc = (rbase >> 7) + (dir ? nchunk - 1 - ci : ci);
        const float* g = GSq + ((size_t)(tc * 8 + head) * 2 + dir) * 384;
        cs_row = g[128 + (tid >> 2)]; pm_last = g[256 + 127];
        if (w == 0) {
#pragma unroll
          for (int hf = 0; hf < 2; ++hf) { gsb[hf] = g[lane + 64 * hf]; gsc[hf] = g[128 + lane + 64 * hf]; gsm[hf] = g[256 + lane + 64 * hf]; }
        }
      }
    };
    prefetch(0);
    for (int ci = 0; ci < nchunk; ++ci) {
      const bf16_t* Ct = Ct0 + (ci & 1) * ML_VR * ML_LD;
      bf16_t* Cn = Ct0 + ((ci + 1) & 1) * ML_VR * ML_LD;
      SYNC();
      if (w == 0) {
#pragma unroll
        for (int hf = 0; hf < 2; ++hf) { const int s = lane + 64 * hf; cs[s] = gsc[hf]; bt[s] = gsb[hf]; Mt[s] = fmaxf(m_prev, gsm[hf]); }
        if (lane == 63) { misc[0] = gsb[1]; misc[1] = fmaxf(m_prev, gsm[1]); }
      }
      {
        const int s = tid >> 2, cg = (tid & 3) * 32;
#pragma unroll
        for (int q8 = 0; q8 < 4; ++q8) st16(Ks + s * ML_LD + cg + q8 * 8, kreg[q8]);
        const float ws = __expf(cs_row - fmaxf(m_prev, pm_last));
#pragma unroll
        for (int i = 0; i < ML_NVL; ++i) {
          const int vc = (tid & 3) * (ML_SLW / 4) + i * 8;
          st16(Vn + s * ML_LDV + vc, vreg[i]);
          const unsigned va[4] = {vreg[i].x, vreg[i].y, vreg[i].z, vreg[i].w};
          st16(Vwn + s * ML_LDV + vc, U4{pack2(bflo(va[0]) * ws, bfhi(va[0]) * ws), pack2(bflo(va[1]) * ws, bfhi(va[1]) * ws),
                                          pack2(bflo(va[2]) * ws, bfhi(va[2]) * ws), pack2(bflo(va[3]) * ws, bfhi(va[3]) * ws)});
        }
        if ((tid & 3) == 0) st16(Vwn + s * ML_LDV + ML_SLW, U4{(unsigned)f2bf(ws), 0u, 0u, 0u});
      }
      bf16x8 qf[4];
#pragma unroll
      for (int kk = 0; kk < 4; ++kk) qf[kk] = as_frag(qreg[kk]);
      SYNC();
      prefetch(ci + 1 < nchunk ? ci + 1 : ci);
      const float M_last = misc[1], b_last = misc[0];
      const int tb = w < 4 ? w : 11 - w;
      const int t = 16 * tb + lr;
      const float M_t = Mt[t];
      f32x4 accn[ML_NVT];
#pragma unroll
      for (int vt = 0; vt < ML_NVT; ++vt) {
        accn[vt] = f32x4{0.f, 0.f, 0.f, 0.f};
#pragma unroll
        for (int kk = 0; kk < 4; ++kk) accn[vt] = mfma16(as_frag(ld16(Ct + (16 * vt + lr) * ML_LD + kk * 32 + lq * 8)), qf[kk], accn[vt]);
        const float wi = __expf(m_prev - M_t);
#pragma unroll
        for (int r = 0; r < 4; ++r) accn[vt][r] *= wi;
      }
      for (int j2 = 0; 2 * j2 <= tb; ++j2) {
        unsigned pk[4] = {0u, 0u, 0u, 0u};
#pragma unroll
        for (int hh = 0; hh < 2; ++hh) {
          const int i = 2 * j2 + hh;
          if (i <= tb) {
            f32x4 sa = f32x4{0.f, 0.f, 0.f, 0.f};
#pragma unroll
            for (int kk = 0; kk < 4; ++kk) sa = mfma16(as_frag(ld16(Ks + (16 * i + lr) * ML_LD + kk * 32 + lq * 8)), qf[kk], sa);
            float pv[4];
#pragma unroll
            for (int r = 0; r < 4; ++r) {
              const int s = 16 * i + 4 * lq + r;
              pv[r] = s <= t ? sa[r] * __expf(cs[s] - M_t) : 0.f;
            }
            pk[hh * 2] = pack2(pv[0], pv[1]); pk[hh * 2 + 1] = pack2(pv[2], pv[3]);
          }
        }
        const bf16x8 pf = as_frag(U4{pk[0], pk[1], pk[2], pk[3]});
#pragma unroll
        for (int vt = 0; vt < ML_NVT; ++vt) {
          const bf16_t* vp = Vn + (32 * j2 + 4 * lq + (lr >> 2)) * ML_LDV + 16 * vt + 4 * (lr & 3);
          accn[vt] = mfma16(as_frag2(lds_tr_read(vp), lds_tr_read(vp + 16 * ML_LDV)), pf, accn[vt]);
        }
      }
      {
        const float den = __shfl(accn[ML_NVT - 1][0], lr);
        const float flo = __expf(-(bt[t] + M_t));
        const float inv = 1.f / fmaxf(fabsf(den), flo);
        const int off = ci * 128 + t;
        const int row = dir ? rbase + L - 1 - off : rbase + off;
#pragma unroll
        for (int vt = 0; vt < ML_NVT - 1; ++vt)
          st8(HO + (size_t)row * HLD + head * 128 + sl * ML_SLW + 16 * vt + 4 * lq,
              U2{pack2(accn[vt][0] * inv, accn[vt][1] * inv), pack2(accn[vt][2] * inv, accn[vt][3] * inv)});
      }
      {
        const float keep = __expf(m_prev - M_last);
        bf16x8 kf[4];
#pragma unroll
        for (int ss = 0; ss < 4; ++ss) {
          const bf16_t* kp = Ks + (32 * ss + 8 * lq + (lr >> 2)) * ML_LD + 16 * w + 4 * (lr & 3);
          kf[ss] = as_frag2(lds_tr_read(kp), lds_tr_read(kp + 4 * ML_LD));
        }
#pragma unroll
        for (int vt = 0; vt < ML_NVT; ++vt) {
#pragma unroll
          for (int r = 0; r < 4; ++r) Cacc[vt][r] *= keep;
#pragma unroll
          for (int ss = 0; ss < 4; ++ss) {
            const bf16_t* wp = Vwn + (32 * ss + 8 * lq + (lr >> 2)) * ML_LDV + 16 * vt + 4 * (lr & 3);
            Cacc[vt] = mfma16(as_frag2(lds_tr_read(wp), lds_tr_read(wp + 4 * ML_LDV)), kf[ss], Cacc[vt]);
          }
#pragma unroll
          for (int r = 0; r < 4; ++r) Cn[(16 * vt + 4 * lq + r) * ML_LD + 16 * w + lr] = f2bf(Cacc[vt][r]);
        }
        m_prev = b_last + M_last;
      }
    }
    if (seq < NB_C) {
      const size_t sb = ((size_t)seq * 2 + dir) * 8 + head;
      const int k = 16 * w + lr;
#pragma unroll
      for (int vt = 0; vt < ML_NVT - 1; ++vt)
        stf4(P.out + OUT_MLC + sb * 16384 + (size_t)k * 128 + sl * ML_SLW + 16 * vt + 4 * lq, F4{Cacc[vt][0], Cacc[vt][1], Cacc[vt][2], Cacc[vt][3]});
      if (sl == 0 && lq == 0) P.out[OUT_MLN + sb * 128 + k] = Cacc[ML_NVT - 1][0];
      if (sl == 0 && tid == 0) P.out[OUT_MLM + sb] = m_prev;
    }
  }
}
DEV void phase_mlstm_norm(const Params& P) {
  const int lane = threadIdx.x & 63, w = threadIdx.x >> 6;
  const bf16_t* PR = wsp<bf16_t>(P, OFF_PROJ1);
  const bf16_t* HF = PR; const bf16_t* HB = PR + 1024;
  bf16_t* HN = wsp<bf16_t>(P, OFF_RA);
  for (int r = blockIdx.x * NW + w; r < NTOK; r += gridDim.x * NW) {
    float h[16], o[16];
#pragma unroll
    for (int hh = 0; hh < 2; ++hh) {
      const int c = hh * 512 + lane * 8;
      U4 a = ld16(HF + (size_t)r * HLD + c), b = ld16(HB + (size_t)r * HLD + c), ov = ld16(PR + (size_t)r * 4096 + 3072 + c);
      const unsigned aa[4] = {a.x, a.y, a.z, a.w}, bb[4] = {b.x, b.y, b.z, b.w}, oo[4] = {ov.x, ov.y, ov.z, ov.w};
#pragma unroll
      for (int j = 0; j < 4; ++j) {
        h[hh * 8 + 2 * j] = bflo(aa[j]) + bflo(bb[j]); h[hh * 8 + 2 * j + 1] = bfhi(aa[j]) + bfhi(bb[j]);
        o[hh * 8 + 2 * j] = bflo(oo[j]); o[hh * 8 + 2 * j + 1] = bfhi(oo[j]);
      }
    }
#pragma unroll
    for (int hh = 0; hh < 2; ++hh) {
      const int c = hh * 512 + lane * 8;
      float ss = 0.f;
#pragma unroll
      for (int j = 0; j < 8; ++j) ss += h[hh * 8 + j] * h[hh * 8 + j];
      ss += __shfl_xor(ss, 1); ss += __shfl_xor(ss, 2); ss += __shfl_xor(ss, 4); ss += __shfl_xor(ss, 8);
      const float rs = rsqrtf(ss * (1.f / 128.f) + EPS);
      const F4 g0 = ldf4(P.in[I_MLNORMG] + c), g1 = ldf4(P.in[I_MLNORMG] + c + 4);
      const float ng[8] = {g0.x, g0.y, g0.z, g0.w, g1.x, g1.y, g1.z, g1.w};
      unsigned pk[4];
#pragma unroll
      for (int j = 0; j < 4; ++j) pk[j] = pack2(h[hh * 8 + 2 * j] * rs * ng[2 * j] * silu_f(o[hh * 8 + 2 * j]), h[hh * 8 + 2 * j + 1] * rs * ng[2 * j + 1] * silu_f(o[hh * 8 + 2 * j + 1]));
      st16(HN + (size_t)r * 1024 + c, U4{pk[0], pk[1], pk[2], pk[3]});
    }
  }
}
DEV void phase_final(const Params& P) {
  const int lane = threadIdx.x & 63, w = threadIdx.x >> 6;
  const float* X = wsp<float>(P, OFF_X);
  const float* g = P.in[I_FINALG];
  F4 gq[4];
#pragma unroll
  for (int i = 0; i < 4; ++i) gq[i] = ldf4(g + i * 256 + lane * 4);
  for (int r = blockIdx.x * NW + w; r < NTOK; r += gridDim.x * NW) {
    const float* x = X + (size_t)r * 1024;
    F4 v[4]; float ss = 0.f;
#pragma unroll
    for (int i = 0; i < 4; ++i) { v[i] = ldf4(x + i * 256 + lane * 4); ss += v[i].x * v[i].x + v[i].y * v[i].y + v[i].z * v[i].z + v[i].w * v[i].w; }
    ss = wave_sum(ss);
    const float rs = rsqrtf(ss * (1.f / 1024.f) + EPS);
#pragma unroll
    for (int i = 0; i < 4; ++i) {
      const int c = i * 256 + lane * 4;
      const F4 gg = gq[i];
      stf4_nt(P.out + OUT_Y + (size_t)r * 1024 + c, F4{v[i].x * rs * gg.x, v[i].y * rs * gg.y, v[i].z * rs * gg.z, v[i].w * rs * gg.w});
    }
  }
}


constexpr int NPHASE = 25;
constexpr size_t SMEM_BYTES = 160 * 1024;
#ifndef ONLY_PHASE
#define ONLY_PHASE -1
#endif
#ifndef EXCL_MASK
#define EXCL_MASK 0u
#endif
#define PH_EN(k) ((ONLY_PHASE < 0 || ONLY_PHASE == (k)) && !(((EXCL_MASK) >> (k)) & 1u))
#ifndef PROBE_MASK
#define PROBE_MASK 0u
#endif
#ifndef PROBE_SYNC2
#define PROBE_SYNC2 0
#endif
#define PROBE_ON(k) (((PROBE_MASK) >> (k)) & 1u)
#define PROBE_SCALE(k) (PROBE_ON(k) ? 0.5f : 1.0f)
DEV void run_phase(const Params& P, int ph, unsigned char* smem, int rep = 0) {
  switch (ph) {
    case 0: if (PH_EN(0)) { phase_prep(P, smem); } break;
    case 1: if (PH_EN(1)) { phase_norm(P, 0, 0, false); phase_hyena_filters(P, smem); } break;
    case 2: if (PH_EN(2)) { gemm_phase<256>(wsp<bf16_t>(P, OFF_RA), 1024, wsp<bf16_t>(P, OFF_WEVIN), 1024, NTOK, 2048, 1024,
                       EpiStoreBf16{wsp<bf16_t>(P, OFF_PROJ0), 2048}, smem); } break;
    case 3: if (PH_EN(3)) { phase_l0_a(P, smem); } break;
    case 4: if (PH_EN(4)) { phase_s5_carry(P); } break;
    case 5: if (PH_EN(5)) { phase_l0_b(P, smem); } break;
    case 6: if (PH_EN(6)) { phase_l0_c(P, smem); } break;
    case 7: if (PH_EN(7)) { gemm_phase<128>(wsp<bf16_t>(P, OFF_RA), 1024, wsp<bf16_t>(P, OFF_WEVOUT), 1024, NTOK, 1024, 1024,
                       EpiResid{wsp<float>(P, OFF_X), wsp<float>(P, OFF_MOD) + 2 * 1024, PROBE_SCALE(7)}, smem); } break;
    case 8: if (PH_EN(8)) { phase_norm(P, 0, 1, true); phase_wf(P, 0, smem); } break;
    case 9: if (PH_EN(9)) { gemm_phase<256>(wsp<bf16_t>(P, OFF_RA), 1024, wsp<bf16_t>(P, OFF_WF), 1024, NTOK, 2048, 1024,
                       EpiTopk{wsp<unsigned short>(P, OFF_EIDX), wsp<bf16_t>(P, OFF_EGT)}, smem); } break;
    case 10: if (PH_EN(10)) { phase_peer_u(P, 0, rep, smem); } break;
    case 11: if (PH_EN(11)) { phase_peer_act(P, smem); } break;
    case 12: if (PH_EN(12)) { phase_peer_v(P, 0, PROBE_SCALE(12), rep, smem); } break;
    case 13: if (PH_EN(13)) { phase_norm(P, 1, 0, false); } break;
    case 14: if (PH_EN(14)) { phase_odin(P, smem); } break;
    case 15: if (PH_EN(15)) { phase_qkconv(P); phase_gate_scan(P); } break;
    case 16: if (PH_EN(16)) { phase_mlstm(P, smem); } break;
    case 17: if (PH_EN(17)) { phase_mlstm_norm(P); } break;
    case 18: if (PH_EN(18)) { gemm_phase<128>(wsp<bf16_t>(P, OFF_RA), 1024, wsp<bf16_t>(P, OFF_WODOUT), 1024, NTOK, 1024, 1024,
                        EpiResid{wsp<float>(P, OFF_X), wsp<float>(P, OFF_MOD) + (size_t)NCOND * 6144 + 2 * 1024, PROBE_SCALE(18)}, smem); } break;
    case 19: if (PH_EN(19)) { phase_norm(P, 1, 1, false); phase_wf(P, 1, smem); } break;
    case 20: if (PH_EN(20)) { gemm_phase<256>(wsp<bf16_t>(P, OFF_RA), 1024, wsp<bf16_t>(P, OFF_WF), 1024, NTOK, 2048, 1024,
                        EpiTopk{wsp<unsigned short>(P, OFF_EIDX), wsp<bf16_t>(P, OFF_EGT)}, smem); } break;
    case 21: if (PH_EN(21)) { phase_peer_u(P, 1, rep, smem); } break;
    case 22: if (PH_EN(22)) { phase_peer_act(P, smem); } break;
    case 23: if (PH_EN(23)) { phase_peer_v(P, 1, PROBE_SCALE(23), rep, smem); } break;
    case 24: if (PH_EN(24)) { phase_final(P); } break;
    default: break;
  }
}
#ifndef EMU
#define PHASE_SYNC(PH) do { if ((PH) == 1) GRID_SYNC(); else xcd_barrier(xb); } while (0)
#else
#define PHASE_SYNC(PH) GRID_SYNC()
#endif
template <int PH> DEV void run_phase_t(const Params& P, int ph_lo, int ph_hi, unsigned char* smem, const XcdBarrier& xb) {
  if (PH >= ph_lo && PH < ph_hi) {
    if (PH > ph_lo) { PHASE_SYNC(PH); if (PROBE_SYNC2) PHASE_SYNC(PH); }
    run_phase(P, PH, smem);
    if (PROBE_ON(PH)) { PHASE_SYNC(PH); run_phase(P, PH, smem, 1); }
  }
}
template <int... I> struct IntSeq {};
template <int N, int... I> struct MakeSeq : MakeSeq<N - 1, N - 1, I...> {};
template <int... I> struct MakeSeq<0, I...> { typedef IntSeq<I...> type; };
template <int... I> DEV void run_all(const Params& P, int lo, int hi, unsigned char* smem, const XcdBarrier& xb, IntSeq<I...>) {
  int dummy[] = {(run_phase_t<I>(P, lo, hi, smem, xb), 0)...};
  (void)dummy;
}
__global__ void __launch_bounds__(NT, 1) mega_kernel(Params P, int ph_lo, int ph_hi) {
  SMEM_DECL(smem);
#ifndef EMU
  volatile unsigned* st = reinterpret_cast<volatile unsigned*>(smem + SMEM_BYTES - 16);
  if (threadIdx.x == 0) { st[0] = 0u; st[1] = 0u; st[2] = 0u; st[3] = 0u; }
  __syncthreads();
  XcdBarrier xb = xcd_barrier_post(reinterpret_cast<unsigned*>(P.ws + OFF_BAR), st);
#else
  XcdBarrier xb{0};
#endif
  run_all(P, ph_lo, ph_hi, smem, xb, typename MakeSeq<NPHASE>::type());
}

#ifndef EMU
extern "C" void kernel_launch(void* const* d_in, const int* in_sizes, int n_in, void* d_out, int out_size, void* d_ws,
                              size_t ws_size, hipStream_t stream) {
  Params P{};
  for (int i = 0; i < 45; ++i) P.in[i] = (const float*)d_in[i];
  P.out = (float*)d_out; P.ws = (unsigned char*)d_ws;
  static int grid_blocks = 0;
  if (!grid_blocks) {
    int dev = 0, cus = 0, per_cu = 0;
    hipGetDevice(&dev);
    hipDeviceGetAttribute(&cus, hipDeviceAttributeMultiprocessorCount, dev);
    hipFuncSetAttribute((const void*)mega_kernel, hipFuncAttributeMaxDynamicSharedMemorySize, (int)SMEM_BYTES);
    hipOccupancyMaxActiveBlocksPerMultiprocessor(&per_cu, mega_kernel, NT, SMEM_BYTES);
    if (per_cu > 1) per_cu = 1;
    grid_blocks = cus * per_cu;
    if (grid_blocks <= 0) grid_blocks = 256;
  }
  hipMemsetAsync(P.ws + OFF_BAR, 0, SZ_BAR, stream);
  int lo = 0, hi = NPHASE;
  void* args[] = {&P, &lo, &hi};
  hipError_t e = hipLaunchCooperativeKernel((const void*)mega_kernel, dim3(grid_blocks), dim3(NT), args, (unsigned)SMEM_BYTES, stream);
  if (e != hipSuccess) fprintf(stderr, "cooperative launch failed: %s (grid %d)\n", hipGetErrorString(e), grid_blocks);
}
#endif
```

```cpp
#ifndef EMU
#include <hip/hip_runtime.h>
#include <hip/hip_cooperative_groups.h>
#include <cstdio>
#include <cstdint>
typedef __attribute__((ext_vector_type(8))) short bf16x8;
typedef __attribute__((ext_vector_type(4))) float f32x4;
#define DEV __device__ __forceinline__
#define DEVM __device__ __forceinline__
DEV f32x4 mfma16(bf16x8 a, bf16x8 b, f32x4 c) { return __builtin_amdgcn_mfma_f32_16x16x32_bf16(a, b, c, 0, 0, 0); }
typedef __attribute__((ext_vector_type(4))) short bf16x4;
DEV f32x4 mfma16k16(bf16x4 a, bf16x4 b, f32x4 c) { return __builtin_amdgcn_mfma_f32_16x16x16bf16_1k(a, b, c, 0, 0, 0); }
DEV float u2f(unsigned u) { return __uint_as_float(u); }
DEV unsigned f2u(float f) { return __float_as_uint(f); }
#define SYNC() __syncthreads()
#define GRID_SYNC() cooperative_groups::this_grid().sync()
#define SMEM_DECL(name) extern __shared__ __attribute__((aligned(16))) unsigned char name[]
DEV void glds16(const void* g, void* l) {
  __builtin_amdgcn_global_load_lds((const __attribute__((address_space(1))) unsigned*)g, (__attribute__((address_space(3))) unsigned*)l, 16, 0, 0);
}
DEV void glds_wait() { asm volatile("s_waitcnt vmcnt(0)" ::: "memory"); }
DEV void asm_wait_vm6() { asm volatile("s_waitcnt vmcnt(6)" ::: "memory"); }
DEV int tid_opaque() { int t = threadIdx.x; asm volatile("" : "+v"(t) :: "memory"); return t; }
template <int CTRL> DEV float dpp_mov(float v) { return __int_as_float(__builtin_amdgcn_mov_dpp(__float_as_int(v), CTRL, 0xF, 0xF, true)); }
#else
#define DEV static inline
#define DEVM inline
DEV f32x4 mfma16(bf16x8 a, bf16x8 b, f32x4 c) { return emu_mfma_16x16x32_bf16(a, b, c); }
typedef __attribute__((ext_vector_type(4))) short bf16x4;
DEV f32x4 mfma16k16(bf16x4 a, bf16x4 b, f32x4 c) {
  bf16x8 a8 = {0, 0, 0, 0, 0, 0, 0, 0}, b8 = {0, 0, 0, 0, 0, 0, 0, 0};
  const int q = tl_cur->lane >> 4;
  EmuFiber* f = tl_cur; EmuWave& w = f->blk->waves[f->wave]; int par = w.gen & 1; int l = f->lane;
  for (int j = 0; j < 4; ++j) { w.mbuf[par][l].a[j] = a[j]; w.mbuf[par][l].b[j] = b[j]; }
  emu_wave_barrier();
  int col = l & 15; f32x4 d = c; (void)a8; (void)b8; (void)q;
  for (int r = 0; r < 4; ++r) { int row = 4 * (l >> 4) + r; float acc = c[r];
    for (int k = 0; k < 16; ++k) acc += emu_bf2f(w.mbuf[par][row + 16 * (k >> 2)].a[k & 3]) * emu_bf2f(w.mbuf[par][col + 16 * (k >> 2)].b[k & 3]);
    d[r] = acc; }
  return d;
}
DEV float u2f(unsigned u) { float f; memcpy(&f, &u, 4); return f; }
DEV unsigned f2u(float f) { unsigned u; memcpy(&u, &f, 4); return u; }
#define SYNC() __syncthreads()
#define GRID_SYNC() emu_grid_sync()
#define SMEM_DECL(name) unsigned char* name = EMU_SMEM_PTR()
DEV void glds16(const void* g, void* l) { memcpy(l, g, 16); }
DEV void glds_wait() {}
DEV void asm_wait_vm6() {}
DEV int tid_opaque() { return threadIdx.x; }
template <int CTRL> DEV float dpp_mov(float v) { const int l = tl_cur->lane; const int src = CTRL == 0xB1 ? (l ^ 1) : CTRL == 0x4E ? (l ^ 2) : ((l & ~7) | (7 - (l & 7))); return emu_shfl(v, src); }
#endif

#ifndef CFG_BATCH
#define CFG_BATCH 32
#endif
#ifndef CFG_SEQ
#define CFG_SEQ 256
#endif
#ifndef CFG_DEC_BATCH
#define CFG_DEC_BATCH 4
#endif
#ifndef CFG_DEC_SEQ
#define CFG_DEC_SEQ 4096
#endif
constexpr int D = 1024;
constexpr int NB_C = CFG_BATCH, L_C = CFG_SEQ, NB_L = CFG_DEC_BATCH, L_L = CFG_DEC_SEQ;
constexpr int NTOK_C = NB_C * L_C, NTOK_L = NB_L * L_L, NTOK = NTOK_C + NTOK_L;
constexpr int NSEQ = NB_C + NB_L;
constexpr int NCOND = 1 + NB_L;
constexpr int NT = 512;
constexpr int NW = NT / 64;
constexpr float EPS = 1e-6f;
constexpr int clog2(int n) { return n <= 1 ? 0 : 1 + clog2(n / 2); }
constexpr int LOG_NC = clog2(2 * L_C), LOG_NL = clog2(2 * L_L);
static_assert((1 << LOG_NC) == 2 * L_C && (1 << LOG_NL) == 2 * L_L, "pow2 seq");
static_assert(L_C % 256 == 0 && L_L % 256 == 0, "seq multiple of 256");
static_assert(NB_C % 2 == 0 && NB_L % 2 == 0, "even batches");
constexpr int ODIN_N = 4128, ODIN_NPAD = 4352;

typedef unsigned short bf16_t;
DEV float bf2f(bf16_t h) { return u2f(((unsigned)h) << 16); }
DEV bf16_t f2bf(float f) { unsigned u = f2u(f); u += 0x7fffu + ((u >> 16) & 1u); return (bf16_t)(u >> 16); }
DEV unsigned pack2(float a, float b) { return (unsigned)f2bf(a) | ((unsigned)f2bf(b) << 16); }
DEV float bflo(unsigned u) { return u2f(u << 16); }
DEV float bfhi(unsigned u) { return u2f(u & 0xffff0000u); }
DEV float silu_f(float x) { return x / (1.f + __expf(-x)); }
DEV float sigmoid_f(float x) { return 1.f / (1.f + __expf(-x)); }
DEV float gelu_f(float x) { float u = 0.7978845608028654f * (x + 0.044715f * x * x * x); float e = __expf(-2.f * fabsf(u)); float t = (1.f - e) / (1.f + e); t = u < 0.f ? -t : t; return 0.5f * x * (1.f + t); }
DEV float log_sigmoid_f(float x) { return fminf(x, 0.f) - log1pf(__expf(-fabsf(x))); }
DEV float sum8_dpp(float v) { v += dpp_mov<0xB1>(v); v += dpp_mov<0x4E>(v); v += dpp_mov<0x141>(v); return v; }
DEV float wave_sum(float v) { for (int m = 32; m >= 1; m >>= 1) v += __shfl_xor(v, m); return v; }
DEV float wave_max(float v) { for (int m = 32; m >= 1; m >>= 1) v = fmaxf(v, __shfl_xor(v, m)); return v; }

typedef __attribute__((ext_vector_type(2))) float f32x2_t;
#ifndef EMU
DEV f32x2_t fp8lo2(unsigned w) { return __builtin_amdgcn_cvt_pk_f32_fp8((int)w, false); }
DEV f32x2_t fp8hi2(unsigned w) { return __builtin_amdgcn_cvt_pk_f32_fp8((int)w, true); }
DEV int uniform_i(int v) { return __builtin_amdgcn_readfirstlane(v); }
DEV unsigned pack_fp8x4(float a, float b, float c, float d) {
  int r = __builtin_amdgcn_cvt_pk_fp8_f32(a, b, 0, false);
  r = __builtin_amdgcn_cvt_pk_fp8_f32(c, d, r, true);
  return (unsigned)r;
}
DEV void unpack_fp8x4(unsigned w, float* o) {
  f32x2_t lo = __builtin_amdgcn_cvt_pk_f32_fp8((int)w, false), hi = __builtin_amdgcn_cvt_pk_f32_fp8((int)w, true);
  o[0] = lo[0]; o[1] = lo[1]; o[2] = hi[0]; o[3] = hi[1];
}
DEV void wave_sync() { __builtin_amdgcn_wave_barrier(); }
DEV void wave_lds_fence() { __syncthreads(); }
#else
DEV unsigned emu_enc_fp8(float x) {
  unsigned sgn = x < 0.f ? 0x80u : 0u; float ax = fabsf(x);
  if (!(ax == ax)) return 0x7fu;
  if (ax >= 448.f) return sgn | 0x7eu;
  if (ax < 0.015625f) { int q = (int)nearbyintf(ax * 512.f); return sgn | (unsigned)(q >= 8 ? 0x08 : q); }
  int e; float fr = frexpf(ax, &e);
  e -= 1; float m = fr * 2.f - 1.f;
  int qm = (int)nearbyintf(m * 8.f);
  if (qm == 8) { qm = 0; e += 1; }
  unsigned b = (unsigned)((e + 7) << 3) | (unsigned)qm;
  if (b > 0x7eu) b = 0x7eu;
  return sgn | b;
}
DEV float emu_dec_fp8(unsigned b) {
  unsigned e = (b >> 3) & 15u, m = b & 7u; float v = e == 0 ? (float)m * 0.001953125f : ldexpf(1.f + (float)m * 0.125f, (int)e - 7);
  return (b & 0x80u) ? -v : v;
}
DEV unsigned pack_fp8x4(float a, float b, float c, float d) { return emu_enc_fp8(a) | (emu_enc_fp8(b) << 8) | (emu_enc_fp8(c) << 16) | (emu_enc_fp8(d) << 24); }
DEV void unpack_fp8x4(unsigned w, float* o) { for (int i = 0; i < 4; ++i) o[i] = emu_dec_fp8((w >> (8 * i)) & 255u); }
DEV f32x2_t fp8lo2(unsigned w) { f32x2_t r; r[0] = emu_dec_fp8(w & 255u); r[1] = emu_dec_fp8((w >> 8) & 255u); return r; }
DEV f32x2_t fp8hi2(unsigned w) { f32x2_t r; r[0] = emu_dec_fp8((w >> 16) & 255u); r[1] = emu_dec_fp8((w >> 24) & 255u); return r; }
DEV int uniform_i(int v) { return v; }
DEV void wave_sync() { emu_wave_barrier(); }
DEV void wave_lds_fence() { __syncthreads(); }
#endif
struct U4 { unsigned x, y, z, w; };
struct U2 { unsigned x, y; };
struct F4 { float x, y, z, w; };
struct F2 { float x, y; };
DEV U4 ld16(const void* p) { return *reinterpret_cast<const U4*>(p); }
DEV void st16(void* p, U4 v) { *reinterpret_cast<U4*>(p) = v; }
DEV U2 ld8(const void* p) { return *reinterpret_cast<const U2*>(p); }
DEV void st8(void* p, U2 v) { *reinterpret_cast<U2*>(p) = v; }
DEV F4 ldf4(const float* p) { return *reinterpret_cast<const F4*>(p); }
DEV void stf4(float* p, F4 v) { *reinterpret_cast<F4*>(p) = v; }
#ifndef EMU
DEV F4 ldf4_nt(const float* p) { const f32x4 t = __builtin_nontemporal_load(reinterpret_cast<const f32x4*>(p)); return F4{t[0], t[1], t[2], t[3]}; }
DEV void stf4_nt(float* p, F4 v) { const f32x4 t = {v.x, v.y, v.z, v.w}; __builtin_nontemporal_store(t, reinterpret_cast<f32x4*>(p)); }
#else
DEV F4 ldf4_nt(const float* p) { return ldf4(p); }
DEV void stf4_nt(float* p, F4 v) { stf4(p, v); }
#endif
DEV bf16x8 as_frag(U4 v) { bf16x8 r; memcpy(&r, &v, 16); return r; }
DEV bf16x8 as_frag2(U2 a, U2 b) { U4 v{a.x, a.y, b.x, b.y}; return as_frag(v); }
#ifndef EMU
typedef short v4s_t __attribute__((ext_vector_type(4)));
DEV U2 lds_tr_read(const bf16_t* p) {
  const v4s_t r = __builtin_amdgcn_ds_read_tr16_b64_v4i16((__attribute__((address_space(3))) v4s_t*)p);
  U2 o; memcpy(&o, &r, 8); return o;
}
#else
DEV U2 lds_tr_read(const bf16_t* p) {
  const unsigned long long a = (unsigned long long)(uintptr_t)p;
  const int lane = threadIdx.x & 63, i = lane & 15, gb = lane & 48;
  unsigned short e[4];
  for (int q = 0; q < 4; ++q) {
    const int src = gb + 4 * q + (i >> 2);
    const unsigned lo = (unsigned)__shfl((int)(unsigned)(a & 0xffffffffull), src), hi = (unsigned)__shfl((int)(unsigned)(a >> 32), src);
    const bf16_t* rp = (const bf16_t*)(uintptr_t)(((unsigned long long)hi << 32) | lo);
    e[q] = rp[i & 3];
  }
  return U2{(unsigned)e[0] | ((unsigned)e[1] << 16), (unsigned)e[2] | ((unsigned)e[3] << 16)};
}
#endif

DEV int row_seq(int r) { return r < NTOK_C ? r / L_C : NB_C + (r - NTOK_C) / L_L; }
DEV int row_pos(int r) { return r < NTOK_C ? r % L_C : (r - NTOK_C) % L_L; }
DEV int row_cond(int r) { return r < NTOK_C ? 0 : 1 + (r - NTOK_C) / L_L; }
DEV int seq_start(int s) { return s < NB_C ? s * L_C : NTOK_C + (s - NB_C) * L_L; }
DEV int seq_len(int s) { return s < NB_C ? L_C : L_L; }


#ifndef EMU
#define XB_TMO      128
#define XB_XCNT(j)  (256  + 64 * (j))
#define XB_XSUB(j)  (1280 + 64 * (j))
#define XB_XGEN(j)  (2304 + 64 * (j))
#define XB_TOP      3328
#define XB_TOPGEN   3392
#define XCD_BAR_WORDS 3456
#define XB_SPIN_CAP (1u << 22)
#define LAS __attribute__((address_space(3)))
DEV unsigned xb_ld(unsigned* p) { return __hip_atomic_load(p, __ATOMIC_RELAXED, __HIP_MEMORY_SCOPE_AGENT); }
DEV unsigned xb_add(unsigned* p, unsigned v) { return __hip_atomic_fetch_add(p, v, __ATOMIC_RELAXED, __HIP_MEMORY_SCOPE_AGENT); }
DEV unsigned xb_xcc_id() { return (unsigned)__builtin_amdgcn_s_getreg((3 << 11) | 20) & 0xFu; }
#define XB_SPIN(cond, bar) do { unsigned _sp = 0; while (cond) { __builtin_amdgcn_s_sleep(1); \
    if ((++_sp & 255u) == 0u) { if (xb_ld(&(bar)[XB_TMO])) break; if (_sp > XB_SPIN_CAP) { atomicAdd(&(bar)[XB_TMO], 1u); break; } } } } while (0)
struct XcdBarrier { unsigned* bar; unsigned x; volatile unsigned* st; };
DEV XcdBarrier xcd_barrier_post(unsigned* bar, volatile unsigned* st) {
  XcdBarrier b; b.bar = bar; b.x = xb_xcc_id(); b.st = st;
  if (threadIdx.x == 0) (void)xb_add(&bar[XB_XCNT(b.x)], 1u);
  return b;
}
DEV void xcd_barrier_complete(unsigned* bar, unsigned x, unsigned& nloc, unsigned& nx) {
  const unsigned G = gridDim.x * gridDim.y * gridDim.z;
  unsigned sum, cnt, mine, sp = 0u;
  for (;;) {
    sum = 0u; cnt = 0u; mine = 0u;
#pragma unroll
    for (unsigned j = 0; j < 16; ++j) { const unsigned c = xb_ld(&bar[XB_XCNT(j)]); sum += c; cnt += (c > 0u) ? 1u : 0u; mine = (j == x) ? c : mine; }
    if (sum == G) break;
    __builtin_amdgcn_s_sleep(1);
    if ((++sp & 255u) == 0u) { if (xb_ld(&bar[XB_TMO])) break; if (sp > XB_SPIN_CAP) { atomicAdd(&bar[XB_TMO], 1u); break; } }
  }
  nloc = mine > 0u ? mine : 1u; nx = cnt > 0u ? cnt : 1u;
}
DEV void xcd_barrier(const XcdBarrier& b) {
  asm volatile("s_waitcnt vmcnt(0)" ::: "memory");
  __syncthreads();
  if (threadIdx.x == 0) {
    unsigned* bar = b.bar;
    __builtin_amdgcn_s_waitcnt(0);
    unsigned nloc = b.st[0], nx = b.st[1];
    if (nloc == 0u) { xcd_barrier_complete(bar, b.x, nloc, nx); b.st[0] = nloc; b.st[1] = nx; }
    const unsigned old = xb_add(&bar[XB_XSUB(b.x)], 1u);
    const unsigned gen = old / nloc;
    if (old + 1u == (gen + 1u) * nloc) {
      __builtin_amdgcn_fence(__ATOMIC_RELEASE, "agent");
      asm volatile("s_waitcnt vmcnt(0)" ::: "memory");
      const unsigned og = xb_add(&bar[XB_TOP], 1u);
      const unsigned tg = og / nx;
      if (og + 1u == (tg + 1u) * nx) xb_add(&bar[XB_TOPGEN], 1u);
      else XB_SPIN(xb_ld(&bar[XB_TOPGEN]) == tg, bar);
      __builtin_amdgcn_fence(__ATOMIC_ACQUIRE, "agent");
      xb_add(&bar[XB_XGEN(b.x)], 1u);
      asm volatile("s_waitcnt vmcnt(0)" ::: "memory");
    } else {
      XB_SPIN(xb_ld(&bar[XB_XGEN(b.x)]) == gen, bar);
      __builtin_amdgcn_fence(__ATOMIC_ACQUIRE, "agent");
      asm volatile("s_waitcnt vmcnt(0)" ::: "memory");
    }
  }
  __syncthreads();
}
#else
#define XCD_BAR_WORDS 3456
struct XcdBarrier { int dummy; };
#endif

constexpr size_t al256(size_t x) { return (x + 255) & ~(size_t)255; }
constexpr size_t OFF_BAR = 0;
constexpr size_t SZ_BAR = 16384;
constexpr size_t OFF_QCNT = OFF_BAR + 14336;
constexpr size_t OFF_MOD = OFF_BAR + SZ_BAR;
constexpr size_t SZ_MOD = al256((size_t)2 * NCOND * 6144 * 4);
constexpr size_t OFF_WEVIN = OFF_MOD + SZ_MOD;
constexpr size_t OFF_WGLU = OFF_WEVIN + (size_t)2048 * 1024 * 2;
constexpr size_t OFF_WEVOUT = OFF_WGLU + (size_t)512 * 512 * 2;
constexpr size_t OFF_WODIN = OFF_WEVOUT + (size_t)1024 * 1024 * 2;
constexpr size_t OFF_WODOUT = OFF_WODIN + (size_t)ODIN_NPAD * 1024 * 2;
constexpr size_t OFF_WPKQ = OFF_WODOUT + (size_t)1024 * 1024 * 2;
constexpr size_t OFF_KEYS = OFF_WPKQ + (size_t)2 * 2048 * 1024 * 2;
constexpr size_t OFF_H2 = OFF_KEYS + (size_t)2 * 16 * 128 * 128 * 2;
constexpr size_t OFF_LAMB = OFF_H2 + al256((size_t)(L_C + L_L) * 64 * 4);
constexpr size_t OFF_LAMT = OFF_LAMB + (size_t)2 * 32 * 64 * 8;
constexpr size_t OFF_BBAR = OFF_LAMT + (size_t)2 * 32 * 64 * 8;
constexpr size_t OFF_CMT = OFF_BBAR + (size_t)2 * 32 * 64 * 16 * 8;
constexpr size_t OFF_BB16 = OFF_CMT + (size_t)2 * 32 * 16 * 128 * 2;
constexpr size_t OFF_X = OFF_BB16 + (size_t)2 * 32 * 128 * 16 * 2;
constexpr size_t OFF_TAB = OFF_X + (size_t)NTOK * 1024 * 4;
constexpr size_t SZ_TAB = (size_t)2 * 16384 * 1024 * 2;
constexpr size_t OFF_RA = OFF_TAB + SZ_TAB;
constexpr size_t SZ_RA = (size_t)NTOK * 1024 * 2;
constexpr size_t OFF_RB = OFF_RA + SZ_RA;
constexpr size_t SZ_RB = (size_t)NTOK * 4096 * 2 + (size_t)NTOK * 32 * 4;
constexpr size_t OFF_RC = OFF_RB + al256(SZ_RB);
constexpr int KF_N = 2 * L_C + 2 * L_L;
constexpr size_t SZ_KF = (size_t)512 * 2 * KF_N * 8;
constexpr size_t SZ_RC = SZ_KF > (size_t)NTOK * 1024 * 2 ? SZ_KF : (size_t)NTOK * 1024 * 2;
constexpr size_t OFF_S5C = OFF_RC + al256(SZ_RC);
constexpr size_t SZ_S5C = (size_t)(NTOK / 64) * 32 * 2 * 64 * 8;
constexpr size_t WS_TOTAL = OFF_S5C + SZ_S5C;
constexpr size_t OFF_PROJ0 = OFF_RB;
constexpr size_t OFF_HT3 = OFF_RB + (size_t)NTOK * 2048 * 2;
constexpr size_t OFF_HYT = OFF_HT3 + (size_t)3 * 512 * NTOK * 2;
constexpr size_t OFF_Q = OFF_RB;
constexpr size_t OFF_WF = OFF_RB;
constexpr size_t OFF_SV = OFF_RB + (size_t)NTOK * 2048 * 2;
constexpr size_t OFF_SI = OFF_SV + (size_t)NTOK * 256 * 4;
constexpr size_t OFF_PART = OFF_RB;
constexpr size_t OFF_EIDX = OFF_SI + (size_t)NTOK * 256;
constexpr size_t OFF_EGT = OFF_EIDX + (size_t)NTOK * 128 * 4;
static_assert(OFF_EGT + (size_t)NTOK * 128 * 4 <= OFF_RB + SZ_RB, "peer buffers fit region B");
static_assert((size_t)8 * NTOK * 128 * 4 <= (size_t)NTOK * 2048 * 2, "PART fits the Q buffer");
constexpr size_t OFF_PROJ1 = OFF_RB;
constexpr size_t OFF_GATES = OFF_RB + (size_t)NTOK * 4096 * 2;
constexpr size_t OFF_KF = OFF_RC;
constexpr size_t OFF_QC = OFF_RA;
constexpr size_t OFF_KC = OFF_RC;
static_assert((size_t)NTOK * 1024 * 2 <= SZ_RC, "Kc fits region C");
constexpr size_t OFF_GS = OFF_S5C;
static_assert((size_t)(NTOK / 128) * 8 * 2 * 3 * 128 * 4 <= SZ_S5C, "GS fits");
constexpr int HLD = 4096;
constexpr size_t OFF_YS5 = OFF_TAB;

struct Params {
  const float* in[45];
  float* out;
  unsigned char* ws;
};
enum { I_XP = 0, I_XS, I_S5RE, I_S5IM, I_MLC, I_MLN, I_MLM, I_C, I_CCTX, I_NORMG, I_ADAW, I_ADAB, I_FINALG, I_EVWIN,
       I_HYCW, I_HYCB, I_HYW1, I_HYB1, I_HYW2, I_HYB2, I_HYW3, I_HYFREQ, I_HYDECAY, I_HYBIAS, I_S5ARE, I_S5AIM, I_S5BRE,
       I_S5BIM, I_S5CRE, I_S5CIM, I_S5LOGSTEP, I_S5D, I_S5GLUW, I_S5GLUB, I_EVWOUT, I_ODWIN, I_ODGATEB, I_MLCW, I_MLCB,
       I_MLNORMG, I_ODWOUT, I_PKWQ, I_PKKEYS, I_PKU, I_PKV };
constexpr size_t OUT_Y = 0;
constexpr size_t OUT_S5RE = (size_t)NTOK * 1024;
constexpr size_t OUT_S5IM = OUT_S5RE + (size_t)NB_C * 2 * 32 * 64;
constexpr size_t OUT_MLC = OUT_S5IM + (size_t)NB_C * 2 * 32 * 64;
constexpr size_t OUT_MLN = OUT_MLC + (size_t)NB_C * 2 * 8 * 128 * 128;
constexpr size_t OUT_MLM = OUT_MLN + (size_t)NB_C * 2 * 8 * 128;
constexpr size_t OUT_TOTAL = OUT_MLM + (size_t)NB_C * 2 * 8;

template <typename T> DEV T* wsp(const Params& P, size_t off) { return reinterpret_cast<T*>(P.ws + off); }

DEV void job_transpose(const float* src, bf16_t* dst, int K, int N, int Npad, int tile, unsigned char* smem) {
  float* t = reinterpret_cast<float*>(smem);
  const int ntn = Npad / 64;
  const int k0 = (tile / ntn) * 64, n0 = (tile % ntn) * 64;
  const int tid = threadIdx.x;
#pragma unroll
  for (int i = 0; i < 2; ++i) {
    const int e = tid + i * NT, kk = e >> 4, n4 = (e & 15) * 4;
    F4 v = (n0 + n4 < N) ? ldf4(src + (size_t)(k0 + kk) * N + n0 + n4) : F4{0.f, 0.f, 0.f, 0.f};
    float* tp = t + kk * 65 + n4; tp[0] = v.x; tp[1] = v.y; tp[2] = v.z; tp[3] = v.w;
  }
  SYNC();
  {
    const int nn = tid >> 3, k8 = (tid & 7) * 8;
    const float* tp = t + k8 * 65 + nn;
    st16(dst + (size_t)(n0 + nn) * K + k0 + k8, U4{pack2(tp[0], tp[65]), pack2(tp[130], tp[195]), pack2(tp[260], tp[325]), pack2(tp[390], tp[455])});
  }
  SYNC();
}
DEV void job_convert(const float* src, bf16_t* dst, int tile) {
  size_t e = (size_t)tile * 4096 + (size_t)threadIdx.x * 8;
  F4 a = ldf4(src + e), b = ldf4(src + e + 4);
  st16(dst + e, U4{pack2(a.x, a.y), pack2(a.z, a.w), pack2(b.x, b.y), pack2(b.z, b.w)});
}
DEV void job_mod(const Params& P, int task, unsigned char* smem) {
  float* sc = reinterpret_cast<float*>(smem);
  float* part = sc + NCOND * 1024;
  const int l = task / 96, ct = task % 96;
  const int tid = threadIdx.x, lane = tid & 63, w = tid >> 6;
  for (int e = tid; e < NCOND * 1024; e += NT) {
    int cb = e >> 10, k = e & 1023;
    float c = cb == 0 ? P.in[I_CCTX][k] : P.in[I_C][(size_t)(cb - 1) * 1024 + k];
    sc[e] = silu_f(c);
  }
  SYNC();
  const int n = ct * 64 + lane;
  const float* wp = P.in[I_ADAW] + (size_t)l * 1024 * 6144 + (size_t)(w * 128) * 6144 + n;
  float acc[NCOND];
#pragma unroll
  for (int cb = 0; cb < NCOND; ++cb) acc[cb] = 0.f;
#pragma unroll 8
  for (int k = 0; k < 128; ++k) {
    float wv = wp[(size_t)k * 6144];
#pragma unroll
    for (int cb = 0; cb < NCOND; ++cb) acc[cb] += sc[cb * 1024 + w * 128 + k] * wv;
  }
#pragma unroll
  for (int cb = 0; cb < NCOND; ++cb) part[(w * NCOND + cb) * 64 + lane] = acc[cb];
  SYNC();
  if (tid < NCOND * 64) {
    const int cb = tid >> 6, ln = tid & 63;
    float s = P.in[I_ADAB][(size_t)l * 6144 + ct * 64 + ln];
#pragma unroll
    for (int ww = 0; ww < NW; ++ww) s += part[(ww * NCOND + cb) * 64 + ln];
    wsp<float>(P, OFF_MOD)[((size_t)l * NCOND + cb) * 6144 + ct * 64 + ln] = s;
  }
  SYNC();
}
DEV void job_xinit(const Params& P, int tile) {
  const int lane = threadIdx.x & 63, w = threadIdx.x >> 6;
  const int r = tile * 8 + w;
  float* X = wsp<float>(P, OFF_X) + (size_t)r * 1024;
  if (r < NTOK_C) {
    const float* src = P.in[I_XP] + (size_t)r * 1024;
    for (int i = 0; i < 4; ++i) stf4(X + i * 256 + lane * 4, ldf4(src + i * 256 + lane * 4));
  } else {
    const int rl = r - NTOK_C;
    const float* src = P.in[I_XS] + (size_t)rl * 1024;
    const int pos = rl % L_L;
    const float prow = (float)(pos / 64), pcol = (float)(pos % 64);
    for (int i = 0; i < 4; ++i) {
      int c0 = i * 256 + lane * 4;
      F4 v = ldf4(src + c0);
      float o[4] = {v.x, v.y, v.z, v.w};
#pragma unroll
      for (int j = 0; j < 4; ++j) {
        int c = c0 + j;
        int half = c >> 9, cc = c & 511;
        int isc = cc >> 8, fi = cc & 255;
        float omega = exp2f(-(float)fi * (13.287712379549449f / 256.f));
        float ang = (half ? pcol : prow) * omega;
        o[j] += isc ? cosf(ang) : sinf(ang);
      }
      stf4(X + c0, F4{o[0], o[1], o[2], o[3]});
    }
  }
}
DEV void job_h2(const Params& P, int tile) {
  const int lane = threadIdx.x & 63, w = threadIdx.x >> 6;
  const int gi = tile * 8 + w;
  const int L = gi < L_C ? L_C : L_L;
  const int i = gi < L_C ? gi : gi - L_C;
  const float t = (float)i / (float)L;
  float z = 0.f;
  if (lane == 0) z = t;
  else if (lane <= 32) {
    int b = (lane - 1) & 15;
    float band = 1e-4f + (float)b * ((15.f - 1e-4f) / 15.f);
    float ang = 6.283185307179586f * t * band;
    z = lane <= 16 ? cosf(ang) : sinf(ang);
  }
  const float* w1 = P.in[I_HYW1]; const float* w2 = P.in[I_HYW2];
  const float fr = P.in[I_HYFREQ][lane];
  float a = P.in[I_HYB1][lane];
  for (int j = 0; j < 33; ++j) a += __shfl(z, j) * w1[j * 64 + lane];
  float h1 = sinf(fr * a);
  float a2 = P.in[I_HYB2][lane];
  for (int j = 0; j < 64; ++j) a2 += __shfl(h1, j) * w2[j * 64 + lane];
  float h2 = sinf(fr * a2);
  wsp<float>(P, OFF_H2)[(gi < L_C ? (size_t)0 : (size_t)64 * L_C) + (size_t)lane * L + i] = h2;
}
DEV void job_s5p(const Params& P, int task) {
  const int dir = task >> 5, g = task & 31;
  const int p = threadIdx.x & 63, jg = threadIdx.x >> 6;
  const size_t ip = ((size_t)dir * 32 + g) * 64 + p;
  const float are = P.in[I_S5ARE][ip], aim = P.in[I_S5AIM][ip];
  const float dt = expf(P.in[I_S5LOGSTEP][dir * 32 + g]);
  const float mag = expf(are * dt);
  const float sn = sinf(aim * dt), cs = cosf(aim * dt);
  const float lre = mag * cs, lim = mag * sn;
  const float nre = lre - 1.f, nim = lim;
  const float den = are * are + aim * aim;
  const float fre = (nre * are + nim * aim) / den, fim = (nim * are - nre * aim) / den;
  if (jg == 0) {
    wsp<F2>(P, OFF_LAMB)[ip] = F2{lre, lim};
    float xr = lre, xi = lim;
    for (int s = 0; s < 6; ++s) { float nr = xr * xr - xi * xi, ni = 2.f * xr * xi; xr = nr; xi = ni; }
    wsp<F2>(P, OFF_LAMT)[ip] = F2{xr, xi};
  }
  for (int jj = 0; jj < 2; ++jj) {
    int j = jg * 2 + jj;
    float bre = P.in[I_S5BRE][ip * 16 + j], bim = P.in[I_S5BIM][ip * 16 + j];
    wsp<F2>(P, OFF_BBAR)[ip * 16 + j] = F2{fre * bre - fim * bim, fre * bim + fim * bre};
    { bf16_t* bb = wsp<bf16_t>(P, OFF_BB16) + (((size_t)dir * 32 + g) * 128 + 2 * p) * 16 + j; bb[0] = f2bf(fre * bre - fim * bim); bb[16] = f2bf(fre * bim + fim * bre); }
    size_t ic = (((size_t)dir * 32 + g) * 16 + j) * 64 + p;
    unsigned v = pack2(P.in[I_S5CRE][ic], -P.in[I_S5CIM][ic]);
    *reinterpret_cast<unsigned*>(wsp<bf16_t>(P, OFF_CMT) + (((size_t)dir * 32 + g) * 16 + j) * 128 + 2 * p) = v;
  }
}

constexpr int J0_EVIN = 0;
constexpr int J0_GLU = J0_EVIN + 16 * 32;
constexpr int J0_EVOUT = J0_GLU + 8 * 8;
constexpr int J0_ODIN = J0_EVOUT + 16 * 16;
constexpr int J0_ODOUT = J0_ODIN + 16 * (ODIN_NPAD / 64);
constexpr int J0_PKQ0 = J0_ODOUT + 16 * 16;
constexpr int J0_PKQ1 = J0_PKQ0 + 16 * 32;
constexpr int J0_KEYS = J0_PKQ1 + 16 * 32;
constexpr int J0_MOD = J0_KEYS + 128;
constexpr int J0_XINIT = J0_MOD + 2 * 96;
constexpr int J0_H2 = J0_XINIT + NTOK / 8;
constexpr int J0_S5P = J0_H2 + (L_C + L_L) / 8;
constexpr int J0_END = J0_S5P + 64;
constexpr int TAB_TILES = 2 * 16384 / 8;
constexpr size_t OFF_TAB8 = OFF_TAB;
constexpr size_t OFF_RSC = OFF_TAB + (size_t)2 * 16384 * 1024;
DEV void job_tab(const Params& P, int layer, int t) {
  const int lane = threadIdx.x & 63, w = threadIdx.x >> 6;
  const int row = t * 8 + w;
  const int which = row >> 14, r = row & 16383;
  const float* src = P.in[which ? I_PKV : I_PKU] + ((size_t)layer * 16384 + r) * 1024 + lane * 4;
  F4 v[4]; float am = 0.f;
#pragma unroll
  for (int i = 0; i < 4; ++i) { v[i] = ldf4_nt(src + i * 256); am = fmaxf(am, fmaxf(fmaxf(fabsf(v[i].x), fabsf(v[i].y)), fmaxf(fabsf(v[i].z), fabsf(v[i].w)))); }
  am = wave_max(am);
  const float sc = am > 0.f ? 240.f / am : 1.f;
  unsigned char* dst = wsp<unsigned char>(P, OFF_TAB8) + (size_t)which * 16384 * 1024 + (size_t)(lane >> 5) * (16384 * 128) + (size_t)r * 128 + (lane & 31) * 4;
#pragma unroll
  for (int i = 0; i < 4; ++i)
    *reinterpret_cast<unsigned*>(dst + (size_t)(2 * i) * (16384 * 128)) = pack_fp8x4(v[i].x * sc, v[i].y * sc, v[i].z * sc, v[i].w * sc);
  if (lane == 0) wsp<float>(P, OFF_RSC)[row] = am > 0.f ? am / 240.f : 1.f;
}

DEV void phase_prep(const Params& P, unsigned char* smem) {
  for (int t = blockIdx.x; t < J0_END; t += gridDim.x) {
    if (t < J0_GLU) job_transpose(P.in[I_EVWIN], wsp<bf16_t>(P, OFF_WEVIN), 1024, 2048, 2048, t - J0_EVIN, smem);
    else if (t < J0_EVOUT) job_transpose(P.in[I_S5GLUW], wsp<bf16_t>(P, OFF_WGLU), 512, 512, 512, t - J0_GLU, smem);
    else if (t < J0_ODIN) job_transpose(P.in[I_EVWOUT], wsp<bf16_t>(P, OFF_WEVOUT), 1024, 1024, 1024, t - J0_EVOUT, smem);
    else if (t < J0_ODOUT) job_transpose(P.in[I_ODWIN], wsp<bf16_t>(P, OFF_WODIN), 1024, ODIN_N, ODIN_NPAD, t - J0_ODIN, smem);
    else if (t < J0_PKQ0) job_transpose(P.in[I_ODWOUT], wsp<bf16_t>(P, OFF_WODOUT), 1024, 1024, 1024, t - J0_ODOUT, smem);
    else if (t < J0_KEYS) job_convert(P.in[I_PKWQ], wsp<bf16_t>(P, OFF_WPKQ), t - J0_PKQ0);
    else if (t < J0_MOD) job_convert(P.in[I_PKKEYS], wsp<bf16_t>(P, OFF_KEYS), t - J0_KEYS);
    else if (t < J0_XINIT) job_mod(P, t - J0_MOD, smem);
    else if (t < J0_H2) job_xinit(P, t - J0_XINIT);
    else if (t < J0_S5P) job_h2(P, t - J0_H2);
    else job_s5p(P, t - J0_S5P);
  }
}

DEV void phase_norm(const Params& P, int layer, int which, bool with_tab) {
  const int lane = threadIdx.x & 63, w = threadIdx.x >> 6;
  const float* X = wsp<float>(P, OFF_X);
  bf16_t* XN = wsp<bf16_t>(P, OFF_RA);
  const float* g = P.in[I_NORMG] + ((size_t)layer * 2 + which) * 1024;
  F4 gg[4], sh[4], sc[4];
#pragma unroll
  for (int i = 0; i < 4; ++i) gg[i] = ldf4(g + i * 256 + lane * 4);
  int ccur = -1;
  if (with_tab && !(w & 1)) for (int t = blockIdx.x; t < TAB_TILES; t += gridDim.x) job_tab(P, layer, t);
  for (int r = blockIdx.x * NW + w; r < NTOK; r += gridDim.x * NW) {
    const float* x = X + (size_t)r * 1024;
    const int cd = row_cond(r);
    if (cd != ccur) {
      const float* mod = wsp<float>(P, OFF_MOD) + ((size_t)layer * NCOND + cd) * 6144 + (which ? 3 * 1024 : 0);
#pragma unroll
      for (int i = 0; i < 4; ++i) { sh[i] = ldf4(mod + i * 256 + lane * 4); sc[i] = ldf4(mod + 1024 + i * 256 + lane * 4); }
      ccur = cd;
    }
    F4 v[4]; float ss = 0.f;
#pragma unroll
    for (int i = 0; i < 4; ++i) { v[i] = ldf4(x + i * 256 + lane * 4); ss += v[i].x * v[i].x + v[i].y * v[i].y + v[i].z * v[i].z + v[i].w * v[i].w; }
    ss = wave_sum(ss);
    const float rs = rsqrtf(ss * (1.f / 1024.f) + EPS);
#pragma unroll
    for (int i = 0; i < 4; ++i) {
      int c = i * 256 + lane * 4;
      float o0 = v[i].x * rs * gg[i].x * (1.f + sc[i].x) + sh[i].x, o1 = v[i].y * rs * gg[i].y * (1.f + sc[i].y) + sh[i].y;
      float o2 = v[i].z * rs * gg[i].z * (1.f + sc[i].z) + sh[i].z, o3 = v[i].w * rs * gg[i].w * (1.f + sc[i].w) + sh[i].w;
      st8(XN + (size_t)r * 1024 + c, U2{pack2(o0, o1), pack2(o2, o3)});
    }
  }
  if (with_tab && (w & 1)) for (int t = blockIdx.x; t < TAB_TILES; t += gridDim.x) job_tab(P, layer, t);
}

DEV void cswap_desc(float& a, float& b) { const float hi = fmaxf(a, b), lo = fminf(a, b); a = hi; b = lo; }
DEV void bitonic_sort16_desc(float* v) {
#pragma unroll
  for (int k = 2; k <= 16; k <<= 1)
#pragma unroll
    for (int jj = k >> 1; jj >= 1; jj >>= 1)
#pragma unroll
      for (int i = 0; i < 16; ++i) {
        const int l = i ^ jj;
        if (l > i) { if ((i & k) == 0) cswap_desc(v[i], v[l]); else cswap_desc(v[l], v[i]); }
      }
}
DEV void sort16_net_desc(float* v) {
#define CS(i, j) cswap_desc(v[i], v[j])
  CS(0, 13); CS(1, 12); CS(2, 15); CS(3, 14); CS(4, 8); CS(5, 6); CS(7, 11); CS(9, 10);
  CS(0, 5); CS(1, 7); CS(2, 9); CS(3, 4); CS(6, 13); CS(8, 14); CS(10, 15); CS(11, 12);
  CS(0, 1); CS(2, 3); CS(4, 5); CS(6, 8); CS(7, 9); CS(10, 11); CS(12, 13); CS(14, 15);
  CS(0, 2); CS(1, 3); CS(4, 10); CS(5, 11); CS(6, 7); CS(8, 9); CS(12, 14); CS(13, 15);
  CS(1, 2); CS(3, 12); CS(4, 6); CS(5, 7); CS(8, 10); CS(9, 11); CS(13, 14);
  CS(1, 4); CS(2, 6); CS(5, 8); CS(7, 10); CS(9, 13); CS(11, 14);
  CS(2, 4); CS(3, 6); CS(9, 12); CS(11, 13);
  CS(3, 5); CS(6, 8); CS(7, 9); CS(10, 12);
  CS(3, 4); CS(5, 6); CS(7, 8); CS(9, 10); CS(11, 12);
  CS(6, 7); CS(8, 9);
#undef CS
}
DEV void bitonic_merge16_desc(float* v) {
#pragma unroll
  for (int jj = 8; jj >= 1; jj >>= 1)
#pragma unroll
    for (int i = 0; i < 16; ++i) { const int l = i ^ jj; if (l > i) cswap_desc(v[i], v[l]); }
}
DEV float pack_key(float v, int idx) { return u2f((f2u(v) & 0xffffff80u) | (unsigned)(127 - idx)); }
struct EpiTopk { unsigned short* EIDX; bf16_t* EGT;
  DEVM bf16_t* stage_base(int, int) const { return nullptr; }
  DEVM int stage_ld() const { return 0; }
  DEVM void operator()(int, int, f32x4) const {} };
template <class E> struct IsTopk { static constexpr bool value = false; };
template <> struct IsTopk<EpiTopk> { static constexpr bool value = true; };
DEV void topk_rows(const float* S, float* best, int tid) {
  const int lane = tid & 63, w = tid >> 6;
  const int row = 32 * w + (lane & 31), half = lane >> 5;
  const float* sr = S + row * 129 + half * 64;
#pragma unroll
  for (int g = 0; g < 4; ++g) {
    float v[16];
#pragma unroll
    for (int i = 0; i < 16; ++i) v[i] = pack_key(sr[g * 16 + i], half * 64 + g * 16 + i);
    sort16_net_desc(v);
    if (g == 0) {
#pragma unroll
      for (int i = 0; i < 16; ++i) best[i] = v[i];
    } else {
#pragma unroll
      for (int i = 0; i < 16; ++i) best[i] = fmaxf(best[i], v[15 - i]);
      bitonic_merge16_desc(best);
    }
  }
  float oth[16];
#pragma unroll
  for (int i = 0; i < 16; ++i) oth[i] = __shfl_xor(best[15 - i], 32);
#pragma unroll
  for (int i = 0; i < 16; ++i) best[i] = fmaxf(best[i], oth[i]);
  bitonic_merge16_desc(best);
}
template <int ST>
DEV void route_row(const float* ka, const float* kb, float* sb, unsigned char* ia, unsigned char* ib, int col, unsigned short* EI, bf16_t* GT, int head) {
  float* ct = reinterpret_cast<float*>(ib + 16 * ST);
  float a[8];
  const float b0 = u2f(f2u(kb[0]) & 0xffffff80u);
#pragma unroll
  for (int i = 0; i < 16; ++i) {
    const unsigned ua = f2u(ka[i]), ub = f2u(kb[i]);
    const float av = u2f(ua & 0xffffff80u);
    if (i < 8) a[i] = av; else ct[(i - 8) * ST + col] = av + b0;
    sb[i * ST + col] = u2f(ub & 0xffffff80u);
    ia[i * ST + col] = (unsigned char)(127u - (ua & 127u)); ib[i * ST + col] = (unsigned char)(127u - (ub & 127u));
  }
  ct[8 * ST + col] = -3.0e38f;
  float cur[8];
#pragma unroll
  for (int i = 0; i < 8; ++i) cur[i] = a[i] + b0;
  float curT = ct[col];
  int tp = 0;
  unsigned jp = 0u;
  float best[16]; int ex[16];
#pragma unroll
  for (int o2 = 0; o2 < 16; ++o2) {
    float bv = cur[0]; int bi = 0;
#pragma unroll
    for (int i = 1; i < 8; ++i) if (cur[i] > bv) { bv = cur[i]; bi = i; }
    const bool tail = curT > bv;
    best[o2] = tail ? curT : bv;
    const int j = (int)((jp >> (4 * bi)) & 15u);
    const int ra = tail ? 8 + tp : bi, cb = tail ? 0 : j;
    ex[o2] = (int)ia[ra * ST + col] * 128 + (int)ib[cb * ST + col];
    const int jn = j + 1;
    float nv = -3.0e38f;
    if ((bi + 1) * (jn + 1) <= 16) {
      float av = a[0];
#pragma unroll
      for (int i = 1; i < 8; ++i) av = (i == bi) ? a[i] : av;
      nv = av + sb[(jn & 15) * ST + col];
    }
    const int tq = tp + 1 < 8 ? tp + 1 : 8;
    const float nt = ct[tq * ST + col];
    const int bsel = tail ? 8 : bi;
#pragma unroll
    for (int i = 0; i < 8; ++i) cur[i] = (i == bsel) ? nv : cur[i];
    jp += tail ? 0u : (1u << (4 * bi));
    curT = tail ? nt : curT; tp = tail ? tq : tp;
  }
  float sum = 0.f;
  const float bmax = best[0];
#pragma unroll
  for (int o2 = 0; o2 < 16; ++o2) { best[o2] = __expf(best[o2] - bmax); sum += best[o2]; }
  const float inv = 1.f / sum;
#pragma unroll
  for (int o2 = 0; o2 < 16; ++o2) {
    const int pos = (o2 & 7) * 16 + head * 2 + (o2 >> 3);
    EI[pos] = (unsigned short)ex[o2]; GT[pos] = f2bf(best[o2] * inv);
  }
}

constexpr int G_BM = 256, G_BK = 64;
template <int BN, class Epi>
DEV void gemm_tile(const bf16_t* A, int lda, const bf16_t* Bt, int ldb, int K, int m0, int n0, Epi& epi, unsigned char* smem) {
  constexpr int BUFB = (G_BM + BN) * 128;
  constexpr int NST = BN == 256 ? 2 : 3;
  constexpr int MI = BN == 256 ? 8 : 4;
  constexpr int NBP = BN / 64;
  const int tid = threadIdx.x, lane = tid & 63, w = tid >> 6;
  const int wm = BN == 256 ? (w >> 2) : (w >> 1), wn = BN == 256 ? (w & 3) : (w & 1);
  const int lr = lane & 15, lq = lane >> 4;
  f32x4 acc[MI][4];
#pragma unroll
  for (int i = 0; i < MI; ++i)
#pragma unroll
    for (int j = 0; j < 4; ++j) acc[i][j] = f32x4{0.f, 0.f, 0.f, 0.f};
  const int prow = lane >> 3, pslot = (lane & 7) ^ prow;
  auto stage = [&](unsigned char* buf, int k0) {
#pragma unroll
    for (int i = 0; i < 4; ++i) {
      const int piece = w * 4 + i;
      glds16(A + (size_t)(m0 + piece * 8 + prow) * lda + k0 + pslot * 8, buf + piece * 1024 + lane * 16);
    }
#pragma unroll
    for (int i = 0; i < NBP; ++i) {
      const int piece = w * NBP + i;
      glds16(Bt + (size_t)(n0 + piece * 8 + prow) * ldb + k0 + pslot * 8, buf + G_BM * 128 + piece * 1024 + lane * 16);
    }
  };
  auto compute = [&](const unsigned char* As) {
    const unsigned char* Bs = As + G_BM * 128;
#pragma unroll
    for (int kk = 0; kk < 2; ++kk) {
      bf16x8 fa[MI], fb[4];
#pragma unroll
      for (int j = 0; j < 4; ++j) {
        const int r = IsTopk<Epi>::value ? (j >> 1) * 128 + wn * 32 + (j & 1) * 16 + lr : wn * 64 + j * 16 + lr;
        fb[j] = as_frag(ld16(Bs + r * 128 + (((kk * 4 + lq) ^ (r & 7)) << 4)));
      }
#pragma unroll
      for (int i = 0; i < MI; ++i) { const int r = wm * (16 * MI) + i * 16 + lr; fa[i] = as_frag(ld16(As + r * 128 + (((kk * 4 + lq) ^ (r & 7)) << 4))); }
#pragma unroll
      for (int i = 0; i < MI; ++i)
#pragma unroll
        for (int j = 0; j < 4; ++j) acc[i][j] = mfma16(fb[j], fa[i], acc[i][j]);
    }
  };
  const int nk = K / G_BK;
  SYNC();
#pragma unroll
  for (int p = 0; p < NST - 1; ++p) if (p < nk) stage(smem + p * BUFB, p * G_BK);
  for (int kt = 0; kt < nk; ++kt) {
    if (NST == 3 && kt + 1 < nk) asm_wait_vm6(); else glds_wait();
    SYNC();
    SYNC();
    if (kt + NST - 1 < nk) stage(smem + ((kt + NST - 1) % NST) * BUFB, (kt + NST - 1) * G_BK);
    compute(smem + (kt % NST) * BUFB);
  }
  SYNC();
  if constexpr (IsTopk<Epi>::value) {
    static_assert(BN == 256, "top-k epilogue needs the 256-wide tile");
    float* S = reinterpret_cast<float*>(smem);
    const int te = tid, le = lane, we = w;
    float* pw = S + (wm * (16 * MI) + lr) * 129 + wn * 32 + lq * 4;
    float ka[16], kb[16];
#pragma unroll
    for (int i = 0; i < MI; ++i)
#pragma unroll
      for (int j = 0; j < 2; ++j) {
        float* p = pw + i * 16 * 129 + j * 16;
        p[0] = acc[i][j][0]; p[1] = acc[i][j][1]; p[2] = acc[i][j][2]; p[3] = acc[i][j][3];
      }
    SYNC();
    topk_rows(S, ka, te);
    SYNC();
#pragma unroll
    for (int i = 0; i < MI; ++i)
#pragma unroll
      for (int j = 0; j < 2; ++j) {
        float* p = pw + i * 16 * 129 + j * 16;
        p[0] = acc[i][2 + j][0]; p[1] = acc[i][2 + j][1]; p[2] = acc[i][2 + j][2]; p[3] = acc[i][2 + j][3];
      }
    SYNC();
    topk_rows(S, kb, te);
    SYNC();
    if (le < 32) {
      const int col = we * 32 + le;
      float* sb = reinterpret_cast<float*>(smem);
      unsigned char* ia = smem + 16 * 256 * 4;
      unsigned char* ib = ia + 16 * 256;
      route_row<256>(ka, kb, sb, ia, ib, col, epi.EIDX + (size_t)(m0 + col) * 128, epi.EGT + (size_t)(m0 + col) * 128, n0 >> 8);
    }
    return;
  }
  bf16_t* sbase = epi.stage_base(n0, BN);
  if (sbase != nullptr) {
    bf16_t* T = reinterpret_cast<bf16_t*>(smem) + (size_t)w * (16 * MI) * 68;
#pragma unroll
    for (int i = 0; i < MI; ++i)
#pragma unroll
      for (int j = 0; j < 4; ++j) st8(T + (i * 16 + lr) * 68 + j * 16 + lq * 4, U2{pack2(acc[i][j][0], acc[i][j][1]), pack2(acc[i][j][2], acc[i][j][3])});
    wave_lds_fence();
    const int ldc = epi.stage_ld();
    bf16_t* dst = sbase + (size_t)(m0 + wm * (16 * MI)) * ldc + n0 + wn * 64;
#pragma unroll
    for (int p = 0; p < 2 * MI; ++p) {
      const int r = p * 8 + (lane >> 3), c8 = (lane & 7) * 8;
      const U2 a = ld8(T + r * 68 + c8), b = ld8(T + r * 68 + c8 + 4);
      st16(dst + (size_t)r * ldc + c8, U4{a.x, a.y, b.x, b.y});
    }
  } else {
#pragma unroll
    for (int i = 0; i < MI; ++i)
#pragma unroll
      for (int j = 0; j < 4; ++j) epi(m0 + wm * (16 * MI) + i * 16 + lr, n0 + wn * 64 + j * 16 + lq * 4, acc[i][j]);
  }
  SYNC();
}
#ifndef EMU
#define G8_BAR() __builtin_amdgcn_s_barrier()
#define G8_WAIT_V(n) asm volatile("s_waitcnt vmcnt(" #n ")" ::: "memory")
#define G8_WAIT_L(n) asm volatile("s_waitcnt lgkmcnt(" #n ")" ::: "memory")
#define G8_SCHED() __builtin_amdgcn_sched_barrier(0)
#define G8_PRIO(p) __builtin_amdgcn_s_setprio(p)
#else
#define G8_BAR() SYNC()
#define G8_WAIT_V(n) do {} while (0)
#define G8_WAIT_L(n) do {} while (0)
#define G8_SCHED() do {} while (0)
#define G8_PRIO(p) do {} while (0)
#endif
DEV int g8_lds_byte(int r, int c) { const int st = (r >> 4) * 2 + (c >> 5), rr = r & 15, cc = c & 31, ob = rr * 64 + cc * 2; return st * 1024 + (ob ^ (((ob >> 9) & 1) << 5)); }
DEV void g8_stage_rc(int b, int& R, int& C) { const int st = b / 1024, sb = b % 1024, swz = sb ^ (((sb >> 9) & 1) << 5); R = (st >> 1) * 16 + swz / 64; C = (st & 1) * 32 + (swz % 64) / 2; }
template <class Epi>
DEV void gemm8_tile(const bf16_t* A, const bf16_t* Bt, int brow, int bcol, Epi& epi, unsigned char* smem) {
  constexpr int LD = 1024, HT = 128 * 64, NTK = LD / 64;
  const int tid = threadIdx.x, wid = tid >> 6, lane = tid & 63, wr = wid >> 2, wc = wid & 3, fr = lane & 15, fq = lane >> 4;
  bf16_t* shm = reinterpret_cast<bf16_t*>(smem);
#define G8_SA(b, h) (shm + ((b) * 2 + (h)) * HT)
#define G8_SB(b, h) (shm + (4 + (b) * 2 + (h)) * HT)
#ifndef EMU
  const int ldst = uniform_i((tid >> 6) * 1024);
#else
  const int ldst = tid * 16;
#endif
  unsigned voff[2];
#pragma unroll
  for (int i = 0; i < 2; ++i) { int r_, c_; g8_stage_rc(tid * 16 + i * 8192, r_, c_); voff[i] = (unsigned)(r_ * LD + c_) * 2u; }
#define G8_STAGE(PP, BASE, br, kt) do { \
    const unsigned char* _gb = reinterpret_cast<const unsigned char*>(BASE) + ((size_t)(br) * LD + (size_t)(kt) * 64) * 2; \
    _Pragma("unroll") for (int _i = 0; _i < 2; ++_i) glds16(_gb + voff[_i], reinterpret_cast<unsigned char*>(PP) + ldst + _i * 8192); } while (0)
#define G8_LDA(dst, b, h) do { _Pragma("unroll") for (int m = 0; m < 4; ++m) _Pragma("unroll") for (int k = 0; k < 2; ++k) \
    dst[m][k] = *reinterpret_cast<const bf16x8*>(reinterpret_cast<const unsigned char*>(G8_SA(b, h)) + g8_lds_byte(wr * 64 + m * 16 + fr, k * 32 + fq * 8)); } while (0)
#define G8_LDB(dst, b, h) do { _Pragma("unroll") for (int n = 0; n < 2; ++n) _Pragma("unroll") for (int k = 0; k < 2; ++k) \
    dst[n][k] = *reinterpret_cast<const bf16x8*>(reinterpret_cast<const unsigned char*>(G8_SB(b, h)) + g8_lds_byte(wc * 32 + n * 16 + fr, k * 32 + fq * 8)); } while (0)
#define G8_MMA(ai, bj, AT, BT) do { G8_PRIO(1); \
    _Pragma("unroll") for (int m = 0; m < 4; ++m) _Pragma("unroll") for (int n = 0; n < 2; ++n) _Pragma("unroll") for (int k = 0; k < 2; ++k) \
      acc[ai][bj][m][n] = mfma16(BT[n][k], AT[m][k], acc[ai][bj][m][n]); \
    G8_PRIO(0); } while (0)
  f32x4 acc[2][2][4][2];
#pragma unroll
  for (int a = 0; a < 2; ++a)
#pragma unroll
    for (int b = 0; b < 2; ++b)
#pragma unroll
      for (int m = 0; m < 4; ++m)
#pragma unroll
        for (int n = 0; n < 2; ++n) acc[a][b][m][n] = f32x4{0.f, 0.f, 0.f, 0.f};
  bf16x8 At[4][2], B0[2][2], B1[2][2];
  SYNC();
  G8_STAGE(G8_SB(0, 0), Bt, bcol, 0); G8_STAGE(G8_SA(0, 0), A, brow, 0);
  G8_STAGE(G8_SB(0, 1), Bt, bcol + 128, 0); G8_STAGE(G8_SA(0, 1), A, brow + 128, 0);
  if (wr == 1) G8_BAR();
  G8_WAIT_V(4); G8_BAR();
  G8_STAGE(G8_SB(1, 0), Bt, bcol, 1); G8_STAGE(G8_SA(1, 0), A, brow, 1); G8_STAGE(G8_SB(1, 1), Bt, bcol + 128, 1);
  G8_WAIT_V(6); G8_BAR();
#pragma unroll 1
  for (int t = 0; t < NTK - 2; t += 2) {
    G8_LDB(B0, 0, 0); G8_SCHED(); G8_LDA(At, 0, 0); G8_STAGE(G8_SA(1, 1), A, brow + 128, t + 1);
    G8_WAIT_L(8); G8_BAR(); G8_WAIT_L(0); G8_MMA(0, 0, At, B0); G8_BAR(); G8_SCHED();
    G8_LDB(B1, 0, 1); G8_STAGE(G8_SB(0, 0), Bt, bcol, t + 2);
    G8_BAR(); G8_WAIT_L(0); G8_MMA(0, 1, At, B1); G8_BAR();
    G8_LDA(At, 0, 1); G8_STAGE(G8_SA(0, 0), A, brow, t + 2);
    G8_BAR(); G8_WAIT_L(0); G8_MMA(1, 0, At, B0); G8_BAR(); G8_SCHED();
    G8_STAGE(G8_SB(0, 1), Bt, bcol + 128, t + 2);
    G8_WAIT_V(6); G8_BAR(); G8_MMA(1, 1, At, B1); G8_BAR();
    G8_LDB(B0, 1, 0); G8_SCHED(); G8_LDA(At, 1, 0); G8_STAGE(G8_SA(0, 1), A, brow + 128, t + 2);
    G8_WAIT_L(8); G8_BAR(); G8_WAIT_L(0); G8_MMA(0, 0, At, B0); G8_BAR(); G8_SCHED();
    G8_LDB(B1, 1, 1); G8_STAGE(G8_SB(1, 0), Bt, bcol, t + 3);
    G8_BAR(); G8_WAIT_L(0); G8_MMA(0, 1, At, B1); G8_BAR();
    G8_LDA(At, 1, 1); G8_STAGE(G8_SA(1, 0), A, brow, t + 3);
    G8_BAR(); G8_WAIT_L(0); G8_MMA(1, 0, At, B0); G8_BAR(); G8_SCHED();
    G8_STAGE(G8_SB(1, 1), Bt, bcol + 128, t + 3);
    G8_WAIT_V(6); G8_BAR(); G8_MMA(1, 1, At, B1); G8_BAR();
  }
  { G8_LDB(B0, 0, 0); G8_LDA(At, 0, 0); G8_STAGE(G8_SA(1, 1), A, brow + 128, NTK - 1);
    G8_BAR(); G8_WAIT_L(0); G8_MMA(0, 0, At, B0); G8_BAR();
    G8_LDB(B1, 0, 1); G8_BAR(); G8_WAIT_L(0); G8_MMA(0, 1, At, B1); G8_BAR();
    G8_LDA(At, 0, 1); G8_WAIT_V(4); G8_BAR(); G8_WAIT_L(0); G8_MMA(1, 0, At, B0); G8_MMA(1, 1, At, B1); G8_BAR(); }
  { G8_LDB(B0, 1, 0); G8_LDA(At, 1, 0); G8_WAIT_V(2); G8_BAR(); G8_WAIT_L(0); G8_MMA(0, 0, At, B0); G8_BAR();
    G8_LDB(B1, 1, 1); G8_WAIT_V(0); G8_BAR(); G8_WAIT_L(0); G8_MMA(0, 1, At, B1); G8_BAR();
    G8_LDA(At, 1, 1); G8_BAR(); G8_WAIT_L(0); G8_MMA(1, 0, At, B0); G8_MMA(1, 1, At, B1); G8_BAR(); }
  if (wr == 0) G8_BAR();
#undef G8_SA
#undef G8_SB
#undef G8_STAGE
#undef G8_LDA
#undef G8_LDB
#undef G8_MMA
  SYNC();
  const int te = tid_opaque(), wie = te >> 6, lae = te & 63, wre = wie >> 2, wce = wie & 3, fre = lae & 15, fqe = lae >> 4;
  if constexpr (IsTopk<Epi>::value) {
    float* S = reinterpret_cast<float*>(smem);
    float* pw = S + (wre * 64 + fre) * 129 + wce * 32 + fqe * 4;
    float ka[16], kb[16];
#pragma unroll
    for (int ai = 0; ai < 2; ++ai)
#pragma unroll
      for (int m = 0; m < 4; ++m)
#pragma unroll
        for (int n = 0; n < 2; ++n) {
          float* p = pw + (ai * 128 + m * 16) * 129 + n * 16;
          p[0] = acc[ai][0][m][n][0]; p[1] = acc[ai][0][m][n][1]; p[2] = acc[ai][0][m][n][2]; p[3] = acc[ai][0][m][n][3];
        }
    SYNC();
    topk_rows(S, ka, te);
    SYNC();
#pragma unroll
    for (int ai = 0; ai < 2; ++ai)
#pragma unroll
      for (int m = 0; m < 4; ++m)
#pragma unroll
        for (int n = 0; n < 2; ++n) {
          float* p = pw + (ai * 128 + m * 16) * 129 + n * 16;
          p[0] = acc[ai][1][m][n][0]; p[1] = acc[ai][1][m][n][1]; p[2] = acc[ai][1][m][n][2]; p[3] = acc[ai][1][m][n][3];
        }
    SYNC();
    topk_rows(S, kb, te);
    SYNC();
    if (lae < 32) {
      const int col = wie * 32 + lae;
      float* sb = reinterpret_cast<float*>(smem);
      unsigned char* ia = smem + 16 * 256 * 4;
      unsigned char* ib = ia + 16 * 256;
      route_row<256>(ka, kb, sb, ia, ib, col, epi.EIDX + (size_t)(brow + col) * 128, epi.EGT + (size_t)(brow + col) * 128, bcol >> 8);
    }
    return;
  }
  bf16_t* sbase = epi.stage_base(bcol, 256);
  if (sbase != nullptr) {
    bf16_t* T = reinterpret_cast<bf16_t*>(smem);
#pragma unroll
    for (int ai = 0; ai < 2; ++ai)
#pragma unroll
      for (int bj = 0; bj < 2; ++bj)
#pragma unroll
        for (int m = 0; m < 4; ++m)
#pragma unroll
          for (int n = 0; n < 2; ++n)
            st8(T + (ai * 128 + wre * 64 + m * 16 + fre) * 264 + bj * 128 + wce * 32 + n * 16 + fqe * 4,
                U2{pack2(acc[ai][bj][m][n][0], acc[ai][bj][m][n][1]), pack2(acc[ai][bj][m][n][2], acc[ai][bj][m][n][3])});
    SYNC();
    const int ldc = epi.stage_ld();
    bf16_t* dst = sbase + (size_t)brow * ldc + bcol;
#pragma unroll 4
    for (int p = 0; p < 16; ++p) {
      const int r = wie * 32 + p * 2 + (lae >> 5), c8 = (lae & 31) * 8;
      st16(dst + (size_t)r * ldc + c8, ld16(T + r * 264 + c8));
    }
  } else {
#pragma unroll
    for (int ai = 0; ai < 2; ++ai)
#pragma unroll
      for (int bj = 0; bj < 2; ++bj)
#pragma unroll
        for (int m = 0; m < 4; ++m)
#pragma unroll
          for (int n = 0; n < 2; ++n)
            epi(brow + ai * 128 + wre * 64 + m * 16 + fre, bcol + bj * 128 + wce * 32 + n * 16 + fqe * 4, acc[ai][bj][m][n]);
  }
}
#ifndef USE_G8
#define USE_G8 1
#endif
template <int BN, class Epi>
DEV void gemm_tile_sel(const bf16_t* A, int lda, const bf16_t* Bt, int ldb, int K, int m0, int n0, Epi& epi, unsigned char* smem) {
  if constexpr (BN == 256 && USE_G8) gemm8_tile(A, Bt, m0, n0, epi, smem); else gemm_tile<BN>(A, lda, Bt, ldb, K, m0, n0, epi, smem);
}
template <int BN, class Epi>
DEV void gemm_phase(const bf16_t* A, int lda, const bf16_t* Bt, int ldb, int M, int Npad, int K, Epi epi, unsigned char* smem) {
  const int ntn = Npad / BN, ntm = M / G_BM;
  if ((ntm & 7) == 0 && (gridDim.x & 7) == 0) {
    const int x = blockIdx.x & 7, jr = blockIdx.x >> 3, per = gridDim.x >> 3;
    const int nloc = (ntm >> 3) * ntn;
    for (int q = jr; q < nloc; q += per) gemm_tile_sel<BN>(A, lda, Bt, ldb, K, ((q / ntn) * 8 + x) * G_BM, (q % ntn) * BN, epi, smem);
  } else {
    for (int t = blockIdx.x; t < ntn * ntm; t += gridDim.x) gemm_tile_sel<BN>(A, lda, Bt, ldb, K, (t / ntn) * G_BM, (t % ntn) * BN, epi, smem);
  }
}
struct EpiStoreBf16 { bf16_t* C; int ldc;
  DEVM bf16_t* stage_base(int, int) const { return C; }
  DEVM int stage_ld() const { return ldc; }
  DEVM void operator()(int m, int n, f32x4 v) const { st8(C + (size_t)m * ldc + n, U2{pack2(v[0], v[1]), pack2(v[2], v[3])}); } };
struct EpiResid { float* X; const float* gate; float scale;
  DEVM bf16_t* stage_base(int, int) const { return nullptr; }
  DEVM int stage_ld() const { return 0; }
  DEVM void operator()(int m, int n, f32x4 v) const {
    const float* g = gate + (size_t)row_cond(m) * 6144 + n;
    float* x = X + (size_t)m * 1024 + n;
    F4 xv = ldf4(x), gv = ldf4(g);
    stf4(x, F4{xv.x + scale * gv.x * v[0], xv.y + scale * gv.y * v[1], xv.z + scale * gv.z * v[2], xv.w + scale * gv.w * v[3]});
  } };
struct EpiWF { bf16_t* W;
  DEVM bf16_t* stage_base(int, int) const { return nullptr; }
  DEVM int stage_ld() const { return 0; }
  DEVM void operator()(int m, int n, f32x4 v) const {
#pragma unroll
    for (int i = 0; i < 4; ++i) W[(size_t)(n + i) * 1024 + m] = (bf16_t)(pack2(v[i], 0.f) & 0xffffu);
  } };
DEV void phase_wf(const Params& P, int layer, unsigned char* smem) {
  for (int t = blockIdx.x; t < 64; t += gridDim.x) {
    const int hc = t >> 2, mt = t & 3;
    EpiWF epi{wsp<bf16_t>(P, OFF_WF) + (size_t)hc * 128 * 1024};
    gemm_tile<128>(wsp<bf16_t>(P, OFF_WPKQ) + (size_t)layer * 1024 * 2048 + hc * 128, 2048,
                   wsp<bf16_t>(P, OFF_KEYS) + ((size_t)layer * 16 + hc) * 128 * 128, 128, 128, mt * 256, 0, epi, smem);
  }
}


DEV void cmulr(float& ar, float& ai, float br, float bi) { float r = ar * br - ai * bi, i = ar * bi + ai * br; ar = r; ai = i; }
template <int LOGN, int NTHR> DEV void fft_radix8_pass(F2* x, const F2* tw, int h, bool inverse, int tl) {
  constexpr int N = 1 << LOGN;
  const int hq = h >> 2;
  const float R = 0.70710678118654752f;
  const int lhq = 31 - __builtin_clz((unsigned)hq);
#pragma unroll 1
  for (int g = tl; g < N / 8; g += NTHR) {
    const int b = g >> lhq, r = g & (hq - 1);
    F2* xp = x + b * 2 * h + r;
    float er[8], ei[8];
#pragma unroll
    for (int j = 0; j < 8; ++j) { F2 v = xp[j * hq]; er[j] = v.x; ei[j] = v.y; }
    const F2 t1 = tw[r << (LOGN - 3 - lhq)];
    const float c1 = t1.x; const float s1 = inverse ? -t1.y : t1.y;
    const float c2 = c1 * c1 - s1 * s1, s2 = 2.f * c1 * s1;
    const float c4 = c2 * c2 - s2 * s2, s4 = 2.f * c2 * s2;
    const float sg = inverse ? 1.f : -1.f;
    const float w8r[4] = {1.f, R, 0.f, -R}, w8i[4] = {0.f, sg * R, sg, sg * R};
    if (!inverse) {
#pragma unroll
      for (int j = 0; j < 4; ++j) {
        float ur = er[j], ui = ei[j], vr = er[j + 4], vi = ei[j + 4];
        er[j] = ur + vr; ei[j] = ui + vi;
        float tr = ur - vr, ti = ui - vi;
        float wr = c1, wi = s1; cmulr(wr, wi, w8r[j], w8i[j]);
        cmulr(tr, ti, wr, wi); er[j + 4] = tr; ei[j + 4] = ti;
      }
#pragma unroll
      for (int jj = 0; jj < 4; ++jj) {
        const int j = (jj & 1) + (jj >> 1) * 4;
        float ur = er[j], ui = ei[j], vr = er[j + 2], vi = ei[j + 2];
        er[j] = ur + vr; ei[j] = ui + vi;
        float tr = ur - vr, ti = ui - vi;
        float wr = c2, wi = s2; if (j & 1) { float t = wr; wr = wi; wi = -t; }
        cmulr(tr, ti, wr, wi); er[j + 2] = tr; ei[j + 2] = ti;
      }
#pragma unroll
      for (int j = 0; j < 8; j += 2) {
        float ur = er[j], ui = ei[j], vr = er[j + 1], vi = ei[j + 1];
        er[j] = ur + vr; ei[j] = ui + vi;
        float tr = ur - vr, ti = ui - vi;
        cmulr(tr, ti, c4, s4); er[j + 1] = tr; ei[j + 1] = ti;
      }
    } else {
#pragma unroll
      for (int j = 0; j < 8; j += 2) {
        float vr = er[j + 1], vi = ei[j + 1]; cmulr(vr, vi, c4, s4);
        float ur = er[j], ui = ei[j];
        er[j] = ur + vr; ei[j] = ui + vi; er[j + 1] = ur - vr; ei[j + 1] = ui - vi;
      }
#pragma unroll
      for (int jj = 0; jj < 4; ++jj) {
        const int j = (jj & 1) + (jj >> 1) * 4;
        float wr = c2, wi = s2; if (j & 1) { float t = wr; wr = -wi; wi = t; }
        float vr = er[j + 2], vi = ei[j + 2]; cmulr(vr, vi, wr, wi);
        float ur = er[j], ui = ei[j];
        er[j] = ur + vr; ei[j] = ui + vi; er[j + 2] = ur - vr; ei[j + 2] = ui - vi;
      }
#pragma unroll
      for (int j = 0; j < 4; ++j) {
        float wr = c1, wi = s1; cmulr(wr, wi, w8r[j], w8i[j]);
        float vr = er[j + 4], vi = ei[j + 4]; cmulr(vr, vi, wr, wi);
        float ur = er[j], ui = ei[j];
        er[j] = ur + vr; ei[j] = ui + vi; er[j + 4] = ur - vr; ei[j + 4] = ui - vi;
      }
    }
#pragma unroll
    for (int j = 0; j < 8; ++j) xp[j * hq] = F2{er[j], ei[j]};
  }
}
template <int LOGN, int NTHR> DEV void fft_radix2_last(F2* x, int tl) {
  constexpr int N = 1 << LOGN;
  for (int g = tl; g < N / 2; g += NTHR) {
    F2 u = x[2 * g], v = x[2 * g + 1];
    x[2 * g] = F2{u.x + v.x, u.y + v.y}; x[2 * g + 1] = F2{u.x - v.x, u.y - v.y};
  }
}
template <int LOGN, int NTHR> DEV void fft_fwd_t(F2* x, const F2* tw, int tl) {
  static_assert(LOGN % 3 == 0 || LOGN % 3 == 1, "fft size");
  int h = (1 << LOGN) / 2;
#pragma unroll 1
  for (int p = 0; p < LOGN / 3; ++p, h >>= 3) { fft_radix8_pass<LOGN, NTHR>(x, tw, h, false, tl); SYNC(); }
  if (LOGN % 3 == 1) { fft_radix2_last<LOGN, NTHR>(x, tl); SYNC(); }
}
template <int LOGN, int NTHR> DEV void fft_inv_t(F2* x, const F2* tw, int tl) {
  if (LOGN % 3 == 1) { fft_radix2_last<LOGN, NTHR>(x, tl); SYNC(); }
  int h = (LOGN % 3 == 1) ? 8 : 4;
#pragma unroll 1
  for (int p = 0; p < LOGN / 3; ++p, h <<= 3) { fft_radix8_pass<LOGN, NTHR>(x, tw, h, true, tl); SYNC(); }
}
template <int LOGN> DEV void fft_fill_twiddles(F2* tw) {
  for (int j = threadIdx.x; j < (1 << LOGN) / 8; j += NT) { float sn, cs; sincospif(-2.f * (float)j / (float)(1 << LOGN), &sn, &cs); tw[j] = F2{cs, sn}; }
}
constexpr size_t SM_TWL = 96 * 1024, SM_TWC = 112 * 1024;

template <int LOGN> DEV void hyena_filter_task(const Params& P, int c, unsigned char* smem) {
  constexpr int N = 1 << LOGN, L = N / 2;
  constexpr int h2base = (LOGN == LOG_NC) ? 0 : L_C;
  constexpr int kfoff = (LOGN == LOG_NC) ? 0 : 2 * L_C;
  F2* x = reinterpret_cast<F2*>(smem);
  float* w3s = reinterpret_cast<float*>(smem + (size_t)N * 8);
  float* red = w3s + 256;
  const int tid = threadIdx.x, lane = tid & 63, w = tid >> 6;
  if (tid < 256) { int f = tid >> 2, k = tid & 3; w3s[tid] = P.in[I_HYW3][(size_t)f * 2048 + (k >> 1) * 1024 + (k & 1) * 512 + c]; }
  float dec[4];
#pragma unroll
  for (int k = 0; k < 4; ++k) dec[k] = fabsf(P.in[I_HYDECAY][(k >> 1) * 1024 + (k & 1) * 512 + c]);
  if (tid == 0) x[L] = F2{0.f, 0.f};
  SYNC();
  const float* H2 = wsp<float>(P, OFF_H2) + (size_t)h2base * 64;
  float ss0 = 0.f, ss1 = 0.f;
  for (int i4 = tid * 4; i4 < L; i4 += NT * 4) {
    float acc[4][4];
#pragma unroll
    for (int pp = 0; pp < 4; ++pp)
#pragma unroll
      for (int k = 0; k < 4; ++k) acc[pp][k] = 0.f;
#pragma unroll 8
    for (int f = 0; f < 64; ++f) {
      const F4 hv = ldf4(H2 + (size_t)f * L + i4);
      const F4 ww = ldf4(w3s + f * 4);
      const float hh[4] = {hv.x, hv.y, hv.z, hv.w};
#pragma unroll
      for (int pp = 0; pp < 4; ++pp) { acc[pp][0] += hh[pp] * ww.x; acc[pp][1] += hh[pp] * ww.y; acc[pp][2] += hh[pp] * ww.z; acc[pp][3] += hh[pp] * ww.w; }
    }
#pragma unroll
    for (int pp = 0; pp < 4; ++pp) {
      const int i = i4 + pp;
      const float t = (float)i / (float)L;
      float hv[4];
#pragma unroll
      for (int k = 0; k < 4; ++k) hv[k] = acc[pp][k] * expf(-t * dec[k]);
      x[i] = F2{hv[0], hv[2]}; ss0 += hv[0] * hv[0]; ss1 += hv[2] * hv[2];
      if (i >= 1) { x[N - i] = F2{hv[1], hv[3]}; ss0 += hv[1] * hv[1]; ss1 += hv[3] * hv[3]; }
    }
  }
  ss0 = wave_sum(ss0); ss1 = wave_sum(ss1);
  if (lane == 0) { red[w] = ss0; red[NW + w] = ss1; }
  SYNC();
  float t0 = 0.f, t1 = 0.f;
#pragma unroll
  for (int i = 0; i < NW; ++i) { t0 += red[i]; t1 += red[NW + i]; }
  const float rs0 = rsqrtf(t0 + EPS), rs1 = rsqrtf(t1 + EPS);
  for (int j = tid; j < N; j += NT) { F2 v = x[j]; x[j] = F2{v.x * rs0, v.y * rs1}; }
  SYNC();
  fft_fwd_t<LOGN, NT>(x, reinterpret_cast<const F2*>(smem + (LOGN == LOG_NC ? SM_TWC : SM_TWL)), tid);
  F2* KF = wsp<F2>(P, OFF_KF);
  const float sc = 0.5f / (float)N;
  for (int p = tid; p < N; p += NT) {
    const int f = (int)(__brev((unsigned)p) >> (32 - LOGN));
    const int p2 = (int)(__brev((unsigned)((N - f) & (N - 1))) >> (32 - LOGN));
    F2 Z = x[p], Z2 = x[p2];
    KF[((size_t)c * 2 + 0) * KF_N + kfoff + p] = F2{(Z.x + Z2.x) * sc, (Z.y - Z2.y) * sc};
    KF[((size_t)c * 2 + 1) * KF_N + kfoff + p] = F2{(Z.y + Z2.y) * sc, -(Z.x - Z2.x) * sc};
  }
  SYNC();
}
DEV void phase_hyena_filters(const Params& P, unsigned char* smem) {
  fft_fill_twiddles<LOG_NL>(reinterpret_cast<F2*>(smem + SM_TWL)); fft_fill_twiddles<LOG_NC>(reinterpret_cast<F2*>(smem + SM_TWC));
  SYNC();
  for (int t = blockIdx.x; t < 1024; t += gridDim.x) {
    if (t < 512) hyena_filter_task<LOG_NL>(P, t, smem);
    else hyena_filter_task<LOG_NC>(P, t - 512, smem);
  }
}

DEV void hyena_conv_task(const Params& P, int task, unsigned char* smem) {
  bf16_t* T = reinterpret_cast<bf16_t*>(smem);
  const int rt = task / 6, ct = task % 6;
  const int r0 = rt * 64, c0 = ct * 256;
  const int tid = threadIdx.x, tl = tid >> 3, cg = (tid & 7) * 8;
  const int r = r0 + tl, pos = row_pos(r), L = r < NTOK_C ? L_C : L_L;
  const float* cw = P.in[I_HYCW]; const float* cb = P.in[I_HYCB];
#pragma unroll
  for (int sub = 0; sub < 4; ++sub) {
    const bf16_t* pr = wsp<bf16_t>(P, OFF_PROJ0) + (size_t)r * 2048 + c0 + sub * 64 + cg;
    const U4 z4{0u, 0u, 0u, 0u};
    U4 xm = pos > 0 ? ld16(pr - 2048) : z4, x0 = ld16(pr), xp = pos < L - 1 ? ld16(pr + 2048) : z4;
    const unsigned am[4] = {xm.x, xm.y, xm.z, xm.w}, a0[4] = {x0.x, x0.y, x0.z, x0.w}, ap[4] = {xp.x, xp.y, xp.z, xp.w};
#pragma unroll
    for (int j = 0; j < 8; ++j) {
      const int c = c0 + sub * 64 + cg + j;
      float vm = (j & 1) ? bfhi(am[j >> 1]) : bflo(am[j >> 1]);
      float v0 = (j & 1) ? bfhi(a0[j >> 1]) : bflo(a0[j >> 1]);
      float vp = (j & 1) ? bfhi(ap[j >> 1]) : bflo(ap[j >> 1]);
      float o = vm * cw[c] + v0 * cw[1536 + c] + vp * cw[3072 + c] + cb[c];
      T[(sub * 64 + cg + j) * 72 + tl] = f2bf(o);
    }
  }
  SYNC();
#pragma unroll
  for (int sub = 0; sub < 4; ++sub) {
    const int cl = sub * 64 + (tid >> 3), tc = (tid & 7) * 8;
    st16(wsp<bf16_t>(P, OFF_HT3) + (size_t)(c0 + cl) * NTOK + r0 + tc, ld16(T + cl * 72 + tc));
  }
  SYNC();
}
DEV void hyena_untranspose_task(const Params& P, int task, unsigned char* smem) {
  bf16_t* T = reinterpret_cast<bf16_t*>(smem);
  const int rt = task / 8, ct = task % 8;
  const int r0 = rt * 64, c0 = ct * 64;
  const int tid = threadIdx.x;
  {
    const int cl = tid >> 3, tc = (tid & 7) * 8;
    U4 v = ld16(wsp<bf16_t>(P, OFF_HYT) + (size_t)(c0 + cl) * NTOK + r0 + tc);
    const unsigned a[4] = {v.x, v.y, v.z, v.w};
#pragma unroll
    for (int j = 0; j < 8; ++j) T[(tc + j) * 72 + cl] = (bf16_t)((j & 1) ? (a[j >> 1] >> 16) : (a[j >> 1] & 0xffffu));
  }
  SYNC();
  {
    const int tl = tid >> 3, cc = (tid & 7) * 8;
    st16(wsp<bf16_t>(P, OFF_RA) + (size_t)(r0 + tl) * 1024 + c0 + cc, ld16(T + tl * 72 + cc));
  }
  SYNC();
}

template <int LOGN, int NTHR> DEV void hyena_main_item(const Params& P, int c, int pair, bool valid, F2* x, const F2* tw, int tl) {
  constexpr int N = 1 << LOGN, L = N / 2;
  constexpr bool CTX = (LOGN == LOG_NC);
  constexpr int kfoff = CTX ? 0 : 2 * L_C;
  constexpr int NI = (L + NTHR - 1) / NTHR;
  const int rowA = CTX ? (2 * pair) * L_C : NTOK_C + (2 * pair) * L_L, rowB = rowA + L;
  const bf16_t* VT = wsp<bf16_t>(P, OFF_HT3) + (size_t)c * NTOK;
  const bf16_t* G1T = VT + (size_t)512 * NTOK; const bf16_t* G2T = VT + (size_t)1024 * NTOK;
  bf16_t* HYT = wsp<bf16_t>(P, OFF_HYT) + (size_t)c * NTOK;
  const F2* KF0 = wsp<F2>(P, OFF_KF) + ((size_t)c * 2 + 0) * KF_N + kfoff;
  const F2* KF1 = KF0 + KF_N;
  const float bias0 = P.in[I_HYBIAS][c], bias1 = P.in[I_HYBIAS][512 + c];
  constexpr int NP = N / NTHR;
  float za[NI], zb[NI], g1a[NI], g1b[NI], g2a[NI], g2b[NI];
#pragma unroll
  for (int i = 0; i < NI; ++i) {
    const int t = tl + i * NTHR;
    const bool in = t < L;
    const int ta = rowA + (in ? t : 0), tb = rowB + (in ? t : 0);
    za[i] = bf2f(VT[ta]); zb[i] = bf2f(VT[tb]); g1a[i] = bf2f(G1T[ta]); g1b[i] = bf2f(G1T[tb]); g2a[i] = bf2f(G2T[ta]); g2b[i] = bf2f(G2T[tb]);
  }
  F2 k0[NP], k1[NP];
#pragma unroll
  for (int i = 0; i < NP; ++i) { k0[i] = KF0[tl + i * NTHR]; k1[i] = KF1[tl + i * NTHR]; }
#pragma unroll
  for (int i = 0; i < NI; ++i) { const int t = tl + i * NTHR; if (t < L) { x[t] = F2{za[i], zb[i]}; x[L + t] = F2{0.f, 0.f}; } }
  SYNC();
  fft_fwd_t<LOGN, NTHR>(x, tw, tl);
#pragma unroll
  for (int i = 0; i < NP; ++i) { const int p = tl + i * NTHR; const F2 v = x[p], k = k0[i]; x[p] = F2{v.x * k.x - v.y * k.y, v.x * k.y + v.y * k.x}; }
  SYNC();
  fft_inv_t<LOGN, NTHR>(x, tw, tl);
  F2 z1r[NI];
#pragma unroll
  for (int i = 0; i < NI; ++i) {
    const int t = tl + i * NTHR;
    if (t < L) {
      F2 cv = x[t];
      z1r[i] = F2{g1a[i] * (cv.x + bias0 * za[i]), g1b[i] * (cv.y + bias0 * zb[i])};
    } else z1r[i] = F2{0.f, 0.f};
  }
  SYNC();
#pragma unroll
  for (int i = 0; i < NI; ++i) { const int t = tl + i * NTHR; if (t < L) { x[t] = z1r[i]; x[L + t] = F2{0.f, 0.f}; } }
  SYNC();
  fft_fwd_t<LOGN, NTHR>(x, tw, tl);
#pragma unroll
  for (int i = 0; i < NP; ++i) { const int p = tl + i * NTHR; const F2 v = x[p], k = k1[i]; x[p] = F2{v.x * k.x - v.y * k.y, v.x * k.y + v.y * k.x}; }
  SYNC();
  fft_inv_t<LOGN, NTHR>(x, tw, tl);
  if (valid) {
#pragma unroll
    for (int i = 0; i < NI; ++i) {
      const int t = tl + i * NTHR;
      if (t < L) {
        F2 cv = x[t];
        HYT[rowA + t] = f2bf(g2a[i] * (cv.x + bias1 * z1r[i].x));
        HYT[rowB + t] = f2bf(g2b[i] * (cv.y + bias1 * z1r[i].y));
      }
    }
  }
  SYNC();
}

DEV void s5_load_u(const bf16_t* p, float* u) {
  U4 a = ld16(p), b = ld16(p + 8);
  u[0] = bflo(a.x); u[1] = bfhi(a.x); u[2] = bflo(a.y); u[3] = bfhi(a.y); u[4] = bflo(a.z); u[5] = bfhi(a.z); u[6] = bflo(a.w); u[7] = bfhi(a.w);
  u[8] = bflo(b.x); u[9] = bfhi(b.x); u[10] = bflo(b.y); u[11] = bfhi(b.y); u[12] = bflo(b.z); u[13] = bfhi(b.z); u[14] = bflo(b.w); u[15] = bfhi(b.w);
}
DEV void s5_u_load(const bf16_t* U, bf16x4* fu, int lr, int lq) {
#pragma unroll
  for (int st = 0; st < 2; ++st) { U2 v = ld8(U + (size_t)(st * 16 + lr) * 2048 + lq * 4); memcpy(&fu[st], &v, 8); }
}
DEV void s5_bb_load(const bf16_t* BB, U2* fb, int lr, int lq) {
#pragma unroll
  for (int pt = 0; pt < 8; ++pt) fb[pt] = ld8(BB + (size_t)(pt * 16 + lr) * 16 + lq * 4);
}
DEV void s5_bu_mma(const bf16x4* fu, const U2* fbv, bf16_t* Bu, int lr, int lq) {
#pragma unroll
  for (int pt = 0; pt < 8; ++pt) {
    bf16x4 fb; memcpy(&fb, &fbv[pt], 8);
#pragma unroll
    for (int st = 0; st < 2; ++st) {
      f32x4 d = mfma16k16(fb, fu[st], f32x4{0.f, 0.f, 0.f, 0.f});
      st8(Bu + (st * 16 + lr) * 136 + pt * 16 + lq * 4, U2{pack2(d[0], d[1]), pack2(d[2], d[3])});
    }
  }
}
DEV void phase_s5_pass1(const Params& P, unsigned char* smem) {
  const int lane = threadIdx.x & 63, w = threadIdx.x >> 6, lr = lane & 15, lq = lane >> 4;
  bf16_t* Bu = reinterpret_cast<bf16_t*>(smem) + (size_t)w * 32 * 136;
  const int ntask = (NTOK / 64) * 32;
  const int niter = (ntask + gridDim.x * NW - 1) / (gridDim.x * NW);
  const bf16_t* PR0 = wsp<bf16_t>(P, OFF_PROJ0) + 1536;
  const bf16_t* BB16 = wsp<bf16_t>(P, OFF_BB16);
  int t = blockIdx.x * NW + w;
  bool valid = t < ntask;
  int ch = valid ? t >> 5 : 0, g = t & 31;
  bf16x4 fu[2]; U2 fb[8];
  s5_u_load(PR0 + (size_t)(ch * 64) * 2048 + g * 16, fu, lr, lq);
  s5_bb_load(BB16 + (size_t)g * 128 * 16, fb, lr, lq);
  for (int it = 0; it < niter; ++it) {
    const bf16_t* U = PR0 + (size_t)(ch * 64) * 2048 + g * 16;
    const int tn = ((it + 1) * gridDim.x + blockIdx.x) * NW + w;
    const bool nvalid = tn < ntask;
    const int nch = nvalid ? tn >> 5 : 0, ng = tn & 31;
#pragma unroll 1
    for (int dir = 0; dir < 2; ++dir) {
      const size_t ip = ((size_t)dir * 32 + g) * 64 + lane;
      const F2 lam = wsp<F2>(P, OFF_LAMB)[ip];
      float hr = 0.f, hi = 0.f;
#pragma unroll 1
      for (int hf = 0; hf < 2; ++hf) {
        SYNC();
        s5_bu_mma(fu, fb, Bu, lr, lq);
        if (hf == 0) s5_u_load(U + (size_t)((dir ? 0 : 1) * 32) * 2048, fu, lr, lq);
        else if (dir == 0) { s5_u_load(U + (size_t)32 * 2048, fu, lr, lq); s5_bb_load(BB16 + ((size_t)32 + g) * 128 * 16, fb, lr, lq); }
        else { s5_u_load(PR0 + (size_t)(nch * 64) * 2048 + ng * 16, fu, lr, lq); s5_bb_load(BB16 + (size_t)ng * 128 * 16, fb, lr, lq); }
        SYNC();
#pragma unroll 8
        for (int s = 0; s < 32; ++s) {
          const int rl = dir ? 31 - s : s;
          const unsigned bv = *reinterpret_cast<const unsigned*>(Bu + rl * 136 + 2 * lane);
          const float nr = lam.x * hr - lam.y * hi + bflo(bv), ni = lam.x * hi + lam.y * hr + bfhi(bv);
          hr = nr; hi = ni;
        }
      }
      if (valid) wsp<F2>(P, OFF_S5C)[(((size_t)ch * 32 + g) * 2 + dir) * 64 + lane] = F2{hr, hi};
    }
    valid = nvalid; ch = nch; g = ng;
  }
}
DEV void phase_s5_carry(const Params& P) {
  const int lane = threadIdx.x & 63, w = threadIdx.x >> 6;
  const int ntask = NSEQ * 64;
  for (int t = blockIdx.x * NW + w; t < ntask; t += gridDim.x * NW) {
    const int seq = t >> 6, g = (t >> 1) & 31, dir = t & 1;
    const int c_first = seq_start(seq) / 64, n = seq_len(seq) / 64;
    const F2 lamT = wsp<F2>(P, OFF_LAMT)[((size_t)dir * 32 + g) * 64 + lane];
    float hr = 0.f, hi = 0.f;
    if (seq >= NB_C) {
      const size_t is = (((size_t)(seq - NB_C) * 2 + dir) * 32 + g) * 64 + lane;
      hr = P.in[I_S5RE][is]; hi = P.in[I_S5IM][is];
    }
    F2* SC = wsp<F2>(P, OFF_S5C) + ((size_t)g * 2 + dir) * 64 + lane;
    const int cstart = dir ? c_first + n - 1 : c_first, cstep = dir ? -1 : 1;
    for (int i0 = 0; i0 < n; i0 += 8) {
      F2 le[8];
#pragma unroll
      for (int u = 0; u < 8; ++u) { const int i = i0 + u < n ? i0 + u : n - 1; le[u] = SC[(size_t)(cstart + cstep * i) * (32 * 2 * 64)]; }
#pragma unroll
      for (int u = 0; u < 8; ++u) if (i0 + u < n) {
        SC[(size_t)(cstart + cstep * (i0 + u)) * (32 * 2 * 64)] = F2{hr, hi};
        float nr = lamT.x * hr - lamT.y * hi + le[u].x, ni = lamT.x * hi + lamT.y * hr + le[u].y; hr = nr; hi = ni;
      }
    }
    if (seq < NB_C) {
      const size_t io = (((size_t)seq * 2 + dir) * 32 + g) * 64 + lane;
      P.out[OUT_S5RE + io] = hr; P.out[OUT_S5IM + io] = hi;
    }
  }
}
DEV void phase_s5_pass2(const Params& P, unsigned char* smem) {
  const int lane = threadIdx.x & 63, w = threadIdx.x >> 6;
  const int lr = lane & 15, lq = lane >> 4;
  bf16_t* Bu = reinterpret_cast<bf16_t*>(smem) + (size_t)w * 32 * 136;
  bf16_t* Hs = reinterpret_cast<bf16_t*>(smem) + (size_t)(NW + w) * 32 * 136;
  const int ntask = (NTOK / 64) * 32;
  const int niter = (ntask + gridDim.x * NW - 1) / (gridDim.x * NW);
  const bf16_t* PR0 = wsp<bf16_t>(P, OFF_PROJ0) + 1536;
  const bf16_t* BB16 = wsp<bf16_t>(P, OFF_BB16);
  int t = blockIdx.x * NW + w;
  bool valid = t < ntask;
  int ch = valid ? t >> 5 : 0, g = t & 31;
  bf16x4 fu[2]; U2 fbb[8];
  s5_u_load(PR0 + (size_t)(ch * 64) * 2048 + g * 16, fu, lr, lq);
  s5_bb_load(BB16 + (size_t)g * 128 * 16, fbb, lr, lq);
  for (int it = 0; it < niter; ++it) {
    const int r0 = ch * 64;
    const bf16_t* U = PR0 + (size_t)r0 * 2048 + g * 16;
    const int tn = ((it + 1) * gridDim.x + blockIdx.x) * NW + w;
    const bool nvalid = tn < ntask;
    const int nch = nvalid ? tn >> 5 : 0, ng = tn & 31;
    const F4 dsk = ldf4(P.in[I_S5D] + g * 16 + lq * 4);
    U2 uu[4];
#pragma unroll
    for (int m = 0; m < 4; ++m) uu[m] = ld8(U + (size_t)(m * 16 + lr) * 2048 + lq * 4);
    f32x4 acc[4];
#pragma unroll
    for (int m = 0; m < 4; ++m) acc[m] = f32x4{0.f, 0.f, 0.f, 0.f};
#pragma unroll 1
    for (int dir = 0; dir < 2; ++dir) {
      const size_t ip = ((size_t)dir * 32 + g) * 64 + lane;
      const F2 lam = wsp<F2>(P, OFF_LAMB)[ip];
      const F2 h0 = wsp<F2>(P, OFF_S5C)[(((size_t)ch * 32 + g) * 2 + dir) * 64 + lane];
      float hr = h0.x, hi = h0.y;
      const bf16_t* CmT = wsp<bf16_t>(P, OFF_CMT) + ((size_t)dir * 32 + g) * 16 * 128;
      bf16x8 fa[4];
#pragma unroll
      for (int kk = 0; kk < 4; ++kk) fa[kk] = as_frag(ld16(CmT + lr * 128 + kk * 32 + lq * 8));
#pragma unroll 1
      for (int hf = 0; hf < 2; ++hf) {
        const int half = dir ? 1 - hf : hf;
        SYNC();
        s5_bu_mma(fu, fbb, Bu, lr, lq);
        if (hf == 0) s5_u_load(U + (size_t)((dir ? 0 : 1) * 32) * 2048, fu, lr, lq);
        else if (dir == 0) { s5_u_load(U + (size_t)32 * 2048, fu, lr, lq); s5_bb_load(BB16 + ((size_t)32 + g) * 128 * 16, fbb, lr, lq); }
        else { s5_u_load(PR0 + (size_t)(nch * 64) * 2048 + ng * 16, fu, lr, lq); s5_bb_load(BB16 + (size_t)ng * 128 * 16, fbb, lr, lq); }
        SYNC();
#pragma unroll 8
        for (int s = 0; s < 32; ++s) {
          const int rl = dir ? 31 - s : s;
          const unsigned bv = *reinterpret_cast<const unsigned*>(Bu + rl * 136 + 2 * lane);
          const float nr = lam.x * hr - lam.y * hi + bflo(bv), ni = lam.x * hi + lam.y * hr + bfhi(bv);
          hr = nr; hi = ni;
          *reinterpret_cast<unsigned*>(Hs + rl * 136 + 2 * lane) = pack2(hr, hi);
        }
        SYNC();
#pragma unroll
        for (int kk = 0; kk < 4; ++kk) {
#pragma unroll
          for (int m2 = 0; m2 < 2; ++m2) {
            bf16x8 fb = as_frag(ld16(Hs + (m2 * 16 + lr) * 136 + kk * 32 + lq * 8));
            if (half == 0) acc[m2] = mfma16(fa[kk], fb, acc[m2]); else acc[2 + m2] = mfma16(fa[kk], fb, acc[2 + m2]);
          }
        }
      }
    }
    if (valid) {
#pragma unroll
      for (int m = 0; m < 4; ++m) {
        const int row = r0 + m * 16 + lr;
        float y0 = gelu_f(acc[m][0] + dsk.x * bflo(uu[m].x)), y1 = gelu_f(acc[m][1] + dsk.y * bfhi(uu[m].x));
        float y2 = gelu_f(acc[m][2] + dsk.z * bflo(uu[m].y)), y3 = gelu_f(acc[m][3] + dsk.w * bfhi(uu[m].y));
        st8(wsp<bf16_t>(P, OFF_YS5) + (size_t)row * 512 + g * 16 + lq * 4, U2{pack2(y0, y1), pack2(y2, y3)});
      }
    }
    valid = nvalid; ch = nch; g = ng;
  }
}
struct EpiGlu { const bf16_t* Y; bf16_t* CAT; const float* b;
  DEVM bf16_t* stage_base(int, int) const { return nullptr; }
  DEVM int stage_ld() const { return 0; }
  DEVM void operator()(int m, int n, f32x4 v) const {
    U2 yy = ld8(Y + (size_t)m * 512 + n); F4 bb = ldf4(b + n);
    float o0 = bflo(yy.x) * sigmoid_f(v[0] + bb.x), o1 = bfhi(yy.x) * sigmoid_f(v[1] + bb.y);
    float o2 = bflo(yy.y) * sigmoid_f(v[2] + bb.z), o3 = bfhi(yy.y) * sigmoid_f(v[3] + bb.w);
    st8(CAT + (size_t)m * 1024 + 512 + n, U2{pack2(o0, o1), pack2(o2, o3)});
  } };

DEV void phase_l0_a(const Params& P, unsigned char* smem) {
  for (int t = blockIdx.x; t < (NTOK / 64) * 6; t += gridDim.x) hyena_conv_task(P, t, smem);
  phase_s5_pass1(P, smem);
}
#ifndef PROBE_SUB
#define PROBE_SUB 0
#endif
#ifndef PROBE_ML
#define PROBE_ML 0
#endif
DEV void phase_l0_b(const Params& P, unsigned char* smem) {
  constexpr int NLAT = 512 * (NB_L / 2), NCTX_ITEMS = 512 * (NB_C / 2), NCTX = (NCTX_ITEMS + NW - 1) / NW;
  const int lane = threadIdx.x & 63, w = threadIdx.x >> 6;
  fft_fill_twiddles<LOG_NL>(reinterpret_cast<F2*>(smem + SM_TWL)); fft_fill_twiddles<LOG_NC>(reinterpret_cast<F2*>(smem + SM_TWC));
  SYNC();
  for (int rep = 0; rep < ((PROBE_SUB & 1) ? 2 : 1); ++rep)
  for (int t = blockIdx.x; t < NLAT; t += gridDim.x)
    hyena_main_item<LOG_NL, NT>(P, t / (NB_L / 2), t % (NB_L / 2), true, reinterpret_cast<F2*>(smem), reinterpret_cast<const F2*>(smem + SM_TWL), threadIdx.x);
  for (int rep = 0; rep < ((PROBE_SUB & 2) ? 2 : 1); ++rep)
  for (int t = blockIdx.x; t < NCTX; t += gridDim.x) {
    const int item = t * NW + w;
    const bool valid = item < NCTX_ITEMS;
    const int it2 = valid ? item : 0;
    hyena_main_item<LOG_NC, 64>(P, it2 / (NB_C / 2), it2 % (NB_C / 2), valid, reinterpret_cast<F2*>(smem) + (size_t)w * (2 * L_C), reinterpret_cast<const F2*>(smem + SM_TWC), lane);
  }
  for (int rep = 0; rep < ((PROBE_SUB & 4) ? 2 : 1); ++rep)
  phase_s5_pass2(P, smem);
}
DEV void phase_l0_c(const Params& P, unsigned char* smem) {
  for (int t = blockIdx.x; t < (NTOK / 64) * 8; t += gridDim.x) hyena_untranspose_task(P, t, smem);
  gemm_phase<128>(wsp<bf16_t>(P, OFF_YS5), 512, wsp<bf16_t>(P, OFF_WGLU), 512, NTOK, 512, 512,
             EpiGlu{wsp<bf16_t>(P, OFF_YS5), wsp<bf16_t>(P, OFF_RA), P.in[I_S5GLUB]}, smem);
}


constexpr int PEER_TPW = 32;
constexpr int PEER_TILE = NW * PEER_TPW;
DEV int peer_my_slice() {
#ifndef EMU
  return (int)(xb_xcc_id() & 7u);
#else
  return (int)(blockIdx.x & 7);
#endif
}
DEV int peer_pull(unsigned* cnt, int* slot) {
  SYNC();
  if (threadIdx.x == 0) *slot = (int)atomicAdd(cnt, 1u);
  SYNC();
  return *slot;
}
DEV void peer_u_item(const Params& P, int tile_, int k_, int lane, int w) {
  const int tile = uniform_i(tile_), k = uniform_i(k_);
  const unsigned char* TU8 = wsp<unsigned char>(P, OFF_TAB8) + (size_t)k * (16384 * 128);
  const int sub = lane >> 3, chunk = lane & 7;
  const int row0 = tile * PEER_TILE + w * PEER_TPW;
  const bf16_t* XR = wsp<bf16_t>(P, OFF_RA) + (size_t)row0 * 1024 + k * 128 + chunk * 16;
  const unsigned short* EIT = wsp<unsigned short>(P, OFF_EIDX) + (size_t)row0 * 128 + 2 * lane;
  auto gather = [&](const unsigned t, int half, U4* u) {
#pragma unroll
    for (int g8 = 0; g8 < 8; ++g8) {
      const int g = half * 8 + g8;
      const unsigned pr = (unsigned)__shfl((int)t, sub * 8 + (g >> 1));
      const unsigned idx = (g & 1) ? (pr >> 16) : (pr & 0xffffu);
      u[g8] = ld16(TU8 + (unsigned)(idx * 128u + (unsigned)chunk * 16u));
    }
  };
  auto dots = [&](const U4* u, const f32x2_t* xa) {
    float res = 0.f;
#pragma unroll
    for (int g8 = 0; g8 < 8; ++g8) {
      const unsigned q[4] = {u[g8].x, u[g8].y, u[g8].z, u[g8].w};
      f32x2_t a2 = fp8lo2(q[0]) * xa[0];
      a2 = fp8hi2(q[0]) * xa[1] + a2;
#pragma unroll
      for (int j = 1; j < 4; ++j) { a2 = fp8lo2(q[j]) * xa[2 * j] + a2; a2 = fp8hi2(q[j]) * xa[2 * j + 1] + a2; }
      float acc = a2[0] + a2[1];
      acc = sum8_dpp(acc);
      if (chunk == g8) res = acc;
    }
    return res;
  };
  unsigned tcur = *reinterpret_cast<const unsigned*>(EIT), tnext = *reinterpret_cast<const unsigned*>(EIT + 128);
  U4 xr0 = ld16(XR), xr1 = ld16(XR + 8);
  U4 ua[8], ub[8];
  gather(tcur, 0, ua);
#pragma unroll 1
  for (int t = 0; t < PEER_TPW; ++t) {
    gather(tcur, 1, ub);
    f32x2_t xa[8];
    { const unsigned q[8] = {xr0.x, xr0.y, xr0.z, xr0.w, xr1.x, xr1.y, xr1.z, xr1.w};
#pragma unroll
      for (int j = 0; j < 8; ++j) { xa[j][0] = bflo(q[j]); xa[j][1] = bfhi(q[j]); } }
    const int tn = t + 1 < PEER_TPW ? t + 1 : PEER_TPW - 1;
    xr0 = ld16(XR + (size_t)tn * 1024); xr1 = ld16(XR + (size_t)tn * 1024 + 8);
    const float res0 = dots(ua, xa);
    gather(tnext, 0, ua);
    const float res1 = dots(ub, xa);
    {
      const int srcA = (lane >> 4) * 8 + (lane & 7), srcB = srcA + 32;
      const float a0 = __shfl(res0, srcA), a1 = __shfl(res1, srcA), b0 = __shfl(res0, srcB), b1 = __shfl(res1, srcB);
      bf16_t* pp = wsp<bf16_t>(P, OFF_PART) + ((size_t)k * NTOK + row0 + t) * 128;
      pp[lane] = f2bf((lane & 8) ? a1 : a0); pp[64 + lane] = f2bf((lane & 8) ? b1 : b0);
    }
    tcur = tnext;
    tnext = *reinterpret_cast<const unsigned*>(EIT + (size_t)(t + 2 < PEER_TPW ? t + 2 : PEER_TPW - 1) * 128);
  }
}
DEV void phase_peer_u(const Params& P, int layer, int rep, unsigned char* smem) {
  int* slot = reinterpret_cast<int*>(smem);
  unsigned* qc = reinterpret_cast<unsigned*>(P.ws + OFF_QCNT) + (layer * 2 + 0) * 8;
  const int tidq = tid_opaque();
  const int lane = tidq & 63, w = tidq >> 6;
  const int my = peer_my_slice();
  for (int s = 0; s < 8; ++s) {
    const int k = (my + s) & 7;
    for (;;) { const int t = peer_pull(qc + k, slot) - rep * (NTOK / PEER_TILE + (int)gridDim.x); if (t >= NTOK / PEER_TILE) break; peer_u_item(P, t, k, lane, w); }
  }
}
DEV void phase_peer_act(const Params& P, unsigned char* smem) {
  float* rs = reinterpret_cast<float*>(smem);
  const float* RSC = wsp<float>(P, OFF_RSC);
  for (int i = threadIdx.x * 4; i < 2 * 16384; i += NT * 4) stf4(rs + i, ldf4(RSC + i));
  SYNC();
  const bf16_t* PART = wsp<bf16_t>(P, OFF_PART);
  const unsigned short* EI = wsp<unsigned short>(P, OFF_EIDX);
  bf16_t* GT = wsp<bf16_t>(P, OFF_EGT);
  for (size_t i = ((size_t)blockIdx.x * NT + threadIdx.x) * 4; i < (size_t)NTOK * 128; i += (size_t)gridDim.x * NT * 4) {
    F4 d{0.f, 0.f, 0.f, 0.f};
#pragma unroll
    for (int k = 0; k < 8; ++k) { const U2 p = ld8(PART + (size_t)k * NTOK * 128 + i); d.x += bflo(p.x); d.y += bfhi(p.x); d.z += bflo(p.y); d.w += bfhi(p.y); }
    const U2 eq = ld8(EI + i), gq = ld8(GT + i);
    const unsigned e0 = eq.x & 0xffffu, e1 = eq.x >> 16, e2 = eq.y & 0xffffu, e3 = eq.y >> 16;
    st8(GT + i, U2{pack2(gelu_f(d.x * rs[e0]) * bflo(gq.x) * rs[16384 + e0], gelu_f(d.y * rs[e1]) * bfhi(gq.x) * rs[16384 + e1]),
                   pack2(gelu_f(d.z * rs[e2]) * bflo(gq.y) * rs[16384 + e2], gelu_f(d.w * rs[e3]) * bfhi(gq.y) * rs[16384 + e3])});
  }
}
DEV void peer_v_item(const Params& P, int layer, float xscale, int tile_, int k_, int lane, int w) {
  const int tile = uniform_i(tile_), k = uniform_i(k_);
  const unsigned char* TV8 = wsp<unsigned char>(P, OFF_TAB8) + (size_t)16384 * 1024 + (size_t)k * (16384 * 128);
  const float* G2 = wsp<float>(P, OFF_MOD) + (size_t)layer * NCOND * 6144 + 5 * 1024;
  const int sub = lane >> 3, chunk = lane & 7;
  const bool b5 = (lane & 32) != 0, b4 = (lane & 16) != 0, b3 = (lane & 8) != 0;
  const int row0 = tile * PEER_TILE + w * PEER_TPW;
  const unsigned short* EIT = wsp<unsigned short>(P, OFF_EIDX) + (size_t)row0 * 128 + 2 * lane;
  const bf16_t* ATT = wsp<bf16_t>(P, OFF_EGT) + (size_t)row0 * 128 + 2 * lane;
  const int c = k * 128 + chunk * 16 + (b5 ? 8 : 0) + (b4 ? 4 : 0) + (b3 ? 2 : 0);
  auto gather = [&](const unsigned t, const unsigned ta, int half, U4* u, float* av) {
#pragma unroll
    for (int g8 = 0; g8 < 8; ++g8) {
      const int g = half * 8 + g8, src = sub * 8 + (g >> 1);
      const unsigned pr = (unsigned)__shfl((int)t, src), pa = (unsigned)__shfl((int)ta, src);
      const unsigned idx = (g & 1) ? (pr >> 16) : (pr & 0xffffu);
      av[g8] = (g & 1) ? bfhi(pa) : bflo(pa);
      u[g8] = ld16(TV8 + (unsigned)(idx * 128u + (unsigned)chunk * 16u));
    }
  };
  auto axpy = [&](const U4* u, const float* av, f32x2_t* oa) {
#pragma unroll
    for (int g8 = 0; g8 < 8; ++g8) {
      const unsigned q[4] = {u[g8].x, u[g8].y, u[g8].z, u[g8].w};
      f32x2_t a2; a2[0] = av[g8]; a2[1] = av[g8];
#pragma unroll
      for (int j = 0; j < 4; ++j) { oa[2 * j] = fp8lo2(q[j]) * a2 + oa[2 * j]; oa[2 * j + 1] = fp8hi2(q[j]) * a2 + oa[2 * j + 1]; }
    }
  };
  unsigned tcur = *reinterpret_cast<const unsigned*>(EIT), tnext = *reinterpret_cast<const unsigned*>(EIT + 128);
  unsigned acur = *reinterpret_cast<const unsigned*>(ATT), anext = *reinterpret_cast<const unsigned*>(ATT + 128);
  U4 va[8], vb[8]; float aa[8], ab[8];
  gather(tcur, acur, 0, va, aa);
#pragma unroll 1
  for (int t = 0; t < PEER_TPW; ++t) {
    gather(tcur, acur, 1, vb, ab);
    f32x2_t oa2[8];
#pragma unroll
    for (int j = 0; j < 8; ++j) { oa2[j][0] = 0.f; oa2[j][1] = 0.f; }
    axpy(va, aa, oa2);
    gather(tnext, anext, 0, va, aa);
    axpy(vb, ab, oa2);
    float oa[16];
#pragma unroll
    for (int j = 0; j < 8; ++j) { oa[2 * j] = oa2[j][0]; oa[2 * j + 1] = oa2[j][1]; }
    const int row = row0 + t;
    float r8[8], r4[4], r2[2];
#pragma unroll
    for (int i = 0; i < 8; ++i) r8[i] = (b5 ? oa[8 + i] : oa[i]) + __shfl_xor(b5 ? oa[i] : oa[8 + i], 32);
#pragma unroll
    for (int i = 0; i < 4; ++i) r4[i] = (b4 ? r8[4 + i] : r8[i]) + __shfl_xor(b4 ? r8[i] : r8[4 + i], 16);
#pragma unroll
    for (int i = 0; i < 2; ++i) r2[i] = (b3 ? r4[2 + i] : r4[i]) + __shfl_xor(b3 ? r4[i] : r4[2 + i], 8);
    float* X = wsp<float>(P, OFF_X) + (size_t)row * 1024 + c;
    const float* g2 = G2 + (size_t)row_cond(row) * 6144 + c;
    F2 xv = *reinterpret_cast<F2*>(X); const F2 gv = *reinterpret_cast<const F2*>(g2);
    xv.x += xscale * gv.x * r2[0]; xv.y += xscale * gv.y * r2[1];
    *reinterpret_cast<F2*>(X) = xv;
    tcur = tnext; acur = anext;
    const int t2 = t + 2 < PEER_TPW ? t + 2 : PEER_TPW - 1;
    tnext = *reinterpret_cast<const unsigned*>(EIT + (size_t)t2 * 128); anext = *reinterpret_cast<const unsigned*>(ATT + (size_t)t2 * 128);
  }
}
DEV void phase_peer_v(const Params& P, int layer, float xscale, int rep, unsigned char* smem) {
  int* slot = reinterpret_cast<int*>(smem);
  unsigned* qc = reinterpret_cast<unsigned*>(P.ws + OFF_QCNT) + (layer * 2 + 1) * 8;
  const int tidq = tid_opaque();
  const int lane = tidq & 63, w = tidq >> 6;
  const int my = peer_my_slice();
  for (int s = 0; s < 8; ++s) {
    const int k = (my + s) & 7;
    for (;;) { const int t = peer_pull(qc + k, slot) - rep * (NTOK / PEER_TILE + (int)gridDim.x); if (t >= NTOK / PEER_TILE) break; peer_v_item(P, layer, xscale, t, k, lane, w); }
  }
}

struct EpiGates { float* GTS;
  DEVM bf16_t* stage_base(int, int) const { return nullptr; }
  DEVM int stage_ld() const { return 0; }
  DEVM void operator()(int m, int n, f32x4 v) const { if (n < 32) stf4(GTS + (size_t)m * 32 + n, F4{v[0], v[1], v[2], v[3]}); } };
DEV void phase_odin(const Params& P, unsigned char* smem) {
  gemm_phase<256>(wsp<bf16_t>(P, OFF_RA), 1024, wsp<bf16_t>(P, OFF_WODIN), 1024, NTOK, 4096, 1024, EpiStoreBf16{wsp<bf16_t>(P, OFF_PROJ1), 4096}, smem);
  EpiGates eg{wsp<float>(P, OFF_GATES)};
  for (int t = (int)gridDim.x - 1 - (int)blockIdx.x; t < NTOK / 256; t += gridDim.x)
    gemm_tile<128>(wsp<bf16_t>(P, OFF_RA), 1024, wsp<bf16_t>(P, OFF_WODIN) + (size_t)4096 * 1024, 1024, 1024, t * 256, 0, eg, smem);
}

DEV void phase_gate_scan(const Params& P) {
  const int lane = threadIdx.x & 63, w = threadIdx.x >> 6;
  const float* GTS = wsp<float>(P, OFF_GATES);
  float* GS = wsp<float>(P, OFF_GS);
  const int ntask = (NTOK / 128) * 16;
  for (int t = blockIdx.x * NW + w; t < ntask; t += gridDim.x * NW) {
    const int tc = t >> 4, head = (t >> 1) & 7, dir = t & 1;
    const float gbi = P.in[I_ODGATEB][dir * 8 + head], gbf = P.in[I_ODGATEB][16 + dir * 8 + head];
    float carry_b = 0.f, carry_m = -3.0e38f;
    float* out = GS + ((size_t)(tc * 8 + head) * 2 + dir) * 384;
#pragma unroll
    for (int hf = 0; hf < 2; ++hf) {
      const int s = lane + 64 * hf;
      const int row = tc * 128 + (dir ? 127 - s : s);
      const float ig = GTS[(size_t)row * 32 + dir * 8 + head] + gbi;
      const float fg = GTS[(size_t)row * 32 + 16 + dir * 8 + head] + gbf;
      float b = log_sigmoid_f(fg);
      for (int d = 1; d < 64; d <<= 1) { float o = __shfl_up(b, d); if (lane >= d) b += o; }
      b += carry_b;
      float c = ig - b, pm = c;
      for (int d = 1; d < 64; d <<= 1) { float o = __shfl_up(pm, d); if (lane >= d) pm = fmaxf(pm, o); }
      pm = fmaxf(pm, carry_m);
      carry_b = __shfl(b, 63); carry_m = __shfl(pm, 63);
      out[s] = b; out[128 + s] = c; out[256 + s] = pm;
    }
  }
}
DEV void phase_qkconv(const Params& P) {
  const bf16_t* PR = wsp<bf16_t>(P, OFF_PROJ1);
  bf16_t* QC = wsp<bf16_t>(P, OFF_QC); bf16_t* KC = wsp<bf16_t>(P, OFF_KC);
  const float* cw = P.in[I_MLCW]; const float* cbias = P.in[I_MLCB];
  const int tid = threadIdx.x;
  for (int t = blockIdx.x; t < (NTOK / 64) * 4; t += gridDim.x) {
    const int r0 = (t >> 2) * 64, c0 = (t & 3) * 512;
    const int c = c0 + (tid & 63) * 8;
    F4 w0a = ldf4(cw + c), w0b = ldf4(cw + c + 4), w1a = ldf4(cw + 2048 + c), w1b = ldf4(cw + 2048 + c + 4);
    F4 w2a = ldf4(cw + 4096 + c), w2b = ldf4(cw + 4096 + c + 4), ba = ldf4(cbias + c), bb = ldf4(cbias + c + 4);
    const float w0[8] = {w0a.x, w0a.y, w0a.z, w0a.w, w0b.x, w0b.y, w0b.z, w0b.w};
    const float w1[8] = {w1a.x, w1a.y, w1a.z, w1a.w, w1b.x, w1b.y, w1b.z, w1b.w};
    const float w2[8] = {w2a.x, w2a.y, w2a.z, w2a.w, w2b.x, w2b.y, w2b.z, w2b.w};
    const float bs[8] = {ba.x, ba.y, ba.z, ba.w, bb.x, bb.y, bb.z, bb.w};
    const float sc = c < 1024 ? 0.08838834764831845f : 1.f;
#pragma unroll 2
    for (int i = 0; i < 8; ++i) {
      const int item = i * NT + tid;
      const int row = r0 + (item >> 6);
      const int pos = row_pos(row), L = row < NTOK_C ? L_C : L_L;
      const bf16_t* p = PR + (size_t)row * 4096 + c;
      const U4 z4{0u, 0u, 0u, 0u};
      U4 xm = pos > 0 ? ld16(p - 4096) : z4, x0 = ld16(p), xp = pos < L - 1 ? ld16(p + 4096) : z4;
      const unsigned am[4] = {xm.x, xm.y, xm.z, xm.w}, a0[4] = {x0.x, x0.y, x0.z, x0.w}, ap[4] = {xp.x, xp.y, xp.z, xp.w};
      float o[8];
#pragma unroll
      for (int j = 0; j < 8; ++j) {
        float vm = (j & 1) ? bfhi(am[j >> 1]) : bflo(am[j >> 1]);
        float v0 = (j & 1) ? bfhi(a0[j >> 1]) : bflo(a0[j >> 1]);
        float vp = (j & 1) ? bfhi(ap[j >> 1]) : bflo(ap[j >> 1]);
        o[j] = silu_f(vm * w0[j] + v0 * w1[j] + vp * w2[j] + bs[j]) * sc;
      }
      bf16_t* dst = c < 1024 ? QC + (size_t)row * 1024 + c : KC + (size_t)row * 1024 + (c - 1024);
      st16(dst, U4{pack2(o[0], o[1]), pack2(o[2], o[3]), pack2(o[4], o[5]), pack2(o[6], o[7])});
    }
  }
}
constexpr int ML_LD = 136;
constexpr int ML_SLW = 64;
constexpr int ML_NSL = 128 / ML_SLW;
constexpr int ML_NVT = ML_SLW / 16 + 1;
constexpr int ML_VR = 16 * ML_NVT;
constexpr int ML_NVL = ML_SLW / 32;
constexpr int ML_LDV = ML_VR + 8;
DEV void phase_mlstm(const Params& P, unsigned char* smem) {
  bf16_t* Ks = reinterpret_cast<bf16_t*>(smem);
  bf16_t* Vn = Ks + 128 * ML_LD;
  bf16_t* Vwn = Vn + 128 * ML_LDV;
  bf16_t* Ct0 = Vwn + 128 * ML_LDV;
  float* cs = reinterpret_cast<float*>(Ct0 + 2 * ML_VR * ML_LD);
  float* Mt = cs + 128; float* bt = Mt + 128; float* misc = bt + 128;
  int* qslot = reinterpret_cast<int*>(misc + 8);
  unsigned* qcnt = reinterpret_cast<unsigned*>(P.ws + OFF_QCNT) + 32;
  const int tid = threadIdx.x, lane = tid & 63, w = tid >> 6, lr = lane & 15, lq = lane >> 4;
  const bf16_t* PR = wsp<bf16_t>(P, OFF_PROJ1);
  const bf16_t* QC = wsp<bf16_t>(P, OFF_QC); const bf16_t* KC = wsp<bf16_t>(P, OFF_KC);
  constexpr int TPS = 16 * ML_NSL;
  constexpr int NLAT = NB_L * TPS, NTASK = (NB_L + NB_C) * TPS;
  constexpr int TABG = 16;
  for (;;) {
    const int task = peer_pull(qcnt, qslot);
    if (task >= NTASK + TAB_TILES / TABG) break;
    if (task >= NTASK) {
      for (int i = 0; i < TABG; ++i) job_tab(P, 1, (task - NTASK) * TABG + i);
      continue;
    }
    const int seq = task < NLAT ? NB_C + task / TPS : (task - NLAT) / TPS;
    const int rem = task % TPS, head = rem / (2 * ML_NSL), dir = (rem / ML_NSL) & 1, sl = rem % ML_NSL;
    const int L = seq_len(seq), nchunk = L / 128, rbase = seq_start(seq);
    bf16_t* HO = wsp<bf16_t>(P, OFF_PROJ1) + (dir ? 1024 : 0);
    f32x4 Cacc[ML_NVT];
    float m_prev = 0.f;
#pragma unroll
    for (int vt = 0; vt < ML_NVT; ++vt) Cacc[vt] = f32x4{0.f, 0.f, 0.f, 0.f};
    if (seq >= NB_C) {
      const size_t sb = ((size_t)(seq - NB_C) * 2 + dir) * 8 + head;
      const float* C0 = P.in[I_MLC] + sb * 16384;
      const int k = 16 * w + lr;
#pragma unroll
      for (int vt = 0; vt < ML_NVT - 1; ++vt) { F4 c = ldf4(C0 + (size_t)k * 128 + sl * ML_SLW + 16 * vt + 4 * lq); Cacc[vt] = f32x4{c.x, c.y, c.z, c.w}; }
      if (lq == 0) Cacc[ML_NVT - 1][0] = P.in[I_MLN][sb * 128 + k];
      m_prev = P.in[I_MLM][sb];
    }
    if (tid < 128) {
      st16(Vn + tid * ML_LDV + ML_SLW, U4{0x3f80u, 0u, 0u, 0u}); st16(Vn + tid * ML_LDV + ML_SLW + 8, U4{0u, 0u, 0u, 0u});
      st16(Vn + tid * ML_LDV + ML_SLW + 16, U4{0u, 0u, 0u, 0u});
      st16(Vwn + tid * ML_LDV + ML_SLW + 8, U4{0u, 0u, 0u, 0u}); st16(Vwn + tid * ML_LDV + ML_SLW + 16, U4{0u, 0u, 0u, 0u});
    }
#pragma unroll
    for (int vt = 0; vt < ML_NVT; ++vt)
#pragma unroll
      for (int r = 0; r < 4; ++r) Ct0[(16 * vt + 4 * lq + r) * ML_LD + 16 * w + lr] = f2bf(Cacc[vt][r]);
    U4 kreg[4], vreg[ML_NVL], qreg[4]; float gsb[2] = {0.f, 0.f}, gsc[2] = {0.f, 0.f}, gsm[2] = {0.f, 0.f}; float cs_row = 0.f, pm_last = 0.f;
    const float* GSq = wsp<float>(P, OFF_GS);
    auto prefetch = [&](int ci) {
      {
        const int s = tid >> 2, cg = (tid & 3) * 32;
        const int off = ci * 128 + s;
        const int row = rbase + (dir ? L - 1 - off : off);
#pragma unroll
        for (int q8 = 0; q8 < 4; ++q8) kreg[q8] = ld16(KC + (size_t)row * 1024 + head * 128 + cg + q8 * 8);
#pragma unroll
        for (int i = 0; i < ML_NVL; ++i) vreg[i] = ld16(PR + (size_t)row * 4096 + 2048 + head * 128 + sl * ML_SLW + (tid & 3) * (ML_SLW / 4) + i * 8);
      }
      {
        const int off = ci * 128 + 16 * (w < 4 ? w : 11 - w) + lr;
        const int row = rbase + (dir ? L - 1 - off : off);
#pragma unroll
        for (int kk = 0; kk < 4; ++kk) qreg[kk] = ld16(QC + (size_t)row * 1024 + head * 128 + kk * 32 + lq * 8);
      }
      {
        const int tc = (rbase >> 7) + (dir ? nchunk - 1 - ci : ci);
        const float* g = GSq + ((size_t)(tc * 8 + head) * 2 + dir) * 384;
        cs_row = g[128 + (tid >> 2)]; pm_last = g[256 + 127];
        if (w == 0) {
#pragma unroll
          for (int hf = 0; hf < 2; ++hf) { gsb[hf] = g[lane + 64 * hf]; gsc[hf] = g[128 + lane + 64 * hf]; gsm[hf] = g[256 + lane + 64 * hf]; }
        }
      }
    };
    prefetch(0);
    for (int ci = 0; ci < nchunk; ++ci) {
      const bf16_t* Ct = Ct0 + (ci & 1) * ML_VR * ML_LD;
      bf16_t* Cn = Ct0 + ((ci + 1) & 1) * ML_VR * ML_LD;
      SYNC();
      if (w == 0) {
#pragma unroll
        for (int hf = 0; hf < 2; ++hf) { const int s = lane + 64 * hf; cs[s] = gsc[hf]; bt[s] = gsb[hf]; Mt[s] = fmaxf(m_prev, gsm[hf]); }
        if (lane == 63) { misc[0] = gsb[1]; misc[1] = fmaxf(m_prev, gsm[1]); }
      }
      {
        const int s = tid >> 2, cg = (tid & 3) * 32;
#pragma unroll
        for (int q8 = 0; q8 < 4; ++q8) st16(Ks + s * ML_LD + cg + q8 * 8, kreg[q8]);
        const float ws = __expf(cs_row - fmaxf(m_prev, pm_last));
#pragma unroll
        for (int i = 0; i < ML_NVL; ++i) {
          const int vc = (tid & 3) * (ML_SLW / 4) + i * 8;
          st16(Vn + s * ML_LDV + vc, vreg[i]);
          const unsigned va[4] = {vreg[i].x, vreg[i].y, vreg[i].z, vreg[i].w};
          st16(Vwn + s * ML_LDV + vc, U4{pack2(bflo(va[0]) * ws, bfhi(va[0]) * ws), pack2(bflo(va[1]) * ws, bfhi(va[1]) * ws),
                                          pack2(bflo(va[2]) * ws, bfhi(va[2]) * ws), pack2(bflo(va[3]) * ws, bfhi(va[3]) * ws)});
        }
        if ((tid & 3) == 0) st16(Vwn + s * ML_LDV + ML_SLW, U4{(unsigned)f2bf(ws), 0u, 0u, 0u});
      }
      bf16x8 qf[4];
#pragma unroll
      for (int kk = 0; kk < 4; ++kk) qf[kk] = as_frag(qreg[kk]);
      SYNC();
      prefetch(ci + 1 < nchunk ? ci + 1 : ci);
      const float M_last = misc[1], b_last = misc[0];
      const int tb = w < 4 ? w : 11 - w;
      const int t = 16 * tb + lr;
      const float M_t = Mt[t];
      f32x4 accn[ML_NVT];
#pragma unroll
      for (int vt = 0; vt < ML_NVT; ++vt) {
        accn[vt] = f32x4{0.f, 0.f, 0.f, 0.f};
#pragma unroll
        for (int kk = 0; kk < 4; ++kk) accn[vt] = mfma16(as_frag(ld16(Ct + (16 * vt + lr) * ML_LD + kk * 32 + lq * 8)), qf[kk], accn[vt]);
        const float wi = __expf(m_prev - M_t);
#pragma unroll
        for (int r = 0; r < 4; ++r) accn[vt][r] *= wi;
      }
      for (int j2 = 0; 2 * j2 <= tb; ++j2) {
        unsigned pk[4] = {0u, 0u, 0u, 0u};
#pragma unroll
        for (int hh = 0; hh < 2; ++hh) {
          const int i = 2 * j2 + hh;
          if (i <= tb) {
            f32x4 sa = f32x4{0.f, 0.f, 0.f, 0.f};
#pragma unroll
            for (int kk = 0; kk < 4; ++kk) sa = mfma16(as_frag(ld16(Ks + (16 * i + lr) * ML_LD + kk * 32 + lq * 8)), qf[kk], sa);
            float pv[4];
#pragma unroll
            for (int r = 0; r < 4; ++r) {
              const int s = 16 * i + 4 * lq + r;
              pv[r] = s <= t ? sa[r] * __expf(cs[s] - M_t) : 0.f;
            }
            pk[hh * 2] = pack2(pv[0], pv[1]); pk[hh * 2 + 1] = pack2(pv[2], pv[3]);
          }
        }
        const bf16x8 pf = as_frag(U4{pk[0], pk[1], pk[2], pk[3]});
#pragma unroll
        for (int vt = 0; vt < ML_NVT; ++vt) {
          const bf16_t* vp = Vn + (32 * j2 + 4 * lq + (lr >> 2)) * ML_LDV + 16 * vt + 4 * (lr & 3);
          accn[vt] = mfma16(as_frag2(lds_tr_read(vp), lds_tr_read(vp + 16 * ML_LDV)), pf, accn[vt]);
        }
      }
      {
        const float den = __shfl(accn[ML_NVT - 1][0], lr);
        const float flo = __expf(-(bt[t] + M_t));
        const float inv = 1.f / fmaxf(fabsf(den), flo);
        const int off = ci * 128 + t;
        const int row = dir ? rbase + L - 1 - off : rbase + off;
#pragma unroll
        for (int vt = 0; vt < ML_NVT - 1; ++vt)
          st8(HO + (size_t)row * HLD + head * 128 + sl * ML_SLW + 16 * vt + 4 * lq,
              U2{pack2(accn[vt][0] * inv, accn[vt][1] * inv), pack2(accn[vt][2] * inv, accn[vt][3] * inv)});
      }
      {
        const float keep = __expf(m_prev - M_last);
        bf16x8 kf[4];
#pragma unroll
        for (int ss = 0; ss < 4; ++ss) {
          const bf16_t* kp = Ks + (32 * ss + 8 * lq + (lr >> 2)) * ML_LD + 16 * w + 4 * (lr & 3);
          kf[ss] = as_frag2(lds_tr_read(kp), lds_tr_read(kp + 4 * ML_LD));
        }
#pragma unroll
        for (int vt = 0; vt < ML_NVT; ++vt) {
#pragma unroll
          for (int r = 0; r < 4; ++r) Cacc[vt][r] *= keep;
#pragma unroll
          for (int ss = 0; ss < 4; ++ss) {
            const bf16_t* wp = Vwn + (32 * ss + 8 * lq + (lr >> 2)) * ML_LDV + 16 * vt + 4 * (lr & 3);
            Cacc[vt] = mfma16(as_frag2(lds_tr_read(wp), lds_tr_read(wp + 4 * ML_LDV)), kf[ss], Cacc[vt]);
          }
#pragma unroll
          for (int r = 0; r < 4; ++r) Cn[(16 * vt + 4 * lq + r) * ML_LD + 16 * w + lr] = f2bf(Cacc[vt][r]);
        }
        m_prev = b_last + M_last;
      }
    }
    if (seq < NB_C) {
      const size_t sb = ((size_t)seq * 2 + dir) * 8 + head;
      const int k = 16 * w + lr;
#pragma unroll
      for (int vt = 0; vt < ML_NVT - 1; ++vt)
        stf4(P.out + OUT_MLC + sb * 16384 + (size_t)k * 128 + sl * ML_SLW + 16 * vt + 4 * lq, F4{Cacc[vt][0], Cacc[vt][1], Cacc[vt][2], Cacc[vt][3]});
      if (sl == 0 && lq == 0) P.out[OUT_MLN + sb * 128 + k] = Cacc[ML_NVT - 1][0];
      if (sl == 0 && tid == 0) P.out[OUT_MLM + sb] = m_prev;
    }
  }
}
DEV void phase_mlstm_norm(const Params& P) {
  const int lane = threadIdx.x & 63, w = threadIdx.x >> 6;
  const bf16_t* PR = wsp<bf16_t>(P, OFF_PROJ1);
  const bf16_t* HF = PR; const bf16_t* HB = PR + 1024;
  bf16_t* HN = wsp<bf16_t>(P, OFF_RA);
  for (int r = blockIdx.x * NW + w; r < NTOK; r += gridDim.x * NW) {
    float h[16], o[16];
#pragma unroll
    for (int hh = 0; hh < 2; ++hh) {
      const int c = hh * 512 + lane * 8;
      U4 a = ld16(HF + (size_t)r * HLD + c), b = ld16(HB + (size_t)r * HLD + c), ov = ld16(PR + (size_t)r * 4096 + 3072 + c);
      const unsigned aa[4] = {a.x, a.y, a.z, a.w}, bb[4] = {b.x, b.y, b.z, b.w}, oo[4] = {ov.x, ov.y, ov.z, ov.w};
#pragma unroll
      for (int j = 0; j < 4; ++j) {
        h[hh * 8 + 2 * j] = bflo(aa[j]) + bflo(bb[j]); h[hh * 8 + 2 * j + 1] = bfhi(aa[j]) + bfhi(bb[j]);
        o[hh * 8 + 2 * j] = bflo(oo[j]); o[hh * 8 + 2 * j + 1] = bfhi(oo[j]);
      }
    }
#pragma unroll
    for (int hh = 0; hh < 2; ++hh) {
      const int c = hh * 512 + lane * 8;
      float ss = 0.f;
#pragma unroll
      for (int j = 0; j < 8; ++j) ss += h[hh * 8 + j] * h[hh * 8 + j];
      ss += __shfl_xor(ss, 1); ss += __shfl_xor(ss, 2); ss += __shfl_xor(ss, 4); ss += __shfl_xor(ss, 8);
      const float rs = rsqrtf(ss * (1.f / 128.f) + EPS);
      const F4 g0 = ldf4(P.in[I_MLNORMG] + c), g1 = ldf4(P.in[I_MLNORMG] + c + 4);
      const float ng[8] = {g0.x, g0.y, g0.z, g0.w, g1.x, g1.y, g1.z, g1.w};
      unsigned pk[4];
#pragma unroll
      for (int j = 0; j < 4; ++j) pk[j] = pack2(h[hh * 8 + 2 * j] * rs * ng[2 * j] * silu_f(o[hh * 8 + 2 * j]), h[hh * 8 + 2 * j + 1] * rs * ng[2 * j + 1] * silu_f(o[hh * 8 + 2 * j + 1]));
      st16(HN + (size_t)r * 1024 + c, U4{pk[0], pk[1], pk[2], pk[3]});
    }
  }
}
DEV void phase_final(const Params& P) {
  const int lane = threadIdx.x & 63, w = threadIdx.x >> 6;
  const float* X = wsp<float>(P, OFF_X);
  const float* g = P.in[I_FINALG];
  F4 gq[4];
#pragma unroll
  for (int i = 0; i < 4; ++i) gq[i] = ldf4(g + i * 256 + lane * 4);
  for (int r = blockIdx.x * NW + w; r < NTOK; r += gridDim.x * NW) {
    const float* x = X + (size_t)r * 1024;
    F4 v[4]; float ss = 0.f;
#pragma unroll
    for (int i = 0; i < 4; ++i) { v[i] = ldf4(x + i * 256 + lane * 4); ss += v[i].x * v[i].x + v[i].y * v[i].y + v[i].z * v[i].z + v[i].w * v[i].w; }
    ss = wave_sum(ss);
    const float rs = rsqrtf(ss * (1.f / 1024.f) + EPS);
#pragma unroll
    for (int i = 0; i < 4; ++i) {
      const int c = i * 256 + lane * 4;
      const F4 gg = gq[i];
      stf4_nt(P.out + OUT_Y + (size_t)r * 1024 + c, F4{v[i].x * rs * gg.x, v[i].y * rs * gg.y, v[i].z * rs * gg.z, v[i].w * rs * gg.w});
    }
  }
}


constexpr int NPHASE = 25;
constexpr size_t SMEM_BYTES = 160 * 1024;
#ifndef ONLY_PHASE
#define ONLY_PHASE -1
#endif
#ifndef EXCL_MASK
#define EXCL_MASK 0u
#endif
#define PH_EN(k) ((ONLY_PHASE < 0 || ONLY_PHASE == (k)) && !(((EXCL_MASK) >> (k)) & 1u))
#ifndef PROBE_MASK
#define PROBE_MASK 0u
#endif
#ifndef PROBE_SYNC2
#define PROBE_SYNC2 0
#endif
#define PROBE_ON(k) (((PROBE_MASK) >> (k)) & 1u)
#define PROBE_SCALE(k) (PROBE_ON(k) ? 0.5f : 1.0f)
DEV void run_phase(const Params& P, int ph, unsigned char* smem, int rep = 0) {
  switch (ph) {
    case 0: if (PH_EN(0)) { phase_prep(P, smem); } break;
    case 1: if (PH_EN(1)) { phase_norm(P, 0, 0, false); phase_hyena_filters(P, smem); } break;
    case 2: if (PH_EN(2)) { gemm_phase<256>(wsp<bf16_t>(P, OFF_RA), 1024, wsp<bf16_t>(P, OFF_WEVIN), 1024, NTOK, 2048, 1024,
                       EpiStoreBf16{wsp<bf16_t>(P, OFF_PROJ0), 2048}, smem); } break;
    case 3: if (PH_EN(3)) { phase_l0_a(P, smem); } break;
    case 4: if (PH_EN(4)) { phase_s5_carry(P); } break;
    case 5: if (PH_EN(5)) { phase_l0_b(P, smem); } break;
    case 6: if (PH_EN(6)) { phase_l0_c(P, smem); } break;
    case 7: if (PH_EN(7)) { gemm_phase<128>(wsp<bf16_t>(P, OFF_RA), 1024, wsp<bf16_t>(P, OFF_WEVOUT), 1024, NTOK, 1024, 1024,
                       EpiResid{wsp<float>(P, OFF_X), wsp<float>(P, OFF_MOD) + 2 * 1024, PROBE_SCALE(7)}, smem); } break;
    case 8: if (PH_EN(8)) { phase_norm(P, 0, 1, true); phase_wf(P, 0, smem); } break;
    case 9: if (PH_EN(9)) { gemm_phase<256>(wsp<bf16_t>(P, OFF_RA), 1024, wsp<bf16_t>(P, OFF_WF), 1024, NTOK, 2048, 1024,
                       EpiTopk{wsp<unsigned short>(P, OFF_EIDX), wsp<bf16_t>(P, OFF_EGT)}, smem); } break;
    case 10: if (PH_EN(10)) { phase_peer_u(P, 0, rep, smem); } break;
    case 11: if (PH_EN(11)) { phase_peer_act(P, smem); } break;
    case 12: if (PH_EN(12)) { phase_peer_v(P, 0, PROBE_SCALE(12), rep, smem); } break;
    case 13: if (PH_EN(13)) { phase_norm(P, 1, 0, false); } break;
    case 14: if (PH_EN(14)) { phase_odin(P, smem); } break;
    case 15: if (PH_EN(15)) { phase_qkconv(P); phase_gate_scan(P); } break;
    case 16: if (PH_EN(16)) { phase_mlstm(P, smem); } break;
    case 17: if (PH_EN(17)) { phase_mlstm_norm(P); } break;
    case 18: if (PH_EN(18)) { gemm_phase<128>(wsp<bf16_t>(P, OFF_RA), 1024, wsp<bf16_t>(P, OFF_WODOUT), 1024, NTOK, 1024, 1024,
                        EpiResid{wsp<float>(P, OFF_X), wsp<float>(P, OFF_MOD) + (size_t)NCOND * 6144 + 2 * 1024, PROBE_SCALE(18)}, smem); } break;
    case 19: if (PH_EN(19)) { phase_norm(P, 1, 1, false); phase_wf(P, 1, smem); } break;
    case 20: if (PH_EN(20)) { gemm_phase<256>(wsp<bf16_t>(P, OFF_RA), 1024, wsp<bf16_t>(P, OFF_WF), 1024, NTOK, 2048, 1024,
                        EpiTopk{wsp<unsigned short>(P, OFF_EIDX), wsp<bf16_t>(P, OFF_EGT)}, smem); } break;
    case 21: if (PH_EN(21)) { phase_peer_u(P, 1, rep, smem); } break;
    case 22: if (PH_EN(22)) { phase_peer_act(P, smem); } break;
    case 23: if (PH_EN(23)) { phase_peer_v(P, 1, PROBE_SCALE(23), rep, smem); } break;
    case 24: if (PH_EN(24)) { phase_final(P); } break;
    default: break;
  }
}
#ifndef EMU
#define PHASE_SYNC(PH) do { xcd_barrier(xb); } while (0)
#else
#define PHASE_SYNC(PH) GRID_SYNC()
#endif
template <int PH> DEV void run_phase_t(const Params& P, int ph_lo, int ph_hi, unsigned char* smem, const XcdBarrier& xb) {
  if (PH >= ph_lo && PH < ph_hi) {
    if (PH > ph_lo) { PHASE_SYNC(PH); if (PROBE_SYNC2) PHASE_SYNC(PH); }
    run_phase(P, PH, smem);
    if (PROBE_ON(PH)) { PHASE_SYNC(PH); run_phase(P, PH, smem, 1); }
  }
}
template <int... I> struct IntSeq {};
template <int N, int... I> struct MakeSeq : MakeSeq<N - 1, N - 1, I...> {};
template <int... I> struct MakeSeq<0, I...> { typedef IntSeq<I...> type; };
template <int... I> DEV void run_all(const Params& P, int lo, int hi, unsigned char* smem, const XcdBarrier& xb, IntSeq<I...>) {
  int dummy[] = {(run_phase_t<I>(P, lo, hi, smem, xb), 0)...};
  (void)dummy;
}
__global__ void __launch_bounds__(NT, 1) mega_kernel(Params P, int ph_lo, int ph_hi) {
  SMEM_DECL(smem);
#ifndef EMU
  volatile unsigned* st = reinterpret_cast<volatile unsigned*>(smem + SMEM_BYTES - 16);
  if (threadIdx.x == 0) { st[0] = 0u; st[1] = 0u; st[2] = 0u; st[3] = 0u; }
  __syncthreads();
  XcdBarrier xb = xcd_barrier_post(reinterpret_cast<unsigned*>(P.ws + OFF_BAR), st);
  if (ph_lo == 0) GRID_SYNC();
#else
  XcdBarrier xb{0};
#endif
  run_all(P, ph_lo, ph_hi, smem, xb, typename MakeSeq<NPHASE>::type());
}

#ifndef EMU
extern "C" void kernel_launch(void* const* d_in, const int* in_sizes, int n_in, void* d_out, int out_size, void* d_ws,
                              size_t ws_size, hipStream_t stream) {
  Params P{};
  for (int i = 0; i < 45; ++i) P.in[i] = (const float*)d_in[i];
  P.out = (float*)d_out; P.ws = (unsigned char*)d_ws;
  static int grid_blocks = 0;
  if (!grid_blocks) {
    int dev = 0, cus = 0, per_cu = 0;
    hipGetDevice(&dev);
    hipDeviceGetAttribute(&cus, hipDeviceAttributeMultiprocessorCount, dev);
    hipFuncSetAttribute((const void*)mega_kernel, hipFuncAttributeMaxDynamicSharedMemorySize, (int)SMEM_BYTES);
    hipOccupancyMaxActiveBlocksPerMultiprocessor(&per_cu, mega_kernel, NT, SMEM_BYTES);
    if (per_cu > 1) per_cu = 1;
    grid_blocks = cus * per_cu;
    if (grid_blocks <= 0) grid_blocks = 256;
  }
  hipMemsetAsync(P.ws + OFF_BAR, 0, SZ_BAR, stream);
  int lo = 0, hi = NPHASE;
  void* args[] = {&P, &lo, &hi};
  hipError_t e = hipLaunchCooperativeKernel((const void*)mega_kernel, dim3(grid_blocks), dim3(NT), args, (unsigned)SMEM_BYTES, stream);
  if (e != hipSuccess) fprintf(stderr, "cooperative launch failed: %s (grid %d)\n", hipGetErrorString(e), grid_blocks);
}
#endif
```
